# Optimizing an MI355X kernel written in HIP

```python
import jax, jax.numpy as jnp
from jax import lax
import numpy as np

D_MODEL = 1024
BATCH = 8
SEQ = 2048
DEPTH = 4
DEC_BATCH = 32
DEC_SEQ = 16
PAST_LEN = 1024

CHUNK = 64
N_HEADS = 16
HEAD_DIM = D_MODEL // N_HEADS
D_FF = 2816
LEFT_CHUNKS = 8
BAND = (LEFT_CHUNKS + 1) * CHUNK
A_WINDOW = LEFT_CHUNKS * CHUNK
A_CACHE = min(A_WINDOW, PAST_LEN)
A_KEEP = min(A_WINDOW, SEQ)
REL_MAX = 256
N_REL = 2 * REL_MAX + 1
Q_BLOCK = 128
N_MIXERS = 3
N_A = (DEPTH + 2) // 3
N_B = (DEPTH + 1) // 3
N_C = DEPTH // 3
RMS_EPS = 1e-6
ATTN_SCALE = HEAD_DIM ** -0.5
NEG_INF = -1e30
FORGET_BIAS_INIT = 3.0

kernel_name = 'hybrid_streaming_chunk_encoder_step'


def rms_norm(x, g):
    xf = x.astype(jnp.float32)
    y = xf * lax.rsqrt(jnp.mean(xf * xf, axis=-1, keepdims=True) + RMS_EPS)
    return (y * g.astype(jnp.float32)).astype(x.dtype)


def swiglu(h, w_gate, w_up, w_down):
    return (jax.nn.silu(h @ w_gate) * (h @ w_up)) @ w_down


def project_qkv(h, w_qkv):
    q, k, v = jnp.split(h @ w_qkv, 3, axis=-1)
    shape = h.shape[:-1] + (N_HEADS, HEAD_DIM)
    return q.reshape(shape), k.reshape(shape), v.reshape(shape)


def rel_bias(rel_table, dist):
    idx = jnp.clip(dist, -REL_MAX, REL_MAX) + REL_MAX
    return jnp.moveaxis(rel_table[idx].astype(jnp.float32), -1, 0)


def chunk_attn_prompt(q, k, v, rel_table):
    b, s = q.shape[:2]
    nc = s // CHUNK
    qc = q.reshape(b, nc, CHUNK, N_HEADS, HEAD_DIM)
    pad = ((0, 0), (LEFT_CHUNKS * CHUNK, 0), (0, 0), (0, 0))
    kp = jnp.pad(k, pad).reshape(b, nc + LEFT_CHUNKS, CHUNK, N_HEADS, HEAD_DIM)
    vp = jnp.pad(v, pad).reshape(b, nc + LEFT_CHUNKS, CHUNK, N_HEADS, HEAD_DIM)
    kb = jnp.concatenate([kp[:, o:o + nc] for o in range(LEFT_CHUNKS + 1)], axis=2)
    vb = jnp.concatenate([vp[:, o:o + nc] for o in range(LEFT_CHUNKS + 1)], axis=2)
    i = jnp.arange(CHUNK)[:, None]
    m = jnp.arange(BAND)[None, :]
    bias = rel_bias(rel_table, A_WINDOW + i - m)
    valid = (jnp.arange(nc)[:, None] - LEFT_CHUNKS + jnp.arange(BAND)[None, :] // CHUNK) >= 0
    sc = jnp.einsum('bcihd,bcmhd->bhcim', qc, kb).astype(jnp.float32) * ATTN_SCALE
    sc = sc + bias[None, :, None, :, :]
    sc = jnp.where(valid[None, None, :, None, :], sc, NEG_INF)
    p = jax.nn.softmax(sc, axis=-1).astype(v.dtype)
    o = jnp.einsum('bhcim,bcmhd->bcihd', p, vb)
    return o.reshape(b, s, N_HEADS, HEAD_DIM)


def chunk_attn_sample(q, k, v, cache_k, cache_v, rel_table):
    n_cache = cache_k.shape[1]
    L = q.shape[1]
    kk = jnp.concatenate([cache_k, k], axis=1)
    vv = jnp.concatenate([cache_v, v], axis=1)
    i = jnp.arange(L)[:, None]
    m = jnp.arange(n_cache + L)[None, :]
    bias = rel_bias(rel_table, n_cache + i - m)
    sc = jnp.einsum('bihd,bmhd->bhim', q, kk).astype(jnp.float32) * ATTN_SCALE + bias[None]
    p = jax.nn.softmax(sc, axis=-1).astype(v.dtype)
    return jnp.einsum('bhim,bmhd->bihd', p, vv)


def _fox_block(q_blk, cum_q, q_pos, k, v, cum_k, k_pos):
    sc = jnp.einsum('bqhd,bkhd->bhqk', q_blk, k).astype(jnp.float32) * ATTN_SCALE
    sc = sc + jnp.swapaxes(cum_q, 1, 2)[..., :, None] - jnp.swapaxes(cum_k, 1, 2)[..., None, :]
    sc = jnp.where(k_pos[None, :] <= q_pos[:, None], sc, NEG_INF)
    p = jax.nn.softmax(sc, axis=-1).astype(v.dtype)
    return jnp.einsum('bhqk,bkhd->bqhd', p, v)


def fox_prompt(q, k, v, log_f):
    b, s = q.shape[:2]
    nb = s // Q_BLOCK
    cum = jnp.cumsum(log_f, axis=1)
    pos = jnp.arange(s)
    qb = jnp.swapaxes(q.reshape(b, nb, Q_BLOCK, N_HEADS, HEAD_DIM), 0, 1)
    cb = jnp.swapaxes(cum.reshape(b, nb, Q_BLOCK, N_HEADS), 0, 1)
    pb = pos.reshape(nb, Q_BLOCK)
    out = lax.map(lambda a: _fox_block(a[0], a[1], a[2], k, v, cum, pos), (qb, cb, pb))
    return jnp.swapaxes(out, 0, 1).reshape(b, s, N_HEADS, HEAD_DIM)


def fox_sample(q, k, v, log_f, cache_k, cache_v, cache_log_f):
    past = cache_k.shape[1]
    L = q.shape[1]
    kk = jnp.concatenate([cache_k, k], axis=1)
    vv = jnp.concatenate([cache_v, v], axis=1)
    cum = jnp.cumsum(jnp.concatenate([cache_log_f.astype(jnp.float32), log_f], axis=1), axis=1)
    return _fox_block(q, cum[:, past:], past + jnp.arange(L), kk, vv, cum, jnp.arange(past + L))


def _stick_block(q_blk, q_pos, k, v, k_pos):
    z = jnp.einsum('bqhd,bkhd->bhqk', q_blk, k).astype(jnp.float32) * ATTN_SCALE
    earlier = k_pos[None, :] < q_pos[:, None]
    log_beta = jax.nn.log_sigmoid(z)
    log_keep = jnp.where(earlier, log_beta - z, 0.0)
    tail = lax.cumsum(log_keep, axis=3, reverse=True) - log_keep
    w = jnp.where(earlier, jnp.exp(log_beta + tail), 0.0)
    return jnp.einsum('bhqk,bkhd->bqhd', w.astype(v.dtype), v)


def stick_prompt(q, k, v):
    b, s = q.shape[:2]
    nb = s // Q_BLOCK
    pos = jnp.arange(s)
    qb = jnp.swapaxes(q.reshape(b, nb, Q_BLOCK, N_HEADS, HEAD_DIM), 0, 1)
    pb = pos.reshape(nb, Q_BLOCK)
    out = lax.map(lambda a: _stick_block(a[0], a[1], k, v, pos), (qb, pb))
    return jnp.swapaxes(out, 0, 1).reshape(b, s, N_HEADS, HEAD_DIM)


def stick_sample(q, k, v, cache_k, cache_v):
    past = cache_k.shape[1]
    L = q.shape[1]
    kk = jnp.concatenate([cache_k, k], axis=1)
    vv = jnp.concatenate([cache_v, v], axis=1)
    return _stick_block(q, past + jnp.arange(L), kk, vv, jnp.arange(past + L))


def setup_inputs(seed: int = 0) -> dict:
    key = jax.random.key(seed)
    ks = jax.random.split(key, 32)
    d = D_MODEL

    def nrm(k, shape, scale):
        return jax.random.normal(k, shape, jnp.float32) * scale

    def gain(k, shape):
        return 1.0 + 0.05 * jax.random.normal(k, shape, jnp.float32)

    return {
        'x_prompt': nrm(ks[0], (BATCH, SEQ, d), 1.0),
        'x_sample': nrm(ks[1], (DEC_BATCH, DEC_SEQ, d), 1.0),
        'cache_a_k': nrm(ks[2], (N_A, DEC_BATCH, A_CACHE, N_HEADS, HEAD_DIM), 1.0),
        'cache_a_v': nrm(ks[3], (N_A, DEC_BATCH, A_CACHE, N_HEADS, HEAD_DIM), 1.0),
        'cache_b_k': nrm(ks[4], (N_B, DEC_BATCH, PAST_LEN, N_HEADS, HEAD_DIM), 1.0),
        'cache_b_v': nrm(ks[5], (N_B, DEC_BATCH, PAST_LEN, N_HEADS, HEAD_DIM), 1.0),
        'cache_b_logf': jax.nn.log_sigmoid(FORGET_BIAS_INIT + nrm(ks[6], (N_B, DEC_BATCH, PAST_LEN, N_HEADS), 1.0)),
        'cache_c_k': nrm(ks[7], (N_C, DEC_BATCH, PAST_LEN, N_HEADS, HEAD_DIM), 1.0),
        'cache_c_v': nrm(ks[8], (N_C, DEC_BATCH, PAST_LEN, N_HEADS, HEAD_DIM), 1.0),
        'norm_ffn1': gain(ks[9], (DEPTH, d)),
        'ffn1_gate': nrm(ks[10], (DEPTH, d, D_FF), d ** -0.5),
        'ffn1_up': nrm(ks[11], (DEPTH, d, D_FF), d ** -0.5),
        'ffn1_down': nrm(ks[12], (DEPTH, D_FF, d), D_FF ** -0.5),
        'norm_mix': gain(ks[13], (DEPTH, d)),
        'norm_ffn2': gain(ks[14], (DEPTH, d)),
        'ffn2_gate': nrm(ks[15], (DEPTH, d, D_FF), d ** -0.5),
        'ffn2_up': nrm(ks[16], (DEPTH, d, D_FF), d ** -0.5),
        'ffn2_down': nrm(ks[17], (DEPTH, D_FF, d), D_FF ** -0.5),
        'a_w_qkv': nrm(ks[18], (N_A, d, 3 * d), d ** -0.5),
        'a_w_o': nrm(ks[19], (N_A, d, d), d ** -0.5),
        'a_rel_bias': nrm(ks[20], (N_A, N_REL, N_HEADS), 0.5),
        'b_w_qkv': nrm(ks[21], (N_B, d, 3 * d), d ** -0.5),
        'b_w_o': nrm(ks[22], (N_B, d, d), d ** -0.5),
        'b_w_f': nrm(ks[23], (N_B, d, N_HEADS), d ** -0.5),
        'b_b_f': FORGET_BIAS_INIT + nrm(ks[24], (N_B, N_HEADS), 0.1),
        'c_w_qkv': nrm(ks[25], (N_C, d, 3 * d), d ** -0.5),
        'c_w_o': nrm(ks[26], (N_C, d, d), d ** -0.5),
        'norm_final': gain(ks[27], (d,)),
    }


def reference(x_prompt, x_sample, cache_a_k, cache_a_v, cache_b_k, cache_b_v, cache_b_logf,
              cache_c_k, cache_c_v, norm_ffn1, ffn1_gate, ffn1_up, ffn1_down, norm_mix,
              norm_ffn2, ffn2_gate, ffn2_up, ffn2_down, a_w_qkv, a_w_o, a_rel_bias,
              b_w_qkv, b_w_o, b_w_f, b_b_f, c_w_qkv, c_w_o, norm_final):
    xp, xs = x_prompt, x_sample
    a_kp, a_vp, a_ks, a_vs = [], [], [], []
    b_kp, b_vp, b_fp, b_ks, b_vs, b_fs = [], [], [], [], [], []
    c_kp, c_vp, c_ks, c_vs = [], [], [], []
    for i in range(DEPTH):
        kind, slot = i % N_MIXERS, i // N_MIXERS
        xp = xp + 0.5 * swiglu(rms_norm(xp, norm_ffn1[i]), ffn1_gate[i], ffn1_up[i], ffn1_down[i])
        xs = xs + 0.5 * swiglu(rms_norm(xs, norm_ffn1[i]), ffn1_gate[i], ffn1_up[i], ffn1_down[i])
        hp = rms_norm(xp, norm_mix[i])
        hs = rms_norm(xs, norm_mix[i])
        if kind == 0:
            qp, kp, vp = project_qkv(hp, a_w_qkv[slot])
            qs, ks_, vs = project_qkv(hs, a_w_qkv[slot])
            op = chunk_attn_prompt(qp, kp, vp, a_rel_bias[slot])
            os_ = chunk_attn_sample(qs, ks_, vs, cache_a_k[slot], cache_a_v[slot], a_rel_bias[slot])
            a_kp.append(kp[:, kp.shape[1] - A_KEEP:])
            a_vp.append(vp[:, vp.shape[1] - A_KEEP:])
            a_ks.append(ks_)
            a_vs.append(vs)
            w_o = a_w_o[slot]
        elif kind == 1:
            qp, kp, vp = project_qkv(hp, b_w_qkv[slot])
            qs, ks_, vs = project_qkv(hs, b_w_qkv[slot])
            fp = jax.nn.log_sigmoid((hp @ b_w_f[slot] + b_b_f[slot]).astype(jnp.float32))
            fs = jax.nn.log_sigmoid((hs @ b_w_f[slot] + b_b_f[slot]).astype(jnp.float32))
            op = fox_prompt(qp, kp, vp, fp)
            os_ = fox_sample(qs, ks_, vs, fs, cache_b_k[slot], cache_b_v[slot], cache_b_logf[slot])
            b_kp.append(kp)
            b_vp.append(vp)
            b_fp.append(fp)
            b_ks.append(ks_)
            b_vs.append(vs)
            b_fs.append(fs)
            w_o = b_w_o[slot]
        else:
            qp, kp, vp = project_qkv(hp, c_w_qkv[slot])
            qs, ks_, vs = project_qkv(hs, c_w_qkv[slot])
            op = stick_prompt(qp, kp, vp)
            os_ = stick_sample(qs, ks_, vs, cache_c_k[slot], cache_c_v[slot])
            c_kp.append(kp)
            c_vp.append(vp)
            c_ks.append(ks_)
            c_vs.append(vs)
            w_o = c_w_o[slot]
        xp = xp + op.reshape(xp.shape) @ w_o
        xs = xs + os_.reshape(xs.shape) @ w_o
        xp = xp + 0.5 * swiglu(rms_norm(xp, norm_ffn2[i]), ffn2_gate[i], ffn2_up[i], ffn2_down[i])
        xs = xs + 0.5 * swiglu(rms_norm(xs, norm_ffn2[i]), ffn2_gate[i], ffn2_up[i], ffn2_down[i])
    y_prompt = rms_norm(xp, norm_final)
    y_sample = rms_norm(xs, norm_final)
    return (y_prompt, y_sample,
            jnp.stack(a_kp), jnp.stack(a_vp), jnp.stack(a_ks), jnp.stack(a_vs),
            jnp.stack(b_kp), jnp.stack(b_vp), jnp.stack(b_fp),
            jnp.stack(b_ks), jnp.stack(b_vs), jnp.stack(b_fs),
            jnp.stack(c_kp), jnp.stack(c_vp), jnp.stack(c_ks), jnp.stack(c_vs))
```

```cpp
#include <hip/hip_runtime.h>
#include <cstdio>
#include <cstdint>
namespace pg8 {
#define PG8_LAS __attribute__((address_space(3)))
typedef unsigned short bf16_t;
typedef short bf16x8 __attribute__((ext_vector_type(8)));
typedef float f32x4 __attribute__((ext_vector_type(4)));
typedef unsigned u32x4 __attribute__((ext_vector_type(4)));
constexpr int BM = 256, BK = 64, HALF = 128, HTB = HALF * BK * 2  , STAGE_BYTES = 8 * HTB, NXCD = 8, WGM = 4;

__host__ __device__ __forceinline__ int lds_byte(int r, int c) { const int st = (r >> 4) * 2 + (c >> 5), rr = r & 15, cc = c & 31, ob = rr * 64 + cc * 2; return st * 1024 + (ob ^ (((ob >> 9) & 1) << 5)); }
__host__ __device__ __forceinline__ void stage_rc(int b, int& R, int& C) { const int st = b / 1024, sb = b % 1024, swz = sb ^ (((sb >> 9) & 1) << 5); R = (st >> 1) * 16 + swz / 64; C = (st & 1) * 32 + (swz % 64) / 2; }
__host__ __device__ __forceinline__ int perm32(int rho) { const int n = rho >> 4, i = rho & 15; return 8 * (i >> 2) + 4 * n + (i & 3); }

struct Unit { int pm, pn; };
struct Gemm { const bf16_t* A; const bf16_t* Bt; int M, N, K; };

struct StaticOrder {
    int nM, nN, nwg, G, c;
    __host__ __device__ void init(int M, int N, int G_, int c_) { nM = M / BM; nN = N / BM; nwg = nM * nN; G = G_; c = c_; }
    __host__ __device__ bool next(int i, Unit& u) const {
        const long L = (long)i * G + c; if (L >= nwg) return false;
        int wgid = (int)L; { const int q = nwg / NXCD, r = nwg % NXCD, xcd = wgid % NXCD, off = wgid / NXCD; wgid = (xcd < r ? xcd * (q + 1) : r * (q + 1) + (xcd - r) * q) + off; }
        const int nig = WGM * nN, gid = wgid / nig, fm = gid * WGM, gsz = (nM - fm) < WGM ? (nM - fm) : WGM;
        u.pm = fm + ((wgid % nig) % gsz); u.pn = (wgid % nig) / gsz; return true;
    }
    __device__ __forceinline__ void a_ready(const Unit&) const {}
    __device__ __forceinline__ void done(const Unit&) const {}
};

__device__ __forceinline__ unsigned cvt_pk_bf16(float lo, float hi) { unsigned r; asm volatile("v_cvt_pk_bf16_f32 %0, %1, %2" : "=v"(r) : "v"(lo), "v"(hi)); return r; }
typedef float f32x2 __attribute__((ext_vector_type(2)));
typedef unsigned u32x2 __attribute__((ext_vector_type(2)));
typedef __bf16 bf16x2_t __attribute__((ext_vector_type(2)));
__device__ __forceinline__ unsigned pkbf(float lo, float hi) { f32x2 v = {lo, hi}; bf16x2_t b = __builtin_convertvector(v, bf16x2_t); return __builtin_bit_cast(unsigned, b); }

__device__ __forceinline__ float xor16_f(float v) { return __builtin_bit_cast(float, __builtin_amdgcn_ds_swizzle(__builtin_bit_cast(int, v), 0x401F)); }
__device__ __forceinline__ float sum_xor32(float v) { const unsigned a = __builtin_bit_cast(unsigned, v); auto r = __builtin_amdgcn_permlane32_swap(a, a, false, false);
    const unsigned r0 = r[0], r1 = r[1]; return __builtin_bit_cast(float, r0) + __builtin_bit_cast(float, r1); }
template <int CTRL> __device__ __forceinline__ float dpp_f(float v) { return __builtin_bit_cast(float, __builtin_amdgcn_update_dpp(0, __builtin_bit_cast(int, v), CTRL, 0xF, 0xF, true)); }
__device__ __forceinline__ float sum_row16(float v) { v += dpp_f<0x128>(v); v += dpp_f<0x124>(v); v += dpp_f<0x122>(v); v += dpp_f<0x121>(v); return v; }
__device__ __forceinline__ float sum_quad(float v) { v += dpp_f<0xB1>(v); v += dpp_f<0x4E>(v); return v; }
__device__ __forceinline__ float row_scale(const float* SS, int row) {
    const f32x4* p = (const f32x4*)(SS + (size_t)row * 16); const f32x4 a = p[0], b = p[1], c = p[2], d = p[3];
    const float s = ((a.x + a.y) + (a.z + a.w)) + ((b.x + b.y) + (b.z + b.w)) + ((c.x + c.y) + (c.z + c.w)) + ((d.x + d.y) + (d.z + d.w));
    return __builtin_amdgcn_rsqf(s * (1.0f / 1024.0f) + 1e-6f);
}
__device__ __forceinline__ void row_scales8(const float* SS, int row0, int fq, float (&rs)[2][4]) {
    f32x4 t[2][4];
#pragma unroll
    for (int ai = 0; ai < 2; ++ai)
#pragma unroll
        for (int m = 0; m < 4; ++m) t[ai][m] = *(const f32x4*)(SS + (size_t)(row0 + ai * HALF + m * 16) * 16 + 4 * fq);
#pragma unroll
    for (int ai = 0; ai < 2; ++ai)
#pragma unroll
        for (int m = 0; m < 4; ++m) { float s = (t[ai][m].x + t[ai][m].y) + (t[ai][m].z + t[ai][m].w); s += xor16_f(s); s = sum_xor32(s); rs[ai][m] = __builtin_amdgcn_rsqf(s * (1.0f / 1024.0f) + 1e-6f); }
}
__device__ __forceinline__ void row_scales8_ms(const float* SS, int row0, int fq, float (&rs)[2][4], float (&ms)[2][4]) {
    f32x4 t[2][4];
#pragma unroll
    for (int ai = 0; ai < 2; ++ai)
#pragma unroll
        for (int m = 0; m < 4; ++m) t[ai][m] = *(const f32x4*)(SS + (size_t)(row0 + ai * HALF + m * 16) * 16 + 4 * fq);
#pragma unroll
    for (int ai = 0; ai < 2; ++ai)
#pragma unroll
        for (int m = 0; m < 4; ++m) { float s = (t[ai][m].x + t[ai][m].y) + (t[ai][m].z + t[ai][m].w); s += xor16_f(s); s = sum_xor32(s); ms[ai][m] = s * (1.0f / 1024.0f) + 1e-6f; rs[ai][m] = __builtin_amdgcn_rsqf(ms[ai][m]); }
}
template <class Sched>
__device__ __forceinline__ void ms_prepass(PG8_LAS float* msl, const Sched& S, const float* SS, int tid) {
    f32x4 t[3][4]; bool ok[3]; Unit u;
#pragma unroll
    for (int k = 0; k < 3; ++k) { const int idx = tid + 512 * k; ok[k] = S.next(idx >> 8, u);
        if (ok[k]) { const f32x4* p = (const f32x4*)(SS + (size_t)(u.pm * BM + (idx & 255)) * 16); t[k][0] = p[0]; t[k][1] = p[1]; t[k][2] = p[2]; t[k][3] = p[3]; } }
#pragma unroll
    for (int k = 0; k < 3; ++k) if (ok[k]) { const f32x4 a = t[k][0], b = t[k][1], c = t[k][2], d = t[k][3];
        const float s = ((a.x + a.y) + (a.z + a.w)) + ((b.x + b.y) + (b.z + b.w)) + ((c.x + c.y) + (c.z + c.w)) + ((d.x + d.y) + (d.z + d.w));
        msl[tid + 512 * k] = s * (1.0f / 1024.0f) + 1e-6f; }
    asm volatile("s_waitcnt lgkmcnt(0)" ::: "memory"); __builtin_amdgcn_s_barrier();
}
struct EpiSwiGLU {
    static constexpr bool PERM = true, AFTER_DRAIN = false;
    bf16_t* act; int ldc; PG8_LAS float* msl; int mp; mutable int ord; const float* SS;
    template <class Sched> __device__ __forceinline__ void begin(const Sched& S, int tid) const { ms_prepass(msl, S, SS, tid); }
    __device__ __forceinline__ void operator()(const f32x4 (&acc)[2][2][4][2], const Unit& u, int wr, int wc, int fr, int fq) const {
        const int row0 = u.pm * BM + wr * 64 + fr, col0 = u.pn * HALF + wc * 32 + 8 * fq;
        const PG8_LAS float* mq = msl + ord * 256 + wr * 64 + fr; ++ord;
        float rsv[2][4], msv[2][4];
#pragma unroll
        for (int ai = 0; ai < 2; ++ai)
#pragma unroll
            for (int m = 0; m < 4; ++m) { msv[ai][m] = mq[ai * HALF + m * 16]; rsv[ai][m] = __builtin_amdgcn_rsqf(msv[ai][m]); }
#pragma unroll
        for (int ai = 0; ai < 2; ++ai)
#pragma unroll
            for (int m = 0; m < 4; ++m) {
                const int row = row0 + ai * HALF + m * 16; const float ms = msv[ai][m], ce = -1.4426950408889634f * rsv[ai][m];
                bf16_t* rowp = (u.pm * BM >= mp) ? act + (size_t)mp * ldc + ((size_t)((row - mp) >> 4) * (ldc >> 5) + (col0 >> 5)) * 512 + (fq * 16 + fr) * 8 : act + (size_t)row * ldc + col0;
                float o[8];
#pragma unroll
                for (int n = 0; n < 2; ++n)
#pragma unroll
                    for (int e = 0; e < 4; ++e) { const float g = acc[ai][0][m][n][e], up = acc[ai][1][m][n][e];
                        const float t = __builtin_amdgcn_exp2f(g * ce); const float s = __builtin_amdgcn_rcpf(__builtin_fmaf(t, ms, ms)); o[n * 4 + e] = (g * up) * s; }
                u32x4 w; w.x = pkbf(o[0], o[1]); w.y = pkbf(o[2], o[3]); w.z = pkbf(o[4], o[5]); w.w = pkbf(o[6], o[7]);
                *(u32x4*)rowp = w; }
    }
};
__device__ __forceinline__ float bflo(unsigned w) { return __builtin_bit_cast(float, w << 16); }
__device__ __forceinline__ float bfhi(unsigned w) { return __builtin_bit_cast(float, w & 0xffff0000u); }
struct EpiResid {
    static constexpr bool PERM = true, AFTER_DRAIN = false;
    bf16_t* xb; float* SS; float c;
    template <class Sched> __device__ __forceinline__ void begin(const Sched&, int) const {}
    __device__ __forceinline__ void operator()(const f32x4 (&acc)[2][2][4][2], const Unit& u, int wr, int wc, int fr, int fq) const {
        const int row0 = u.pm * BM + wr * 64 + fr, col0 = u.pn * BM + wc * 32 + 8 * fq;
        u32x4 in[2][4][2];
#pragma unroll
        for (int ai = 0; ai < 2; ++ai)
#pragma unroll
            for (int m = 0; m < 4; ++m)
#pragma unroll
                for (int bj = 0; bj < 2; ++bj) in[ai][m][bj] = *(const u32x4*)(xb + (size_t)(row0 + ai * HALF + m * 16) * 1024 + col0 + bj * HALF);
        asm volatile("" ::: "memory");
#pragma unroll
        for (int ai = 0; ai < 2; ++ai)
#pragma unroll
            for (int m = 0; m < 4; ++m) { const int row = row0 + ai * HALF + m * 16; bf16_t* p = xb + (size_t)row * 1024 + col0; float ss = 0.f;
#pragma unroll
                for (int bj = 0; bj < 2; ++bj) { const u32x4 iv = in[ai][m][bj]; const f32x4 a0 = acc[ai][bj][m][0], a1 = acc[ai][bj][m][1];
                    const float x0 = __builtin_fmaf(a0[0], c, bflo(iv.x)), x1 = __builtin_fmaf(a0[1], c, bfhi(iv.x)), x2 = __builtin_fmaf(a0[2], c, bflo(iv.y)), x3 = __builtin_fmaf(a0[3], c, bfhi(iv.y));
                    const float x4 = __builtin_fmaf(a1[0], c, bflo(iv.z)), x5 = __builtin_fmaf(a1[1], c, bfhi(iv.z)), x6 = __builtin_fmaf(a1[2], c, bflo(iv.w)), x7 = __builtin_fmaf(a1[3], c, bfhi(iv.w));
                    u32x4 w; w.x = pkbf(x0, x1); w.y = pkbf(x2, x3); w.z = pkbf(x4, x5); w.w = pkbf(x6, x7);
                    *(u32x4*)(p + bj * HALF) = w;
                    ss += ((x0 * x0 + x1 * x1) + (x2 * x2 + x3 * x3)) + ((x4 * x4 + x5 * x5) + (x6 * x6 + x7 * x7)); }
                ss += xor16_f(ss); ss = sum_xor32(ss);
                if (fq == 0) SS[(size_t)row * 16 + u.pn * 4 + wc] = ss; }
    }
};
struct EpiQKV {
    static constexpr bool PERM = true, AFTER_DRAIN = false;
    bf16_t* qkv; size_t tstride; float qscale;
    PG8_LAS float* msl; mutable int ord; const float* SS;
    template <class Sched> __device__ __forceinline__ void begin(const Sched& S, int tid) const { ms_prepass(msl, S, SS, tid); }
    __device__ __forceinline__ void operator()(const f32x4 (&acc)[2][2][4][2], const Unit& u, int wr, int wc, int fr, int fq) const {
        typedef __attribute__((address_space(1))) unsigned char gbyte;
        const int t = u.pn >> 2; const int colt = (u.pn & 3) * BM;
        gbyte* bb = (gbyte*)(qkv + (size_t)t * tstride + (size_t)u.pm * BM * 1024); const float sc = (t == 0) ? qscale : 1.0f;
        const PG8_LAS float* mq = msl + ord * 256 + wr * 64 + fr; ++ord;
        float rsv[2][4];
#pragma unroll
        for (int ai = 0; ai < 2; ++ai)
#pragma unroll
            for (int m = 0; m < 4; ++m) rsv[ai][m] = __builtin_amdgcn_rsqf(mq[ai * HALF + m * 16]);
        const unsigned loff = (unsigned)((wr * 64 + fr) * 1024 + colt + wc * 32 + 8 * fq);
#pragma unroll
        for (int ai = 0; ai < 2; ++ai)
#pragma unroll
            for (int m = 0; m < 4; ++m) { const unsigned o = loff + (unsigned)((ai * HALF + m * 16) * 1024); const float rs = rsv[ai][m], scq = sc * rs;
#pragma unroll
                for (int bj = 0; bj < 2; ++bj) { const f32x4 v0 = acc[ai][bj][m][0] * scq, v1 = acc[ai][bj][m][1] * scq;
                    u32x4 w; w.x = pkbf(v0[0], v0[1]); w.y = pkbf(v0[2], v0[3]); w.z = pkbf(v1[0], v1[1]); w.w = pkbf(v1[2], v1[3]);
                    *(__attribute__((address_space(1))) u32x4*)(bb + (size_t)(o + bj * HALF) * 2) = w;
                }
                if (m & 1) asm volatile("" ::: "memory"); }
    }
};
template <class Epi, class Sched, bool ALIGN_EPI = false, bool SP2 = false>
__device__ __forceinline__ void gemm_phase(PG8_LAS unsigned char* lds, const Gemm g, const Sched& S, const Epi& E, const int wv) {
    int lane; asm volatile("v_mbcnt_lo_u32_b32 %0, -1, 0\n\tv_mbcnt_hi_u32_b32 %0, -1, %0" : "=v"(lane)); int wid = wv; asm volatile("" : "+s"(wid)); const int tid = wid * 64 + lane, wr = wid >> 2, wc = wid & 3, fr = lane & 15, fq = lane >> 4;
    const int K = g.K, nt = K / BK;
    unsigned voffA[2], voffB[2];
#pragma unroll
    for (int i = 0; i < 2; ++i) { int R, C; stage_rc(tid * 16 + i * 8192, R, C); const int Rb = Epi::PERM ? ((R & ~31) + perm32(R & 31)) : R;
        voffA[i] = (unsigned)(R * K + C) * 2u; voffB[i] = (unsigned)(Rb * K + C) * 2u; }
    const size_t kstep = (size_t)(BK * 2);
    const size_t hstep = (size_t)HALF * K * 2;
    const size_t tstep = 2 * hstep;
    const unsigned ldsw = (unsigned)wid * 1024u;
    const int aoff = lds_byte(wr * 64 + fr, fq * 8), boff = lds_byte(wc * 32 + fr, fq * 8);
#define PG8_SA(b, h) (((b) * 2 + (h)) * HTB)
#define PG8_SB(b, h) ((4 + (b) * 2 + (h)) * HTB)
#define PG8_STAGE(bufoff, gbase, voff) do { _Pragma("unroll") for (int _i = 0; _i < 2; ++_i) \
        __builtin_amdgcn_global_load_lds((const unsigned*)((const char*)(gbase) + (voff)[_i]), (PG8_LAS unsigned*)(lds + (bufoff) + ldsw + _i * 8192), 16, 0, 0); } while (0)
#define PG8_LDA(dst, b, h) do { _Pragma("unroll") for (int m = 0; m < 4; ++m) _Pragma("unroll") for (int k = 0; k < 2; ++k) dst[m][k] = *(const PG8_LAS bf16x8*)(lds + PG8_SA(b, h) + aoff + m * 2048 + k * 1024); } while (0)
#define PG8_LDB(dst, b, h) do { _Pragma("unroll") for (int n = 0; n < 2; ++n) _Pragma("unroll") for (int k = 0; k < 2; ++k) dst[n][k] = *(const PG8_LAS bf16x8*)(lds + PG8_SB(b, h) + boff + n * 2048 + k * 1024); } while (0)
#define PG8_MMA(ai, bj, At, Bt) do { __builtin_amdgcn_s_setprio(1); _Pragma("unroll") for (int m = 0; m < 4; ++m) _Pragma("unroll") for (int n = 0; n < 2; ++n) _Pragma("unroll") for (int k = 0; k < 2; ++k) \
        acc[ai][bj][m][n] = __builtin_amdgcn_mfma_f32_16x16x32_bf16(Bt[n][k], At[m][k], acc[ai][bj][m][n], 0, 0, 0); __builtin_amdgcn_s_setprio(0); } while (0)
#define PG8_WAIT_V(n) asm volatile("s_waitcnt vmcnt(" #n ")" ::: "memory")
#define PG8_WAIT_L(n) asm volatile("s_waitcnt lgkmcnt(" #n ")" ::: "memory")
#define PG8_BAR __builtin_amdgcn_s_barrier()
#define PG8_SCHED __builtin_amdgcn_sched_barrier(0)
    Unit cur, nxt; int ui = 0;
    if (!S.next(0, cur)) return;
    f32x4 acc[2][2][4][2];
#pragma unroll
    for (int a = 0; a < 2; ++a)
#pragma unroll
        for (int b = 0; b < 2; ++b)
#pragma unroll
            for (int m = 0; m < 4; ++m)
#pragma unroll
                for (int n = 0; n < 2; ++n) acc[a][b][m][n] = (f32x4){0.f, 0.f, 0.f, 0.f};
    bf16x8 At[4][2], B0[2][2], B1[2][2];
    const char* cA = (const char*)g.A + (size_t)cur.pm * tstep; const char* cB = (const char*)g.Bt + (size_t)cur.pn * tstep;
    S.a_ready(cur);
    if constexpr (SP2) {
        PG8_STAGE(PG8_SB(0, 0), cB, voffB); PG8_STAGE(PG8_SB(0, 1), cB + hstep, voffB); PG8_STAGE(PG8_SA(0, 0), cA, voffA); PG8_STAGE(PG8_SA(0, 1), cA + hstep, voffA);
        E.begin(S, tid);
        if (wr == 1) PG8_BAR;
        PG8_WAIT_V(2); PG8_BAR;
        PG8_STAGE(PG8_SB(1, 0), cB + kstep, voffB); PG8_STAGE(PG8_SA(1, 0), cA + kstep, voffA); PG8_STAGE(PG8_SB(1, 1), cB + hstep + kstep, voffB);
        PG8_WAIT_V(6); PG8_BAR;
    } else {
        PG8_STAGE(PG8_SB(0, 0), cB, voffB); PG8_STAGE(PG8_SA(0, 0), cA, voffA); PG8_STAGE(PG8_SB(0, 1), cB + hstep, voffB); PG8_STAGE(PG8_SA(0, 1), cA + hstep, voffA);
        if (wr == 1) PG8_BAR;
        PG8_WAIT_V(4); PG8_BAR;
        PG8_STAGE(PG8_SB(1, 0), cB + kstep, voffB); PG8_STAGE(PG8_SA(1, 0), cA + kstep, voffA); PG8_STAGE(PG8_SB(1, 1), cB + hstep + kstep, voffB);
        PG8_WAIT_V(6); PG8_BAR;
    }
    for (;;) {
        const bool has_next = S.next(ui + 1, nxt);
        const char* nA = has_next ? (const char*)g.A + (size_t)nxt.pm * tstep : cA; const char* nB = has_next ? (const char*)g.Bt + (size_t)nxt.pn * tstep : cB;
        for (int t = 0; t < nt; t += 2) {
            const bool last = (t == nt - 2);
            const char* a1 = cA + (size_t)(t + 1) * kstep;
            const char* a2 = last ? nA : cA + (size_t)(t + 2) * kstep; const char* b2 = last ? nB : cB + (size_t)(t + 2) * kstep;
            const char* a3 = a2 + kstep; const char* b3 = b2 + kstep;
            if (last && has_next) S.a_ready(nxt);
            if constexpr (SP2) {
            PG8_LDB(B0, 0, 0); PG8_LDB(B1, 0, 1); PG8_SCHED; PG8_LDA(At, 0, 0); PG8_STAGE(PG8_SA(1, 1), a1 + hstep, voffA);
            PG8_WAIT_V(8); PG8_WAIT_L(0); PG8_BAR; PG8_MMA(0, 0, At, B0); PG8_MMA(0, 1, At, B1); PG8_BAR; PG8_SCHED;
            PG8_LDA(At, 0, 1); PG8_STAGE(PG8_SB(0, 0), b2, voffB); PG8_STAGE(PG8_SB(0, 1), b2 + hstep, voffB); PG8_STAGE(PG8_SA(0, 0), a2, voffA);
            PG8_WAIT_V(8); PG8_WAIT_L(0); PG8_BAR; PG8_MMA(1, 0, At, B0); PG8_MMA(1, 1, At, B1); PG8_BAR; PG8_SCHED;
            PG8_LDB(B0, 1, 0); PG8_LDB(B1, 1, 1); PG8_SCHED; PG8_LDA(At, 1, 0); PG8_STAGE(PG8_SA(0, 1), a2 + hstep, voffA);
            PG8_WAIT_V(8); PG8_WAIT_L(0); PG8_BAR; PG8_MMA(0, 0, At, B0); PG8_MMA(0, 1, At, B1); PG8_BAR; PG8_SCHED;
            PG8_LDA(At, 1, 1); PG8_STAGE(PG8_SB(1, 0), b3, voffB); PG8_STAGE(PG8_SB(1, 1), b3 + hstep, voffB); PG8_STAGE(PG8_SA(1, 0), a3, voffA);
            PG8_WAIT_V(8); PG8_WAIT_L(0); PG8_BAR; PG8_MMA(1, 0, At, B0); PG8_MMA(1, 1, At, B1); PG8_BAR; PG8_SCHED;
            } else {
            PG8_LDB(B0, 0, 0); PG8_SCHED; PG8_LDA(At, 0, 0); PG8_STAGE(PG8_SA(1, 1), a1 + hstep, voffA);
            PG8_WAIT_L(8); PG8_BAR; PG8_WAIT_L(0); PG8_MMA(0, 0, At, B0); PG8_BAR; PG8_SCHED;
            PG8_LDB(B1, 0, 1); PG8_STAGE(PG8_SB(0, 0), b2, voffB);
            PG8_BAR; PG8_WAIT_L(0); PG8_MMA(0, 1, At, B1); PG8_BAR;
            PG8_LDA(At, 0, 1); PG8_STAGE(PG8_SA(0, 0), a2, voffA);
            PG8_BAR; PG8_WAIT_L(0); PG8_MMA(1, 0, At, B0); PG8_BAR; PG8_SCHED;
            PG8_STAGE(PG8_SB(0, 1), b2 + hstep, voffB);
            PG8_WAIT_V(6); PG8_BAR; PG8_MMA(1, 1, At, B1); PG8_BAR;
            PG8_LDB(B0, 1, 0); PG8_SCHED; PG8_LDA(At, 1, 0); PG8_STAGE(PG8_SA(0, 1), a2 + hstep, voffA);
            PG8_WAIT_L(8); PG8_BAR; PG8_WAIT_L(0); PG8_MMA(0, 0, At, B0); PG8_BAR; PG8_SCHED;
            PG8_LDB(B1, 1, 1); PG8_STAGE(PG8_SB(1, 0), b3, voffB);
            PG8_BAR; PG8_WAIT_L(0); PG8_MMA(0, 1, At, B1); PG8_BAR;
            PG8_LDA(At, 1, 1); PG8_STAGE(PG8_SA(1, 0), a3, voffA);
            PG8_BAR; PG8_WAIT_L(0); PG8_MMA(1, 0, At, B0); PG8_BAR; PG8_SCHED;
            PG8_STAGE(PG8_SB(1, 1), b3 + hstep, voffB);
            PG8_WAIT_V(6); PG8_BAR; PG8_MMA(1, 1, At, B1); PG8_BAR;
            }
        }
        if constexpr (ALIGN_EPI) { if (wr == 0) PG8_BAR; }
        if constexpr (!Epi::AFTER_DRAIN) { E(acc, cur, wr, wc, fr, fq); S.done(cur); }
        if (!has_next) break;
#pragma unroll
        for (int a = 0; a < 2; ++a)
#pragma unroll
            for (int b = 0; b < 2; ++b)
#pragma unroll
                for (int m = 0; m < 4; ++m)
#pragma unroll
                    for (int n = 0; n < 2; ++n) acc[a][b][m][n] = (f32x4){0.f, 0.f, 0.f, 0.f};
        cur = nxt; cA = nA; cB = nB; ++ui;
        if constexpr (ALIGN_EPI) { if (wr == 1) PG8_BAR; }
    }
    PG8_WAIT_V(0);
    if constexpr (!ALIGN_EPI) { if (wr == 0) PG8_BAR; }
    PG8_BAR;
    if constexpr (Epi::AFTER_DRAIN) { E.fused(acc, cur, wr, wc, fr, fq, lds, wid, lane); S.done(cur); }
#undef PG8_SA
#undef PG8_SB
#undef PG8_STAGE
#undef PG8_LDA
#undef PG8_LDB
#undef PG8_MMA
#undef PG8_WAIT_V
#undef PG8_WAIT_L
#undef PG8_BAR
#undef PG8_SCHED
}
}
using pg8::bf16_t; using pg8::bf16x8; using pg8::f32x4; using pg8::u32x4; using pg8::pkbf;
typedef float f32x16 __attribute__((ext_vector_type(16)));
typedef short s16x4 __attribute__((ext_vector_type(4)));
typedef short v4i16_t __attribute__((ext_vector_type(4)));
typedef unsigned u32x2 __attribute__((ext_vector_type(2)));

constexpr int DM = 1024, NH = 16, HD = 64, FF = 2816, SEQ = 2048, NB = 8, DB = 32, DS = 16, PAST = 1024, ACACHE = 512, AKEEP = 512, DEPTH = 4;
constexpr int MP = NB * SEQ, MS = DB * DS, M = MP + MS;
constexpr int NREL = 513, TBLP = 520;
constexpr float RMS_EPS = 1e-6f, LOG2E = 1.4426950408889634f, QSCALE = 0.125f * 1.4426950408889634f;
constexpr int NWAVES = 8;
constexpr size_t O_YP = 0, O_YS = O_YP + (size_t)MP * DM, O_AKP = O_YS + (size_t)MS * DM, O_AVP = O_AKP + (size_t)2 * NB * AKEEP * DM, O_AKS = O_AVP + (size_t)2 * NB * AKEEP * DM,
    O_AVS = O_AKS + (size_t)2 * MS * DM, O_BKP = O_AVS + (size_t)2 * MS * DM, O_BVP = O_BKP + (size_t)MP * DM, O_BFP = O_BVP + (size_t)MP * DM, O_BKS = O_BFP + (size_t)MP * NH,
    O_BVS = O_BKS + (size_t)MS * DM, O_BFS = O_BVS + (size_t)MS * DM, O_CKP = O_BFS + (size_t)MS * NH, O_CVP = O_CKP + (size_t)MP * DM, O_CKS = O_CVP + (size_t)MP * DM,
    O_CVS = O_CKS + (size_t)MS * DM, O_END = O_CVS + (size_t)MS * DM;
constexpr size_t MiB = 1u << 20;
constexpr size_t WS_CTL = 0, CTL_ZERO_BYTES = 1 * MiB;
constexpr size_t W_GU = (size_t)2 * FF * DM * 2, W_DN = (size_t)DM * FF * 2, W_QKV = (size_t)3 * DM * DM * 2, W_WO = (size_t)DM * DM * 2;
constexpr size_t WL_GU1 = 0, WL_DN1 = WL_GU1 + W_GU, WL_QKV = WL_DN1 + W_DN, WL_WO = WL_QKV + W_QKV, WL_GU2 = WL_WO + W_WO, WL_DN2 = WL_GU2 + W_GU,
    WL_DN1F = WL_DN2 + W_DN, WL_DN2F = WL_DN1F + W_DN, WL_QKVF = WL_DN2F + W_DN, WL_WOF = WL_QKVF + W_QKV, WL_SIZE = WL_WOF + W_WO;
constexpr int WSLOTS = 2;
constexpr size_t WS_W = 1 * MiB;
constexpr size_t WS_HB = WS_W + WSLOTS * WL_SIZE;
constexpr size_t WS_ACT = WS_HB + (size_t)M * DM * 2;
constexpr size_t WS_QKV = WS_ACT + (size_t)M * FF * 2;
constexpr size_t QKV_T = (size_t)(M + 64) * DM;
constexpr size_t WS_O = WS_QKV + 3 * QKV_T * 2;
constexpr size_t WS_CUMP = WS_O + (size_t)M * DM * 2;
constexpr size_t WS_CUMS = WS_CUMP + (size_t)128 * SEQ * 4;
constexpr size_t WS_TBL = WS_CUMS + (size_t)512 * 1088 * 4;
constexpr size_t WS_SS = WS_TBL + (size_t)2 * 16 * TBLP * 4;
constexpr size_t WS_WFB = WS_SS + (size_t)M * 16 * 4;
constexpr size_t WS_XBF = WS_WFB + (size_t)NH * DM * 2;
constexpr size_t WS_END = WS_XBF + (size_t)MS * DM * 2;
static_assert(WS_W % 256 == 0 && WL_SIZE % 256 == 0 && WS_HB % 256 == 0 && WS_ACT % 256 == 0 && WS_QKV % 256 == 0 && WS_O % 256 == 0 && WS_CUMP % 256 == 0 && WS_CUMS % 256 == 0 && WS_TBL % 256 == 0 && WS_SS % 256 == 0 && WS_WFB % 256 == 0, "ws alignment");
constexpr int CW_BAR = 4096, CW_Q = 8192;
constexpr size_t WS_PTRS = 512 * 1024;
constexpr int RING_BYTES = 131072, MISC_OFF = RING_BYTES + 320, LDS_BYTES = 147456, MSL_OFF = RING_BYTES + 1024;
static_assert(MSL_OFF + 6 * 256 * 4 <= LDS_BYTES, "LDS map");
constexpr int KROWB = 144, KTILE = 64 * KROWB, VROWB = 192, VTILE = 64 * VROWB;

__device__ __forceinline__ size_t frag_off(int row, int k, int K) { return ((size_t)(row >> 4) * (K >> 5) + (k >> 5)) * 512 + ((((k & 31) >> 3) * 16 + (row & 15)) * 8 + (k & 7)); }
#define GAS __attribute__((address_space(1)))
#define LAS __attribute__((address_space(3)))
#define LDS_WAIT() asm volatile("s_waitcnt lgkmcnt(0)" ::: "memory")
#define XB_TMO      128
#define XB_XCNT(j)  (256  + 64 * (j))
#define XB_XSUB(j)  (1280 + 64 * (j))
#define XB_XGEN(j)  (2304 + 64 * (j))
#define XB_TOP      3328
#define XB_TOPGEN   3392
#define XCD_BAR_WORDS 3456
#define XB_SPIN_CAP (1u << 18)

__device__ __forceinline__ unsigned xb_ld(unsigned* p)              { return __hip_atomic_load(p, __ATOMIC_RELAXED, __HIP_MEMORY_SCOPE_AGENT); }
__device__ __forceinline__ unsigned xb_add(unsigned* p, unsigned v) { return __hip_atomic_fetch_add(p, v, __ATOMIC_RELAXED, __HIP_MEMORY_SCOPE_AGENT); }
__device__ __forceinline__ unsigned xb_xcc_id() { return (unsigned)__builtin_amdgcn_s_getreg((3 << 11) | 20) & 0xFu; }
#define XB_SPIN(cond, bar) do { unsigned _sp = 0; while (cond) { __builtin_amdgcn_s_sleep(1); \
    if ((++_sp & 255u) == 0u) { if (xb_ld(&(bar)[XB_TMO])) break; if (_sp > XB_SPIN_CAP) { atomicAdd(&(bar)[XB_TMO], 1u); break; } } } } while (0)

struct XcdBarrier {
    unsigned* bar; unsigned x;
    volatile LAS unsigned* st;
};

__device__ __forceinline__ XcdBarrier xcd_barrier_post(unsigned* bar, volatile LAS unsigned* st) {
    XcdBarrier b; b.bar = bar; b.x = xb_xcc_id(); b.st = st;
    if (threadIdx.x == 0) (void)xb_add(&bar[XB_XCNT(b.x)], 1u);
    return b;
}
__device__ __forceinline__ void xcd_barrier_complete(unsigned* bar, unsigned x, unsigned& nloc, unsigned& nx) {
    const unsigned G = gridDim.x * gridDim.y * gridDim.z;
    unsigned sum, cnt, mine, sp = 0u;
    for (;;) {
        sum = 0u; cnt = 0u; mine = 0u;
#pragma unroll
        for (unsigned j = 0; j < 16; ++j) { const unsigned c = xb_ld(&bar[XB_XCNT(j)]); sum += c; cnt += (c > 0u) ? 1u : 0u; mine = (j == x) ? c : mine; }
        if (sum == G) break;
        __builtin_amdgcn_s_sleep(1);
        if ((++sp & 255u) == 0u) { if (xb_ld(&bar[XB_TMO])) break; if (sp > XB_SPIN_CAP) { atomicAdd(&bar[XB_TMO], 1u); break; } }
    }
    nloc = mine > 0u ? mine : 1u; nx = cnt > 0u ? cnt : 1u;
}

__device__ __forceinline__ int xb_lane() { int l; asm volatile("v_mbcnt_lo_u32_b32 %0, -1, 0\n\tv_mbcnt_hi_u32_b32 %0, -1, %0" : "=v"(l)); return l; }
__device__ __forceinline__ void xcd_barrier(const XcdBarrier& b, const int wv) {
    asm volatile("s_waitcnt vmcnt(0)" ::: "memory");
    __syncthreads();
    if (wv == 0 && xb_lane() == 0) {
        unsigned* bar = b.bar; unsigned bx_id = __builtin_amdgcn_readfirstlane(b.x); asm volatile("" : "+s"(bx_id));
        __builtin_amdgcn_s_waitcnt(0);
        unsigned nloc = b.st[0], nx = b.st[1];
        if (nloc == 0u) { xcd_barrier_complete(bar, bx_id, nloc, nx); b.st[0] = nloc; b.st[1] = nx; }
        const unsigned old = xb_add(&bar[XB_XSUB(bx_id)], 1u);
        const unsigned gen = old / nloc;
        if (old + 1u == (gen + 1u) * nloc) {
            __builtin_amdgcn_fence(__ATOMIC_RELEASE, "agent");
            asm volatile("s_waitcnt vmcnt(0)" ::: "memory");
            const unsigned og = xb_add(&bar[XB_TOP], 1u);
            const unsigned tg = og / nx;
            if (og + 1u == (tg + 1u) * nx) xb_add(&bar[XB_TOPGEN], 1u);
            else XB_SPIN(xb_ld(&bar[XB_TOPGEN]) == tg, bar);
            __builtin_amdgcn_fence(__ATOMIC_ACQUIRE, "agent");
            xb_add(&bar[XB_XGEN(bx_id)], 1u);
            asm volatile("s_waitcnt vmcnt(0)" ::: "memory");
        } else {
            XB_SPIN(xb_ld(&bar[XB_XGEN(bx_id)]) == gen, bar);
            __builtin_amdgcn_fence(__ATOMIC_ACQUIRE, "agent");
            asm volatile("s_waitcnt vmcnt(0)" ::: "memory");
        }
    }
    __syncthreads();
}
__device__ __forceinline__ int opaque_lane() { int l; asm volatile("v_mbcnt_lo_u32_b32 %0, -1, 0\n\tv_mbcnt_hi_u32_b32 %0, -1, %0" : "=v"(l)); return l; }
#define PHASE_IDS() const int lane = opaque_lane(); int wave = wv; asm volatile("" : "+s"(wave)); const int tid_ = wave * 64 + lane; \
    const int G_ = gridDim.x, bx_ = blockIdx.x, vcu_ = (G_ % 8 == 0) ? (bx_ % 8) * (G_ / 8) + bx_ / 8 : bx_; const int gw = vcu_ * NWAVES + wave, NGW = G_ * NWAVES; (void)lane; (void)gw; (void)NGW
__device__ __forceinline__ float wave_sum(float v) {
    v = pg8::sum_row16(v); v += pg8::xor16_f(v); return pg8::sum_xor32(v);
}
struct TItem { f32x4 v[8]; float gk[8]; };
__device__ __forceinline__ void titem_load(TItem& T, const float* W, int N, int item, int lane, const float* gain) {
    const int nblk = N / 32, kb = item / nblk, nb = item % nblk, k0 = 64 * kb, n0 = 32 * nb; const int rg = lane >> 3, c4 = lane & 7;
#pragma unroll
    for (int i = 0; i < 8; ++i) T.v[i] = __builtin_nontemporal_load((const __attribute__((address_space(1))) f32x4*)(W + (size_t)(k0 + 8 * i + rg) * N + n0 + 4 * c4));
    if (gain) {
#pragma unroll
        for (int i = 0; i < 8; ++i) T.gk[i] = *(const __attribute__((address_space(1))) float*)(gain + k0 + 8 * i + rg);
    } else {
#pragma unroll
        for (int i = 0; i < 8; ++i) T.gk[i] = 1.0f; }
}
__device__ __forceinline__ void titem_finish(const TItem& T, int K, int N, bf16_t* WT, bf16_t* WTF, int mode, LAS float* scr, int item, int lane) {
    const int nblk = N / 32, kb = item / nblk, nb = item % nblk, k0 = 64 * kb, n0 = 32 * nb; const int rg = lane >> 3, c4 = lane & 7;
#pragma unroll
    for (int i = 0; i < 8; ++i) { LAS float* p = scr + (8 * i + rg) * 33 + 4 * c4; p[0] = T.v[i].x * T.gk[i]; p[1] = T.v[i].y * T.gk[i]; p[2] = T.v[i].z * T.gk[i]; p[3] = T.v[i].w * T.gk[i]; }
    LDS_WAIT(); asm volatile("" ::: "memory");
    const int c = lane & 7;
    const int rbase = (mode == 0) ? n0 : ((n0 >> 7) * 256 + (n0 & 127) + (mode == 2 ? 128 : 0));
#pragma unroll
    for (int j = 0; j < 4; ++j) { const int n = (lane >> 3) + 8 * j; const LAS float* s = scr + (8 * c) * 33 + n;
        u32x4 o; o.x = pkbf(s[0 * 33], s[1 * 33]); o.y = pkbf(s[2 * 33], s[3 * 33]); o.z = pkbf(s[4 * 33], s[5 * 33]); o.w = pkbf(s[6 * 33], s[7 * 33]);
        *(u32x4*)(WT + (size_t)(rbase + n) * K + k0 + 8 * c) = o;
        if (WTF) *(u32x4*)(WTF + frag_off(rbase + n, k0 + 8 * c, K)) = o; }
    LDS_WAIT(); asm volatile("" ::: "memory");
}
struct KArgs { const float* in[28]; float* out; unsigned char* ws; };
struct KA2 { float* out; unsigned char* ws; };
__device__ __forceinline__ const float* uniform_fptr(unsigned long long v) { const unsigned lo = __builtin_amdgcn_readfirstlane((unsigned)v), hi = __builtin_amdgcn_readfirstlane((unsigned)(v >> 32)); return (const float*)(((unsigned long long)hi << 32) | lo); }
#define INP(i) uniform_fptr(((const unsigned long long*)(A.ws + WS_PTRS))[i])

constexpr int CI_G = (DM / 64) * (FF / 32), CI_D = (FF / 64) * (DM / 32), CI_Q = (DM / 64) * (3 * DM / 32), CI_O = (DM / 64) * (DM / 32), CI_L = 4 * CI_G + 2 * CI_D + CI_Q + CI_O;
__device__ __forceinline__ const float* inp_of(const KArgs& A, int i) { return A.in[i]; }
__device__ __forceinline__ const float* inp_of(const KA2& A, int i) { return uniform_fptr(((const unsigned long long*)(A.ws + WS_PTRS))[i]); }
struct CItem { const float* W; const float* gain; bf16_t* WT; bf16_t* WTF; int K, N, mode, r; };
template <class AT>
__device__ __forceinline__ CItem citem_of(const AT& A, int L, int r) {
    const int kind = L % 3, slot = L / 3; unsigned char* wl = A.ws + WS_W + (size_t)(L % WSLOTS) * WL_SIZE; CItem c;
    if (r < CI_G) { c = CItem{inp_of(A, 10) + (size_t)L * DM * FF, inp_of(A, 9) + (size_t)L * DM, (bf16_t*)(wl + WL_GU1), nullptr, DM, FF, 1, r}; return c; } r -= CI_G;
    if (r < CI_G) { c = CItem{inp_of(A, 11) + (size_t)L * DM * FF, inp_of(A, 9) + (size_t)L * DM, (bf16_t*)(wl + WL_GU1), nullptr, DM, FF, 2, r}; return c; } r -= CI_G;
    if (r < CI_D) { c = CItem{inp_of(A, 12) + (size_t)L * FF * DM, nullptr, (bf16_t*)(wl + WL_DN1), (bf16_t*)(wl + WL_DN1F), FF, DM, 0, r}; return c; } r -= CI_D;
    if (r < CI_G) { c = CItem{inp_of(A, 15) + (size_t)L * DM * FF, inp_of(A, 14) + (size_t)L * DM, (bf16_t*)(wl + WL_GU2), nullptr, DM, FF, 1, r}; return c; } r -= CI_G;
    if (r < CI_G) { c = CItem{inp_of(A, 16) + (size_t)L * DM * FF, inp_of(A, 14) + (size_t)L * DM, (bf16_t*)(wl + WL_GU2), nullptr, DM, FF, 2, r}; return c; } r -= CI_G;
    if (r < CI_D) { c = CItem{inp_of(A, 17) + (size_t)L * FF * DM, nullptr, (bf16_t*)(wl + WL_DN2), (bf16_t*)(wl + WL_DN2F), FF, DM, 0, r}; return c; } r -= CI_D;
    const float* wq = (kind == 0) ? inp_of(A, 18) : (kind == 1) ? inp_of(A, 21) : inp_of(A, 25);
    const float* wo = (kind == 0) ? inp_of(A, 19) : (kind == 1) ? inp_of(A, 22) : inp_of(A, 26);
    if (r < CI_Q) { c = CItem{wq + (size_t)slot * DM * 3 * DM, inp_of(A, 13) + (size_t)L * DM, (bf16_t*)(wl + WL_QKV), (bf16_t*)(wl + WL_QKVF), DM, 3 * DM, 0, r}; return c; } r -= CI_Q;
    c = CItem{wo + (size_t)slot * DM * DM, nullptr, (bf16_t*)(wl + WL_WO), (bf16_t*)(wl + WL_WOF), DM, DM, 0, r}; return c;
}
constexpr int CR_D1 = 2 * CI_G, CR_G2 = 2 * CI_G + CI_D, CR_D2 = 4 * CI_G + CI_D, CR_Q = 4 * CI_G + 2 * CI_D, CR_O = CR_Q + CI_Q, CV_NA = CI_D + CI_Q + CI_O, CV_G1A = CI_L / 2 - CV_NA, CV_G1B = 2 * CI_G - CV_G1A;
static_assert(CV_G1A > 0 && CV_G1B > 0, "conversion schedule");
__device__ __forceinline__ int conv_list_len(int kind, int L) { return kind == 0 ? 4 * CI_G : kind == 1 ? CV_NA + (L + 1 < DEPTH ? CV_G1A : 0) : CI_D + (L + 1 < DEPTH ? CV_G1B + 2 * CI_G : 0); }
template <class AT>
__device__ __forceinline__ CItem citem_v(const AT& A, int kind, int L, int v) {
    if (kind == 0) return (v < 2 * CI_G) ? citem_of(A, L, v) : citem_of(A, L, CR_G2 + (v - 2 * CI_G));
    if (kind == 1) {
        if (v < CI_D) return citem_of(A, L, CR_D1 + v);
        if (v < CI_D + CI_Q) return citem_of(A, L, CR_Q + (v - CI_D));
        if (v < CV_NA) return citem_of(A, L, CR_O + (v - CI_D - CI_Q));
        return citem_of(A, L + 1, v - CV_NA); }
    if (v < CI_D) return citem_of(A, L, CR_D2 + v);
    if (v < CI_D + CV_G1B) return citem_of(A, L + 1, CV_G1A + (v - CI_D));
    return citem_of(A, L + 1, CR_G2 + (v - CI_D - CV_G1B));
}
template <class AT>
__device__ __forceinline__ void convert_items(const AT& A, int kind, int L, int first, int hi, int stride, LAS float* scr, int lane) {
    if (first >= hi) return;
    TItem Ta; CItem ca = citem_v(A, kind, L, first); titem_load(Ta, ca.W, ca.N, ca.r, lane, ca.gain);
#pragma unroll 1
    for (int it = first; it < hi; it += stride) {
        TItem Tb; CItem cb = ca; const bool more = it + stride < hi;
        if (more) { cb = citem_v(A, kind, L, it + stride); titem_load(Tb, cb.W, cb.N, cb.r, lane, cb.gain); }
        titem_finish(Ta, ca.K, ca.N, ca.WT, ca.WTF, ca.mode, scr, ca.r, lane);
        if (more) { Ta = Tb; ca = cb; }
    }
}
__device__ __forceinline__ void convert_tail(const KA2& A, LAS unsigned char* lds, int kind, int L, int c0, int nc, const int wv) {
    PHASE_IDS();
    LAS float* scr = (LAS float*)(lds + wave * 16384);
    convert_items(A, kind, L, (bx_ - c0) * NWAVES + wave, conv_list_len(kind, L), nc * NWAVES, scr, lane);
}
__device__ __forceinline__ void prologue_phase(const KArgs& A, LAS unsigned char* lds, const int wv) {
    PHASE_IDS();
    LAS float* scr = (LAS float*)(lds + wave * 16384);
    if (tid_ == 0) { const float** tab = (const float**)(A.ws + WS_PTRS);
#pragma unroll
        for (int i = 0; i < 28; ++i) tab[i] = A.in[i]; }
    convert_items(A, 0, 0, gw, conv_list_len(0, 0), NGW, scr, lane);
    bf16_t* XB = (bf16_t*)(A.ws + WS_HB); float* SS = (float*)(A.ws + WS_SS); bf16_t* XBF = (bf16_t*)(A.ws + WS_XBF);
    for (int m0 = 2 * gw; m0 < M; m0 += 2 * NGW) {
        f32x4 v[2][4];
#pragma unroll
        for (int q = 0; q < 2; ++q) { const int m = m0 + q; const float* src = (m < MP) ? A.in[0] + (size_t)m * DM : A.in[1] + (size_t)(m - MP) * DM;
#pragma unroll
            for (int j = 0; j < 4; ++j) v[q][j] = ((const f32x4*)src)[lane + 64 * j]; }
#pragma unroll
        for (int q = 0; q < 2; ++q) { const int m = m0 + q; u32x2* o8 = (u32x2*)(XB + (size_t)m * DM) + lane; float s = 0.f;
#pragma unroll
            for (int j = 0; j < 4; ++j) { u32x2 w; w.x = pkbf(v[q][j].x, v[q][j].y); w.y = pkbf(v[q][j].z, v[q][j].w); o8[64 * j] = w;
                if (m >= MP) *(u32x2*)(XBF + frag_off(m - MP, 4 * (lane + 64 * j), DM)) = w;
                s += (pg8::bflo(w.x) * pg8::bflo(w.x) + pg8::bfhi(w.x) * pg8::bfhi(w.x)) + (pg8::bflo(w.y) * pg8::bflo(w.y) + pg8::bfhi(w.y) * pg8::bfhi(w.y)); }
            s = wave_sum(s);
            if (lane < 16) SS[(size_t)m * 16 + lane] = (lane == 0) ? s : 0.f; }
    }
    { bf16_t* wfb = (bf16_t*)(A.ws + WS_WFB); const float* wf = A.in[23]; const float* gm = A.in[13] + DM;
      for (int i = gw * 64 + lane; i < NH * DM; i += NGW * 64) { const int hh = i / DM, kk = i % DM; wfb[i] = (bf16_t)(pkbf(wf[(size_t)kk * NH + hh] * gm[kk], 0.f) & 0xffffu); } }
    float* tbl = (float*)(A.ws + WS_TBL);
    for (int i = gw * 64 + lane; i < 2 * 16 * NREL; i += NGW * 64) { const int slot = i / (16 * NREL), rem = i % (16 * NREL), h = rem / NREL, idx = rem % NREL;
        tbl[(slot * 16 + h) * TBLP + idx] = A.in[20][((size_t)slot * NREL + idx) * 16 + h] * LOG2E; }
}

__device__ __forceinline__ void fgate_step(const KA2& A, const float* bfv, const int wv) {
    PHASE_IDS();
    const bf16_t* XB = (const bf16_t*)(A.ws + WS_HB); const bf16_t* WFB = (const bf16_t*)(A.ws + WS_WFB); const float* SS = (const float*)(A.ws + WS_SS);
    const float bias = bfv[lane & 15];
    for (int rb = gw; rb < M / 16; rb += NGW) {
        const bf16_t* ap = XB + (size_t)(rb * 16 + (lane & 15)) * DM + 8 * (lane >> 4); const bf16_t* bp = WFB + (size_t)(lane & 15) * DM + 8 * (lane >> 4);
        f32x4 acc = {0.f, 0.f, 0.f, 0.f};
#pragma unroll
        for (int k0 = 0; k0 < DM / 32; k0 += 8) { bf16x8 a[8], b[8];
#pragma unroll
            for (int kk = 0; kk < 8; ++kk) { a[kk] = *(const bf16x8*)(ap + (k0 + kk) * 32); b[kk] = *(const bf16x8*)(bp + (k0 + kk) * 32); }
#pragma unroll
            for (int kk = 0; kk < 8; ++kk) acc = __builtin_amdgcn_mfma_f32_16x16x32_bf16(a[kk], b[kk], acc, 0, 0, 0); }
#pragma unroll
        for (int e = 0; e < 4; ++e) { const int m = rb * 16 + 4 * (lane >> 4) + e; const float z = acc[e] * pg8::row_scale(SS, m) + bias;
            const float lf = fminf(z, 0.f) - 0.6931471805599453f * __builtin_amdgcn_logf(1.0f + __builtin_amdgcn_exp2f(-1.4426950408889634f * fabsf(z)));
            float* dst = (m < MP) ? A.out + O_BFP + (size_t)m * NH : A.out + O_BFS + (size_t)(m - MP) * NH; dst[lane & 15] = lf; }
    }
}
template <int K, int KSPLIT, int CW, int KB, class Epi>
__device__ __forceinline__ void small_gemm(LAS unsigned char* lds, const bf16_t* Af, const bf16_t* Bf, int N, const Epi& E, const int wv) {
    PHASE_IDS();
    constexpr int NCH = 8 / KSPLIT, TN = NCH * CW, KW = K / KSPLIT, NKS = KW / 32, NB = CW / 16, NE = TN / 64;
    static_assert(KW % 32 == 0 && CW % 16 == 0 && TN % 64 == 0 && 8 * 32 * CW * 4 <= RING_BYTES, "small_gemm geometry");
    const int ntn = N / TN, ntiles = (MS / 32) * ntn;
    const int kq = wave % KSPLIT, ch = wave / KSPLIT;
#pragma unroll 1
    for (int tile = bx_; tile < ntiles; tile += G_) {
        const int tm = tile / ntn, tn = tile % ntn;
        const int row = tid_ >> 4, c4 = (tid_ & 15) * 4;
        typename Epi::Pre pre[NE];
#pragma unroll
        for (int q = 0; q < NE; ++q) pre[q] = E.pre(tm * 32 + row, tn * TN + c4 + 64 * q);
        const bf16_t* ap = Af + ((size_t)(tm * 2) * (K / 32) + kq * NKS) * 512 + lane * 8;
        const bf16_t* bp = Bf + ((size_t)((tn * TN + ch * CW) / 16) * (K / 32) + kq * NKS) * 512 + lane * 8;
        f32x4 acc[2][NB];
#pragma unroll
        for (int i = 0; i < 2; ++i)
#pragma unroll
            for (int j = 0; j < NB; ++j) acc[i][j] = (f32x4){0.f, 0.f, 0.f, 0.f};
#pragma unroll
        for (int k0 = 0; k0 < NKS; k0 += KB) {
            bf16x8 a[KB][2], b[KB][NB];
#pragma unroll
            for (int kk = 0; kk < KB; ++kk) if (k0 + kk < NKS) {
#pragma unroll
                for (int i = 0; i < 2; ++i) a[kk][i] = *(const bf16x8*)(ap + (size_t)(i * (K / 32) + k0 + kk) * 512);
#pragma unroll
                for (int j = 0; j < NB; ++j) b[kk][j] = *(const bf16x8*)(bp + (size_t)(j * (K / 32) + k0 + kk) * 512); }
#pragma unroll
            for (int kk = 0; kk < KB; ++kk) if (k0 + kk < NKS) {
#pragma unroll
                for (int i = 0; i < 2; ++i)
#pragma unroll
                    for (int j = 0; j < NB; ++j) acc[i][j] = __builtin_amdgcn_mfma_f32_16x16x32_bf16(a[kk][i], b[kk][j], acc[i][j], 0, 0, 0); }
        }
        LAS float* part = (LAS float*)(lds + wave * (32 * CW * 4));
#pragma unroll
        for (int i = 0; i < 2; ++i)
#pragma unroll
            for (int j = 0; j < NB; ++j)
#pragma unroll
                for (int e = 0; e < 4; ++e) part[(16 * i + 4 * (lane >> 4) + e) * CW + 16 * j + (lane & 15)] = acc[i][j][e];
        __syncthreads();
#pragma unroll
        for (int q = 0; q < NE; ++q) { const int col = c4 + 64 * q, cch = col / CW, cin = col % CW;
            const LAS unsigned char* pb = lds + (size_t)(cch * KSPLIT) * (32 * CW * 4) + (row * CW + cin) * 4;
            f32x4 sum = *(const LAS f32x4*)pb;
#pragma unroll
            for (int w = 1; w < KSPLIT; ++w) sum += *(const LAS f32x4*)(pb + w * (32 * CW * 4));
            E.fin(tm * 32 + row, tn * TN + col, sum, pre[q]); }
        __syncthreads();
    }
}
struct SEpiResid {
    typedef u32x2 Pre;
    bf16_t* xb; float* SS; float c; bf16_t* xbf;
    __device__ __forceinline__ Pre pre(int row, int col) const { return *(const u32x2*)(xb + (size_t)row * DM + col); }
    __device__ __forceinline__ void fin(int row, int col, f32x4 v, const Pre& in) const {
        const size_t off = (size_t)row * DM + col;
        u32x2 w; w.x = pkbf(pg8::bflo(in.x) + v.x * c, pg8::bfhi(in.x) + v.y * c); w.y = pkbf(pg8::bflo(in.y) + v.z * c, pg8::bfhi(in.y) + v.w * c); *(u32x2*)(xb + off) = w; *(u32x2*)(xbf + frag_off(row, col, DM)) = w;
        float ss = (pg8::bflo(w.x) * pg8::bflo(w.x) + pg8::bfhi(w.x) * pg8::bfhi(w.x)) + (pg8::bflo(w.y) * pg8::bflo(w.y) + pg8::bfhi(w.y) * pg8::bfhi(w.y));
        ss = pg8::sum_row16(ss);
        if ((col & 63) == 0) SS[(size_t)row * 16 + (col >> 6)] = ss;
    }
};
struct SEpiQKV {
    typedef f32x4 Pre;
    bf16_t* qkv; size_t tstride; float qscale; float* oks; float* ovs; const float* SS;
    __device__ __forceinline__ Pre pre(int row, int col) const { return *(const f32x4*)(SS + (size_t)row * 16 + (col & 12)); }
    __device__ __forceinline__ void fin(int row, int col, f32x4 v, const Pre& p) const {
        float s = (p.x + p.y) + (p.z + p.w); s = pg8::sum_quad(s);
        const float rs = __builtin_amdgcn_rsqf(s * (1.0f / 1024.0f) + 1e-6f); const int t = col >> 10, c = col & 1023; const float sc = (t == 0) ? qscale * rs : rs;
        u32x2 w; w.x = pkbf(v.x * sc, v.y * sc); w.y = pkbf(v.z * sc, v.w * sc); *(u32x2*)(qkv + (size_t)t * tstride + (size_t)row * DM + c) = w;
        if (t >= 1) { float* o = (t == 1) ? oks : ovs; *(f32x4*)(o + (size_t)row * DM + c) = v * rs; }
    }
};
__device__ __forceinline__ void final_norm_phase(const KA2& A, const int wv) {
    PHASE_IDS();
    const bf16_t* XB = (const bf16_t*)(A.ws + WS_HB); const float* SS = (const float*)(A.ws + WS_SS); const float* gain = INP(27);
    f32x4 g[4];
#pragma unroll
    for (int j = 0; j < 4; ++j) g[j] = ((const f32x4*)gain)[lane + 64 * j];
    for (int m0 = 4 * gw; m0 < M; m0 += 4 * NGW) {
        const float part = SS[(size_t)(m0 + (lane >> 4)) * 16 + (lane & 15)];
        u32x2 w[4][4];
#pragma unroll
        for (int q = 0; q < 4; ++q)
#pragma unroll
            for (int j = 0; j < 4; ++j) w[q][j] = ((const u32x2*)(XB + (size_t)(m0 + q) * DM))[lane + 64 * j];
        const float tot = pg8::sum_row16(part); const float rl = __builtin_amdgcn_rsqf(tot * (1.0f / DM) + RMS_EPS);
#pragma unroll
        for (int q = 0; q < 4; ++q) { const float r = __builtin_bit_cast(float, __builtin_amdgcn_readlane(__builtin_bit_cast(int, rl), 16 * q));
            f32x4* o = (f32x4*)(A.out + O_YP + (size_t)(m0 + q) * DM) + lane;
#pragma unroll
            for (int j = 0; j < 4; ++j) { const f32x4 v = {pg8::bflo(w[q][j].x), pg8::bfhi(w[q][j].x), pg8::bflo(w[q][j].y), pg8::bfhi(w[q][j].y)}; o[64 * j] = v * r * g[j]; } }
    }
}
__device__ __forceinline__ float wave_incl_scan(float v, int lane) {
#pragma unroll
    for (int o = 1; o < 64; o <<= 1) { const float t = __builtin_bit_cast(float, __builtin_amdgcn_ds_bpermute(((lane - o) & 63) << 2, __builtin_bit_cast(int, v))); if (lane >= o) v += t; }
    return v;
}
__device__ __forceinline__ void scan_phase(const KA2& A, const int wv) {
    PHASE_IDS();
    float* cump = (float*)(A.ws + WS_CUMP); float* cums = (float*)(A.ws + WS_CUMS);
    for (int task = gw; task < 128 + 512; task += NGW) {
        if (task < 128) { const int b = task >> 4, h = task & 15; const float* f = A.out + O_BFP + ((size_t)b * SEQ) * NH + h;
            float loc[32]; float run = 0.f;
#pragma unroll
            for (int i = 0; i < 32; ++i) { run += f[(size_t)(32 * lane + i) * NH]; loc[i] = run; }
            const float incl = wave_incl_scan(run, lane); const float off = incl - run;
            float* dst = cump + (size_t)task * SEQ + 32 * lane;
#pragma unroll
            for (int i = 0; i < 32; ++i) dst[i] = (loc[i] + off) * LOG2E;
        } else { const int su = task - 128, b = su >> 4, h = su & 15; const float* f = INP(6) + ((size_t)b * PAST) * NH + h;
            float loc[16]; float run = 0.f;
#pragma unroll
            for (int i = 0; i < 16; ++i) { run += f[(size_t)(16 * lane + i) * NH]; loc[i] = run; }
            const float incl = wave_incl_scan(run, lane); const float off = incl - run;
            float* dst = cums + (size_t)su * 1088;
#pragma unroll
            for (int i = 0; i < 16; ++i) dst[16 * lane + i] = (loc[i] + off) * LOG2E;
            const float total = __builtin_bit_cast(float, __builtin_amdgcn_readlane(__builtin_bit_cast(int, incl), 63));
            const float fn = (lane < 16) ? A.out[O_BFS + (size_t)(b * 16 + lane) * NH + h] : 0.f;
            const float sc = wave_incl_scan(fn, lane);
            if (lane < 16) dst[1024 + lane] = (total + sc) * LOG2E;
        }
    }
}
__device__ __forceinline__ s16x4 vtr(const LAS unsigned char* p) { return __builtin_bit_cast(s16x4, __builtin_amdgcn_ds_read_tr16_b64_v4i16((LAS v4i16_t*)p)); }
struct AttnP {
    const bf16_t* Q; const bf16_t* K; const bf16_t* V; bf16_t* O;
    const float* ck; const float* cv;
    const float* tbl;
    const float* cump; const float* cums;
    unsigned* qctr;
    float* okp; float* ovp;
};
typedef float f32x2 __attribute__((ext_vector_type(2)));
struct AttState { f32x16 o0, o1; float mrun, lsum, R; };
constexpr int AL_KT = 0, AL_VT = 3 * KTILE, AL_AUXP = 3 * KTILE + 2 * VTILE, AL_VS = 0, AL_AUXS = 8 * VTILE, AL_CST = AL_AUXS + 4352, AL_KS1 = AL_CST + 1024, AL_KS2 = RING_BYTES + 1024, KHALF = 32 * KROWB;
static_assert(AL_AUXP + 8192 <= RING_BYTES && AL_KS1 + 5 * KHALF <= RING_BYTES && AL_KS2 + 3 * KHALF <= LDS_BYTES && AL_KS2 >= MISC_OFF + 512 && VTILE >= 4096, "attention LDS map");

__device__ __forceinline__ float max3f(float a, float b, float c) { float r; asm("v_max3_f32 %0, %1, %2, %3" : "=v"(r) : "v"(a), "v"(b), "v"(c)); return r; }
__device__ __forceinline__ float max2f(float a, float b) { float r; asm("v_max_f32_e32 %0, %1, %2" : "=v"(r) : "v"(a), "v"(b)); return r; }
template <int TYPE, bool MASK, bool KMASK, bool FAR>
__device__ __forceinline__ void attn_step(AttState& S, const bf16x8 (&kf)[2][4], const bf16x8 (&qr)[4], const LAS unsigned char* vrd, int kbase, int qpos, int qlim, int klim, int hi, const LAS float* aux, float cfar) {
    f32x16 p0, p1;
    if (TYPE == 0 && !FAR) {
        const LAS float* tb = aux + (384 - qpos + kbase);
#pragma unroll
        for (int r = 0; r < 16; ++r) { const int o = (r & 3) + 8 * (r >> 2); p0[r] = tb[o]; p1[r] = tb[o + 32]; }
    } else if (TYPE == 1) {
#pragma unroll
        for (int gi = 0; gi < 4; ++gi) { const f32x4 c0 = *(const LAS f32x4*)(aux + kbase + 8 * gi), c1 = *(const LAS f32x4*)(aux + kbase + 8 * gi + 32);
#pragma unroll
            for (int e = 0; e < 4; ++e) { p0[4 * gi + e] = c0[e]; p1[4 * gi + e] = c1[e]; } }
    } else if (TYPE == 0 && FAR) {
#pragma unroll
        for (int r = 0; r < 16; ++r) { p0[r] = cfar; p1[r] = cfar; }
    } else { p0 = f32x16{}; p1 = f32x16{}; }
#pragma unroll
    for (int d0 = 0; d0 < 4; ++d0) { p0 = __builtin_amdgcn_mfma_f32_32x32x16_bf16(kf[0][d0], qr[d0], p0, 0, 0, 0); p1 = __builtin_amdgcn_mfma_f32_32x32x16_bf16(kf[1][d0], qr[d0], p1, 0, 0, 0); }
    if (TYPE == 2) {
        float k0[16], k1[16];
#pragma unroll
        for (int r = 0; r < 16; ++r) { const int kp = kbase + (r & 3) + 8 * (r >> 2);
            { const float e = __builtin_amdgcn_exp2f(fminf(p0[r], 100.f)), k = __builtin_amdgcn_rcpf(1.f + e); if (MASK) { const bool v = kp < qlim; k0[r] = v ? k : 1.f; p0[r] = v ? e * k : 0.f; } else { k0[r] = k; p0[r] = e * k; } }
            { const float e = __builtin_amdgcn_exp2f(fminf(p1[r], 100.f)), k = __builtin_amdgcn_rcpf(1.f + e); if (MASK) { const bool v = kp + 32 < qlim; k1[r] = v ? k : 1.f; p1[r] = v ? e * k : 0.f; } else { k1[r] = k; p1[r] = e * k; } } }
        float all[16];
#pragma unroll
        for (int gi = 0; gi < 4; ++gi) {
            const float ga = (k0[4 * gi] * k0[4 * gi + 1]) * (k0[4 * gi + 2] * k0[4 * gi + 3]), gb = (k1[4 * gi] * k1[4 * gi + 1]) * (k1[4 * gi + 2] * k1[4 * gi + 3]);
            auto ra = __builtin_amdgcn_permlane32_swap(__float_as_uint(ga), __float_as_uint(ga), false, false); all[2 * gi] = __uint_as_float(ra[0]); all[2 * gi + 1] = __uint_as_float(ra[1]);
            auto rb = __builtin_amdgcn_permlane32_swap(__float_as_uint(gb), __float_as_uint(gb), false, false); all[8 + 2 * gi] = __uint_as_float(rb[0]); all[8 + 2 * gi + 1] = __uint_as_float(rb[1]); }
        float run = S.R;
#pragma unroll
        for (int gi = 3; gi >= 0; --gi) {
            const float above_odd = run, above_even = run * all[8 + 2 * gi + 1]; float s = hi ? above_odd : above_even; run = above_even * all[8 + 2 * gi];
            p1[4 * gi + 3] *= s; s *= k1[4 * gi + 3]; p1[4 * gi + 2] *= s; s *= k1[4 * gi + 2]; p1[4 * gi + 1] *= s; s *= k1[4 * gi + 1]; p1[4 * gi] *= s; }
#pragma unroll
        for (int gi = 3; gi >= 0; --gi) {
            const float above_odd = run, above_even = run * all[2 * gi + 1]; float s = hi ? above_odd : above_even; run = above_even * all[2 * gi];
            p0[4 * gi + 3] *= s; s *= k0[4 * gi + 3]; p0[4 * gi + 2] *= s; s *= k0[4 * gi + 2]; p0[4 * gi + 1] *= s; s *= k0[4 * gi + 1]; p0[4 * gi] *= s; }
        S.R = run;
    } else {
        if (TYPE == 0 && KMASK) {
#pragma unroll
            for (int r = 0; r < 16; ++r) { const int kp = kbase + (r & 3) + 8 * (r >> 2); p0[r] = (kp < klim) ? p0[r] : -1e30f; p1[r] = (kp + 32 < klim) ? p1[r] : -1e30f; }
        }
        if (TYPE == 1 && MASK) {
#pragma unroll
            for (int r = 0; r < 16; ++r) { const int kp = kbase + (r & 3) + 8 * (r >> 2); p0[r] = (kp <= qlim) ? p0[r] : -1e30f; p1[r] = (kp + 32 <= qlim) ? p1[r] : -1e30f; }
        }
        asm volatile("s_nop 15\n\ts_nop 7" : "+v"(p0), "+v"(p1));
        float tm = max3f(p0[0], p1[0], p0[1]);
#pragma unroll
        for (int r = 1; r < 15; ++r) tm = max3f(tm, p1[r], p0[r + 1]);
        tm = max2f(tm, p1[15]);
        { auto rr = __builtin_amdgcn_permlane32_swap(__float_as_uint(tm), __float_as_uint(tm), false, false); tm = max2f(__uint_as_float(rr[0]), __uint_as_float(rr[1])); }
        if (__any(tm > S.mrun + 8.0f)) {
            const float mt = max2f(S.mrun, tm), alpha = __builtin_amdgcn_exp2f(S.mrun - mt); S.mrun = mt; S.lsum *= alpha;
#pragma unroll
            for (int r = 0; r < 16; ++r) { S.o0[r] *= alpha; S.o1[r] *= alpha; }
        }
        const float mref = S.mrun; float ps = 0.f; const f32x2 m2 = {mref, mref};
#pragma unroll
        for (int r = 0; r < 16; r += 2) { const f32x2 a = (f32x2){p0[r], p0[r + 1]} - m2, bq = (f32x2){p1[r], p1[r + 1]} - m2;
            p0[r] = __builtin_amdgcn_exp2f(a.x); p0[r + 1] = __builtin_amdgcn_exp2f(a.y); p1[r] = __builtin_amdgcn_exp2f(bq.x); p1[r + 1] = __builtin_amdgcn_exp2f(bq.y); }
#pragma unroll
        for (int r = 0; r < 16; ++r) ps += p0[r] + p1[r];
        S.lsum += ps;
    }
    bf16x8 pa[4];
#pragma unroll
    for (int s = 0; s < 2; ++s) {
        u32x4 w0; w0.x = pkbf(p0[8 * s], p0[8 * s + 1]); w0.y = pkbf(p0[8 * s + 2], p0[8 * s + 3]); w0.z = pkbf(p0[8 * s + 4], p0[8 * s + 5]); w0.w = pkbf(p0[8 * s + 6], p0[8 * s + 7]); pa[s] = __builtin_bit_cast(bf16x8, w0);
        u32x4 w1; w1.x = pkbf(p1[8 * s], p1[8 * s + 1]); w1.y = pkbf(p1[8 * s + 2], p1[8 * s + 3]); w1.z = pkbf(p1[8 * s + 4], p1[8 * s + 5]); w1.w = pkbf(p1[8 * s + 6], p1[8 * s + 7]); pa[2 + s] = __builtin_bit_cast(bf16x8, w1); }
#pragma unroll
    for (int ks = 0; ks < 4; ++ks) {
        const s16x4 a0 = vtr(vrd + (16 * ks) * VROWB), a1 = vtr(vrd + (16 * ks + 8) * VROWB), c0 = vtr(vrd + (16 * ks) * VROWB + 64), c1 = vtr(vrd + (16 * ks + 8) * VROWB + 64);
        const bf16x8 v0 = {a0[0], a0[1], a0[2], a0[3], a1[0], a1[1], a1[2], a1[3]}, v1 = {c0[0], c0[1], c0[2], c0[3], c1[0], c1[1], c1[2], c1[3]};
        S.o0 = __builtin_amdgcn_mfma_f32_32x32x16_bf16(v0, pa[ks], S.o0, 0, 0, 0);
        S.o1 = __builtin_amdgcn_mfma_f32_32x32x16_bf16(v1, pa[ks], S.o1, 0, 0, 0); }
}
__device__ __forceinline__ void fill_bias_table(LAS float* aux, const float* tb, int tid) {
    for (int i = tid; i < 640; i += NWAVES * 64) { int d = 384 - i; d = d < -256 ? -256 : (d > 256 ? 256 : d); aux[i] = tb[d + 256]; }
}

template <int TYPE>
__device__ __forceinline__ void kv_out(const AttnP& P, int b, int h, int U, int jt, int srow, int sch, const u32x4 kreg, const u32x4 vreg) {
    if (jt < 4 * U) return;
    if (TYPE == 0 && jt < (SEQ - AKEEP) / 64) return;
    const size_t row = (TYPE == 0) ? (size_t)b * AKEEP + (64 * jt - (SEQ - AKEEP)) + srow : (size_t)b * SEQ + 64 * jt + srow;
    __attribute__((address_space(1))) f32x4* ko = (__attribute__((address_space(1))) f32x4*)(P.okp + row * DM + h * HD + 8 * sch);
    __attribute__((address_space(1))) f32x4* vo = (__attribute__((address_space(1))) f32x4*)(P.ovp + row * DM + h * HD + 8 * sch);
    ko[0] = (f32x4){pg8::bflo(kreg.x), pg8::bfhi(kreg.x), pg8::bflo(kreg.y), pg8::bfhi(kreg.y)}; ko[1] = (f32x4){pg8::bflo(kreg.z), pg8::bfhi(kreg.z), pg8::bflo(kreg.w), pg8::bfhi(kreg.w)};
    vo[0] = (f32x4){pg8::bflo(vreg.x), pg8::bfhi(vreg.x), pg8::bflo(vreg.y), pg8::bfhi(vreg.y)}; vo[1] = (f32x4){pg8::bflo(vreg.z), pg8::bfhi(vreg.z), pg8::bflo(vreg.w), pg8::bfhi(vreg.w)};
}
template <int TYPE>
__device__ __forceinline__ void row_out(float* obase, int b, int h, int U, int jt, int srow, int sch, const u32x4 reg) {
    if (jt < 4 * U) return;
    if (TYPE == 0 && jt < (SEQ - AKEEP) / 64) return;
    const size_t row = (TYPE == 0) ? (size_t)b * AKEEP + (64 * jt - (SEQ - AKEEP)) + srow : (size_t)b * SEQ + 64 * jt + srow;
    __attribute__((address_space(1))) f32x4* o = (__attribute__((address_space(1))) f32x4*)(obase + row * DM + h * HD + 8 * sch);
    o[0] = (f32x4){pg8::bflo(reg.x), pg8::bfhi(reg.x), pg8::bflo(reg.y), pg8::bfhi(reg.y)}; o[1] = (f32x4){pg8::bflo(reg.z), pg8::bfhi(reg.z), pg8::bflo(reg.w), pg8::bfhi(reg.w)};
}
template <int TYPE>
__device__ __forceinline__ void attn_prompt_unit(const AttnP& P, int b, int h, int U, LAS unsigned char* lds, int wave, unsigned nxt, volatile LAS unsigned* slot) {
    const int lane = opaque_lane(), tid = wave * 64 + lane;
    const int r32 = lane & 31, hi = lane >> 5, li = lane & 15;
    const int qblk = 8 * U + wave, c = qblk >> 1, qpos = 32 * qblk + r32;
    const int jlast = 4 * U + 3, jfirst = (TYPE == 0) ? (4 * U > 8 ? 4 * U - 8 : 0) : 0, nt = jlast - jfirst + 1;
    LAS float* aux = (LAS float*)(lds + AL_AUXP);
    if (TYPE == 1) { const float* src = P.cump + (size_t)(b * NH + h) * SEQ; for (int i = tid; i < 256 * (U + 1); i += NWAVES * 64) aux[i] = -src[i]; }
    if (TYPE == 0) fill_bias_table(aux, P.tbl + h * TBLP, tid);
    const float cfar = (TYPE == 0) ? P.tbl[h * TBLP + 512] : 0.f;
    volatile LAS unsigned* dflag = (volatile LAS unsigned*)(lds + MISC_OFF + 256);
    bf16x8 qr[4];
    { const __attribute__((address_space(1))) unsigned char* qb = (const __attribute__((address_space(1))) unsigned char*)(P.Q + (size_t)b * SEQ * DM + h * HD); const unsigned qo = (unsigned)((qpos * DM + 8 * hi) * 2);
#pragma unroll
      for (int d0 = 0; d0 < 4; ++d0) qr[d0] = *(const __attribute__((address_space(1))) bf16x8*)(qb + qo + 32 * d0); }
    const int srow = tid >> 3, sch = tid & 7;
    typedef __attribute__((address_space(1))) const unsigned char gcb;
    gcb* kg = (gcb*)(P.K + (size_t)b * SEQ * DM + h * HD); gcb* vg = (gcb*)(P.V + (size_t)b * SEQ * DM + h * HD);
    const unsigned goff = (unsigned)((srow * DM + 8 * sch) * 2);
#define TILE_LD(base, jj) (*(__attribute__((address_space(1))) const u32x4*)((base) + (size_t)(jj) * (64 * DM * 2) + goff))
    const int soffk = srow * KROWB + 16 * sch, soffv = srow * VROWB + 16 * sch;
#define TIDX(tau) ((TYPE == 2) ? jlast - (tau) : jfirst + (tau))
    { const u32x4 kr0 = TILE_LD(kg, TIDX(0)), kr1 = TILE_LD(kg, TIDX(1)), vr0 = TILE_LD(vg, TIDX(0));
      *(LAS u32x4*)(lds + AL_KT + soffk) = kr0; *(LAS u32x4*)(lds + AL_KT + KTILE + soffk) = kr1; *(LAS u32x4*)(lds + AL_VT + soffv) = vr0;
      row_out<TYPE>(P.okp, b, h, U, TIDX(0), srow, sch, kr0); row_out<TYPE>(P.okp, b, h, U, TIDX(1), srow, sch, kr1); row_out<TYPE>(P.ovp, b, h, U, TIDX(0), srow, sch, vr0); }
    const int grp = wave >> 2, gt = tid & 255, grow = gt >> 3;
    const unsigned ggoff = (unsigned)((grow * DM + 8 * sch) * 2);
#define TILE_LD2(base, jj, half) (*(__attribute__((address_space(1))) const u32x4*)((base) + (size_t)(jj) * (64 * DM * 2) + ggoff + (half) * (32 * DM * 2)))
    const int gsk = grow * KROWB + 16 * sch, gsv = grow * VROWB + 16 * sch;
    u32x4 rk0 = {}, rk1 = {}, rv0 = {}, rv1 = {};
    if (grp == 1) { rk0 = TILE_LD2(kg, TIDX(2), 0); rk1 = TILE_LD2(kg, TIDX(2), 1); rv0 = TILE_LD2(vg, TIDX(1), 0); rv1 = TILE_LD2(vg, TIDX(1), 1); }
    if (tid == 0) slot[1] = nxt;
    __syncthreads();
    AttState S; S.o0 = f32x16{}; S.o1 = f32x16{}; S.mrun = -1e30f; S.lsum = 0.f; S.R = 1.f;
    const int vro = (4 * hi + (li >> 2)) * VROWB + (16 * ((lane >> 4) & 1) + 4 * (li & 3)) * 2, kro = r32 * KROWB + 16 * hi;
    bool done = false;
    bf16x8 kf[2][4];
#pragma unroll
    for (int sub = 0; sub < 2; ++sub)
#pragma unroll
        for (int d0 = 0; d0 < 4; ++d0) kf[sub][d0] = *(const LAS bf16x8*)(lds + AL_KT + kro + sub * 32 * KROWB + 32 * d0);
    int ksl = 0;
#pragma unroll 1
    for (int t = 0; t < nt; ++t) {
        const int j = TIDX(t), bufv = (t & 1) * VTILE;
        const bool mine = ((t ^ grp) & 1) == 0;
        if (mine) { if (t + 3 < nt) { rk0 = TILE_LD2(kg, TIDX(t + 3), 0); rk1 = TILE_LD2(kg, TIDX(t + 3), 1); }
                    if (t + 2 < nt) { rv0 = TILE_LD2(vg, TIDX(t + 2), 0); rv1 = TILE_LD2(vg, TIDX(t + 2), 1); } }
        const bool active = ((TYPE == 0) ? (j >= c - 8 && j <= c) : (j <= c)) && !done;
        if (active) {
            const LAS unsigned char* vrd = lds + AL_VT + bufv + vro; const int kbase = 64 * j + 4 * hi;
            if (TYPE == 0) { if (64 * c - (64 * j + 63) >= 256) attn_step<0, false, false, true>(S, kf, qr, vrd, kbase, qpos, 0, 0, hi, aux, cfar); else attn_step<0, false, false, false>(S, kf, qr, vrd, kbase, qpos, 0, 0, hi, aux, cfar); }
            else { if (j == c) attn_step<TYPE, true, false, false>(S, kf, qr, vrd, kbase, qpos, qpos, 0, hi, aux, 0.f); else attn_step<TYPE, false, false, false>(S, kf, qr, vrd, kbase, qpos, 0, 0, hi, aux, 0.f); }
            if (TYPE == 2) done = __all(S.R == 0.f);
        }
        const int ksn = (ksl == 2) ? 0 : ksl + 1, ksw = (ksn == 2) ? 0 : ksn + 1;
        if (t + 1 < nt) {
#pragma unroll
            for (int sub = 0; sub < 2; ++sub)
#pragma unroll
                for (int d0 = 0; d0 < 4; ++d0) kf[sub][d0] = *(const LAS bf16x8*)(lds + AL_KT + ksn * KTILE + kro + sub * 32 * KROWB + 32 * d0); }
        if (!mine) {
            if (t + 2 < nt) { *(LAS u32x4*)(lds + AL_KT + ksw * KTILE + gsk) = rk0; *(LAS u32x4*)(lds + AL_KT + ksw * KTILE + gsk + 32 * KROWB) = rk1;
                row_out<TYPE>(P.okp, b, h, U, TIDX(t + 2), grow, sch, rk0); row_out<TYPE>(P.okp, b, h, U, TIDX(t + 2), grow + 32, sch, rk1); }
            if (t + 1 < nt) { *(LAS u32x4*)(lds + AL_VT + (VTILE - bufv) + gsv) = rv0; *(LAS u32x4*)(lds + AL_VT + (VTILE - bufv) + gsv + 32 * VROWB) = rv1;
                row_out<TYPE>(P.ovp, b, h, U, TIDX(t + 1), grow, sch, rv0); row_out<TYPE>(P.ovp, b, h, U, TIDX(t + 1), grow + 32, sch, rv1); } }
        ksl = ksn;
        if (TYPE == 2 && lane == 0) dflag[wave] = done ? 1u : 0u;
        __syncthreads();
        if (TYPE == 2) { unsigned alld = 1u;
#pragma unroll
            for (int w = 0; w < NWAVES; ++w) alld &= dflag[w];
            if (alld && t >= 2) break; }
    }
#undef TIDX
    float inv = 1.f;
    if (TYPE != 2) { auto rr = __builtin_amdgcn_permlane32_swap(__float_as_uint(S.lsum), __float_as_uint(S.lsum), false, false); inv = 1.0f / (__uint_as_float(rr[0]) + __uint_as_float(rr[1])); }
#undef TILE_LD
#undef TILE_LD2
    { __attribute__((address_space(1))) unsigned char* ob = (__attribute__((address_space(1))) unsigned char*)(P.O + (size_t)b * SEQ * DM + h * HD);
      const int lane2 = opaque_lane(); const unsigned oo = (unsigned)(((32 * qblk + (lane2 & 31)) * DM) * 2 + ((lane2 >> 5) ? 16 : 0));
      u32x2 grp[8];
#pragma unroll
      for (int g = 0; g < 4; ++g) { grp[g].x = pkbf(S.o0[4 * g] * inv, S.o0[4 * g + 1] * inv); grp[g].y = pkbf(S.o0[4 * g + 2] * inv, S.o0[4 * g + 3] * inv);
        grp[4 + g].x = pkbf(S.o1[4 * g] * inv, S.o1[4 * g + 1] * inv); grp[4 + g].y = pkbf(S.o1[4 * g + 2] * inv, S.o1[4 * g + 3] * inv); }
#pragma unroll
      for (int k = 0; k < 8; k += 2) {
          auto rx = __builtin_amdgcn_permlane32_swap(grp[k].x, grp[k + 1].x, false, false); auto ry = __builtin_amdgcn_permlane32_swap(grp[k].y, grp[k + 1].y, false, false);
          const unsigned ax = rx[0], bx2 = rx[1], ay = ry[0], by2 = ry[1];
          u32x4 w; w.x = ax; w.y = ay; w.z = bx2; w.w = by2;
          *(__attribute__((address_space(1))) u32x4*)(ob + oo + 16 * k) = w; } }
}

template <int TYPE>
__device__ __forceinline__ void attn_sample_unit(const AttnP& P, int b, int h, LAS unsigned char* lds, int wave, unsigned nxt, volatile LAS unsigned* slot) {
    const int lane = opaque_lane(), tid = wave * 64 + lane;
    constexpr int NCACHE = (TYPE == 0) ? ACACHE : PAST, NTC = NCACHE / 64, TPW = NTC / 8;
    const int r32 = lane & 31, hi = lane >> 5, li = lane & 15, q16 = r32 & 15;
    const size_t qrow = (size_t)MP + b * DS + q16; const int qpos = NCACHE + q16;
    LAS float* aux = (LAS float*)(lds + AL_AUXS); LAS unsigned char* vl = lds + AL_VS + wave * VTILE; LAS unsigned char* kl = lds + (wave < 5 ? AL_KS1 + wave * KHALF : AL_KS2 + (wave - 5) * KHALF);
    if (TYPE == 1) { const float* src = P.cums + (size_t)(b * NH + h) * 1088; for (int i = tid; i < 1088; i += NWAVES * 64) aux[i] = -src[i]; }
    if (TYPE == 0) fill_bias_table(aux, P.tbl + h * TBLP, tid);
    const float cfar = (TYPE == 0) ? P.tbl[h * TBLP + 512] : 0.f;
    bf16x8 qr[4];
    { const bf16_t* qp = P.Q + qrow * DM + h * HD + 8 * hi;
#pragma unroll
      for (int d0 = 0; d0 < 4; ++d0) qr[d0] = *(const bf16x8*)(qp + 16 * d0); }
    if (tid == 0) slot[1] = nxt;
    __syncthreads();
    AttState S; S.o0 = f32x16{}; S.o1 = f32x16{}; S.mrun = -1e30f; S.lsum = 0.f; S.R = 1.f;
    const int vro = (4 * hi + (li >> 2)) * VROWB + (16 * ((lane >> 4) & 1) + 4 * (li & 3)) * 2;
    const int ntw = TPW + (wave == 7 ? 1 : 0);
#pragma unroll 1
    for (int t = 0; t < ntw; ++t) {
        const int j = (TYPE == 2) ? ((wave + 1) * TPW - 1 + (wave == 7 ? 1 : 0) - t) : (wave * TPW + t);
        bf16x8 kf[2][4];
        if (j == NTC) {
            typedef __attribute__((address_space(1))) const unsigned char gcb2;
            gcb2* kb2 = (gcb2*)(P.K + ((size_t)MP + b * DS) * DM + h * HD); gcb2* vb2 = (gcb2*)(P.V + ((size_t)MP + b * DS) * DM + h * HD);
#pragma unroll
            for (int sub = 0; sub < 2; ++sub) { const int kr = 32 * sub + r32; const unsigned ko = (unsigned)(((kr < DS - 1 ? kr : DS - 1) * DM + 8 * hi) * 2);
#pragma unroll
                for (int d0 = 0; d0 < 4; ++d0) kf[sub][d0] = *(__attribute__((address_space(1))) const bf16x8*)(kb2 + ko + 32 * d0); }
            u32x4 vv[8];
#pragma unroll
            for (int i = 0; i < 8; ++i) { const int row = 8 * i + (lane >> 3); vv[i] = *(__attribute__((address_space(1))) const u32x4*)(vb2 + (unsigned)(((row < DS - 1 ? row : DS - 1) * DM + 8 * (lane & 7)) * 2)); }
#pragma unroll
            for (int i = 0; i < 8; ++i) { const int row = 8 * i + (lane >> 3); *(LAS u32x4*)(vl + row * VROWB + 16 * (lane & 7)) = vv[i]; }
        } else {
            typedef __attribute__((address_space(1))) const unsigned char gcb;
            gcb* kb = (gcb*)(P.ck + (((size_t)b * NCACHE + 64 * j) * NH + h) * HD); gcb* vb = (gcb*)(P.cv + (((size_t)b * NCACHE + 64 * j) * NH + h) * HD);
            const unsigned voff = (unsigned)((lane >> 4) * (NH * HD * 4) + li * 16);
            f32x4 kk[16], vv[16];
#pragma unroll
            for (int i = 0; i < 16; ++i) { gcb* kbi = kb + i * 4 * (NH * HD * 4); kk[i] = *(__attribute__((address_space(1))) const f32x4*)(kbi + voff); }
#pragma unroll
            for (int i = 0; i < 16; ++i) { gcb* vbi = vb + i * 4 * (NH * HD * 4); vv[i] = *(__attribute__((address_space(1))) const f32x4*)(vbi + voff); }
#pragma unroll
            for (int sub = 0; sub < 2; ++sub) {
#pragma unroll
                for (int i = 0; i < 8; ++i) { const int row = 4 * i + (lane >> 4); u32x2 w; w.x = pkbf(kk[8 * sub + i].x, kk[8 * sub + i].y); w.y = pkbf(kk[8 * sub + i].z, kk[8 * sub + i].w); *(LAS u32x2*)(kl + row * KROWB + 8 * li) = w; }
#pragma unroll
                for (int d0 = 0; d0 < 4; ++d0) kf[sub][d0] = *(const LAS bf16x8*)(kl + r32 * KROWB + 16 * hi + 32 * d0);
            }
#pragma unroll
            for (int i = 0; i < 16; ++i) { const int row = 4 * i + (lane >> 4); u32x2 w; w.x = pkbf(vv[i].x, vv[i].y); w.y = pkbf(vv[i].z, vv[i].w); *(LAS u32x2*)(vl + row * VROWB + 8 * li) = w; }
        }
        { const int kbase = 64 * j + 4 * hi; const bool isnew = (j == NTC);
          if (TYPE == 0) { const bool far = (NCACHE - (64 * j + 63)) >= 256;
              if (isnew) attn_step<0, false, true, false>(S, kf, qr, vl + vro, kbase, qpos, 0, NCACHE + DS, hi, aux, cfar);
              else if (far) attn_step<0, false, false, true>(S, kf, qr, vl + vro, kbase, qpos, 0, 0, hi, aux, cfar);
              else attn_step<0, false, false, false>(S, kf, qr, vl + vro, kbase, qpos, 0, 0, hi, aux, cfar); }
          else { if (isnew) attn_step<TYPE, true, false, false>(S, kf, qr, vl + vro, kbase, qpos, qpos, 0, hi, aux, 0.f); else attn_step<TYPE, false, false, false>(S, kf, qr, vl + vro, kbase, qpos, 0, 0, hi, aux, 0.f); } }
    }
    LAS float* comb = (LAS float*)(lds + AL_VS + wave * VTILE); LAS float* cst = (LAS float*)(lds + AL_CST) + wave * 32;
    float ltot = 0.f;
    if (TYPE != 2) { auto rr = __builtin_amdgcn_permlane32_swap(__float_as_uint(S.lsum), __float_as_uint(S.lsum), false, false); ltot = __uint_as_float(rr[0]) + __uint_as_float(rr[1]); }
    if (r32 < 16) {
#pragma unroll
        for (int r = 0; r < 16; ++r) { const int d = (r & 3) + 8 * (r >> 2) + 4 * hi; comb[q16 * 64 + d] = S.o0[r]; comb[q16 * 64 + 32 + d] = S.o1[r]; }
        if (hi == 0) { cst[q16] = (TYPE == 2) ? S.R : S.mrun; cst[16 + q16] = ltot; }
    }
    __syncthreads();
    { const int tid2 = wave * 64 + opaque_lane(); const int q = tid2 >> 5, d2 = (tid2 & 31) * 2; const LAS float* cb = (const LAS float*)(lds + AL_VS); const LAS float* cs = (const LAS float*)(lds + AL_CST);
      float n0 = 0.f, n1 = 0.f;
      if (TYPE == 2) { float f = 1.f;
#pragma unroll
          for (int w = 7; w >= 0; --w) { n0 += f * cb[w * (VTILE / 4) + q * 64 + d2]; n1 += f * cb[w * (VTILE / 4) + q * 64 + d2 + 1]; f *= cs[w * 32 + q]; } }
      else { float mx = cs[q];
#pragma unroll
          for (int w = 1; w < 8; ++w) mx = fmaxf(mx, cs[w * 32 + q]);
          float den = 0.f;
#pragma unroll
          for (int w = 0; w < 8; ++w) { const float f = __builtin_amdgcn_exp2f(cs[w * 32 + q] - mx); den += f * cs[w * 32 + 16 + q]; n0 += f * cb[w * (VTILE / 4) + q * 64 + d2]; n1 += f * cb[w * (VTILE / 4) + q * 64 + d2 + 1]; }
          const float inv = 1.0f / den; n0 *= inv; n1 *= inv; }
      *(unsigned*)(P.O + (size_t)MP * DM + frag_off(b * DS + q, h * HD + d2, DM)) = pkbf(n0, n1); }
    __syncthreads();
}

template <int TYPE>
__device__ __forceinline__ void attn_phase(const AttnP& P, LAS unsigned char* lds, const int wv) {
    PHASE_IDS();
    volatile LAS unsigned* slot = (volatile LAS unsigned*)(lds + MISC_OFF) + 16;
    constexpr unsigned NU = 3 * DB * NH / 8, NS2 = 2 * DB * NH / 8;
    const int xq = bx_ & 7; unsigned* qc = P.qctr + 64 * xq;
    if (tid_ == 0) slot[1] = atomicAdd(qc, 1u);
    __syncthreads();
#pragma unroll 1
    for (;;) {
        const unsigned n = slot[1];
        if (n >= NU) break;
        unsigned nxt = 0u;
        if (tid_ == 0) nxt = atomicAdd(qc, 1u);
        __syncthreads();
        if (n < NS2 && (n & 1u)) { const int s = (int)(n >> 1); attn_sample_unit<TYPE>(P, s >> 1, (s & 1) * 8 + xq, lds, wave, nxt, slot); }
        else { const int p = (n < NS2) ? (int)(n >> 1) : (int)(n - NS2 / 2); const int U = 7 - (p >> 4), bhl = p & 15; attn_prompt_unit<TYPE>(P, bhl >> 1, (bhl & 1) * 8 + xq, U, lds, wave, nxt, slot); }
        __syncthreads();
    }
}
__global__ void __launch_bounds__(NWAVES * 64, 2) fwd_kernel(KArgs A0) {
    extern __shared__ __attribute__((aligned(16))) unsigned char lds_raw[];
    LAS unsigned char* lds = (LAS unsigned char*)lds_raw;
    volatile LAS unsigned* MISC = (volatile LAS unsigned*)(lds + MISC_OFF);
    const int tid = threadIdx.x; const int G0 = gridDim.x, bx0 = blockIdx.x; const int wv = __builtin_amdgcn_readfirstlane(tid >> 6);
    for (int u = tid; u < (LDS_BYTES - RING_BYTES) / 4; u += NWAVES * 64) ((LAS unsigned*)(lds + RING_BYTES))[u] = 0u;
    __syncthreads();
    unsigned* ctl = (unsigned*)(A0.ws + WS_CTL);
    XcdBarrier bar = xcd_barrier_post(ctl + CW_BAR, MISC + 8);
    unsigned char* ws = A0.ws;
    bf16_t* HB = (bf16_t*)(ws + WS_HB); bf16_t* ACT = (bf16_t*)(ws + WS_ACT); bf16_t* QKV = (bf16_t*)(ws + WS_QKV); bf16_t* OB = (bf16_t*)(ws + WS_O);

    float* SS = (float*)(ws + WS_SS);
    prologue_phase(A0, lds, wv);
    xcd_barrier(bar, wv);
    KA2 A; A.out = A0.out; A.ws = A0.ws;

#pragma unroll 1
    for (int step = 0; step < 3 * DEPTH; ++step) {
        const int L = step / 3, sb = step % 3, kind = L % 3, slot = L / 3;
        int G = G0, bx = bx0; asm volatile("" : "+s"(G), "+s"(bx));
        unsigned char* wl = ws + WS_W + (size_t)(L % WSLOTS) * WL_SIZE;
        if (sb != 1) {
            { pg8::Gemm g{HB, (const bf16_t*)(wl + (sb == 0 ? WL_GU1 : WL_GU2)), M, 2 * FF, DM}; pg8::StaticOrder S; S.init(M, 2 * FF, G, bx);
              pg8::EpiSwiGLU E{ACT, FF, (LAS float*)(lds + MSL_OFF), MP, 0, SS};
              pg8::gemm_phase<pg8::EpiSwiGLU, pg8::StaticOrder, true, true>(lds, g, S, E, wv);
              {
                  const int nwg = S.nwg, umax = (nwg + G - 1) / G; int c0 = (nwg % G == 0) ? G : nwg - (umax - 1) * G, nc = G - c0; if (nc < 32) { c0 = 0; nc = G; }
                  if (bx >= c0) convert_tail(A, lds, (sb == 0) ? 1 : 2, L, c0, nc, wv); } }
            xcd_barrier(bar, wv);
            { const bf16_t* wd = (const bf16_t*)(wl + (sb == 0 ? WL_DN1 : WL_DN2));
              pg8::Gemm g{ACT, wd, MP, DM, FF}; pg8::StaticOrder S; S.init(MP, DM, G, bx);
              pg8::EpiResid E{HB, SS, 0.5f};
              pg8::gemm_phase<pg8::EpiResid, pg8::StaticOrder, true, true>(lds, g, S, E, wv);
              SEpiResid SE{HB + (size_t)MP * DM, SS + (size_t)MP * 16, 0.5f, (bf16_t*)(ws + WS_XBF)};
              small_gemm<FF, 8, 64, 6, SEpiResid>(lds, ACT + (size_t)MP * FF, (const bf16_t*)(wl + (sb == 0 ? WL_DN1F : WL_DN2F)), DM, SE, wv); }
            xcd_barrier(bar, wv);
        } else {
            if (kind == 1) fgate_step(A, INP(24) + (size_t)slot * NH, wv);
            { const bf16_t* wq = (const bf16_t*)(wl + WL_QKV);
              float *oks, *ovs;
              if (kind == 0) { oks = A.out + O_AKS + (size_t)slot * MS * DM; ovs = A.out + O_AVS + (size_t)slot * MS * DM; }
              else if (kind == 1) { oks = A.out + O_BKS; ovs = A.out + O_BVS; }
              else { oks = A.out + O_CKS; ovs = A.out + O_CVS; }
              pg8::Gemm g{HB, wq, MP, 3 * DM, DM}; pg8::StaticOrder S; S.init(MP, 3 * DM, G, bx);
              pg8::EpiQKV E;
              E.qkv = QKV; E.tstride = QKV_T; E.qscale = QSCALE; E.msl = (LAS float*)(lds + MSL_OFF); E.ord = 0; E.SS = SS;
              pg8::gemm_phase<pg8::EpiQKV, pg8::StaticOrder, true, true>(lds, g, S, E, wv);
              SEpiQKV SE{QKV + (size_t)MP * DM, QKV_T, QSCALE, oks, ovs, SS + (size_t)MP * 16};
              small_gemm<DM, 4, 96, 4, SEpiQKV>(lds, (const bf16_t*)(ws + WS_XBF), (const bf16_t*)(wl + WL_QKVF), 3 * DM, SE, wv); }
            xcd_barrier(bar, wv);
            if (kind == 1) { scan_phase(A, wv); xcd_barrier(bar, wv); }
            { AttnP P; P.Q = QKV; P.K = QKV + QKV_T; P.V = QKV + 2 * QKV_T; P.O = OB;
              P.tbl = (const float*)(ws + WS_TBL) + (size_t)slot * NH * TBLP; P.cump = (const float*)(ws + WS_CUMP); P.cums = (const float*)(ws + WS_CUMS); P.qctr = ctl + CW_Q + 512 * L;
              if (kind == 0) { P.okp = A.out + O_AKP + (size_t)slot * NB * AKEEP * DM; P.ovp = A.out + O_AVP + (size_t)slot * NB * AKEEP * DM; } else if (kind == 1) { P.okp = A.out + O_BKP; P.ovp = A.out + O_BVP; } else { P.okp = A.out + O_CKP; P.ovp = A.out + O_CVP; }
              if (kind == 0) { P.ck = INP(2) + (size_t)slot * DB * ACACHE * DM; P.cv = INP(3) + (size_t)slot * DB * ACACHE * DM; attn_phase<0>(P, lds, wv); }
              else if (kind == 1) { P.ck = INP(4); P.cv = INP(5); attn_phase<1>(P, lds, wv); }
              else { P.ck = INP(7); P.cv = INP(8); attn_phase<2>(P, lds, wv); } }
            xcd_barrier(bar, wv);
            { const bf16_t* wo = (const bf16_t*)(wl + WL_WO);
              pg8::Gemm g{OB, wo, MP, DM, DM}; pg8::StaticOrder S; S.init(MP, DM, G, bx);
              pg8::EpiResid E{HB, SS, 1.0f};
              pg8::gemm_phase<pg8::EpiResid, pg8::StaticOrder, true, true>(lds, g, S, E, wv);
              SEpiResid SE{HB + (size_t)MP * DM, SS + (size_t)MP * 16, 1.0f, (bf16_t*)(ws + WS_XBF)};
              small_gemm<DM, 8, 64, 4, SEpiResid>(lds, OB + (size_t)MP * DM, (const bf16_t*)(wl + WL_WOF), DM, SE, wv); }
            xcd_barrier(bar, wv);
        }
    }
    final_norm_phase(A, wv);
}

extern "C" void kernel_launch(void* const* d_in, const int* in_sizes, int n_in, void* d_out, int out_size, void* d_ws, size_t ws_size, hipStream_t stream) {
    static int grid = 0;
    if (grid == 0) {
        if (n_in != 28 || (size_t)out_size != O_END || ws_size < WS_END) { fprintf(stderr, "kernel_launch: unexpected shapes: n_in %d out %d (want %zu) ws %zu (want %zu)\n", n_in, out_size, (size_t)O_END, ws_size, (size_t)WS_END); grid = -1; return; }
        int dev = 0, cus = 0, per_cu = 0;
        if (hipGetDevice(&dev) != hipSuccess || hipDeviceGetAttribute(&cus, hipDeviceAttributeMultiprocessorCount, dev) != hipSuccess) { grid = -1; return; }
        if (hipFuncSetAttribute((const void*)fwd_kernel, hipFuncAttributeMaxDynamicSharedMemorySize, LDS_BYTES) != hipSuccess) { fprintf(stderr, "kernel_launch: hipFuncSetAttribute failed\n"); grid = -1; return; }
        if (hipOccupancyMaxActiveBlocksPerMultiprocessor(&per_cu, (const void*)fwd_kernel, NWAVES * 64, LDS_BYTES) != hipSuccess || per_cu < 1) fprintf(stderr, "kernel_launch: occupancy query reports %d blocks per CU\n", per_cu);
        (void)hipGetLastError();
        if (cus < 243) { fprintf(stderr, "kernel_launch: %d CUs: the per-phase LDS row table holds 6 units per workgroup (needs >= 243 workgroups)\n", cus); grid = -1; return; }
        grid = cus;
    }
    if (grid < 0) return;
    if (hipMemsetAsync((char*)d_ws + WS_CTL, 0, CTL_ZERO_BYTES, stream) != hipSuccess) { fprintf(stderr, "kernel_launch: memset failed\n"); return; }
    KArgs a{};
    for (int i = 0; i < 28; ++i) a.in[i] = (const float*)d_in[i];
    a.out = (float*)d_out; a.ws = (unsigned char*)d_ws;
    hipLaunchKernelGGL(fwd_kernel, dim3(grid), dim3(NWAVES * 64), LDS_BYTES, stream, a);
    const hipError_t le = hipPeekAtLastError();
    if (le != hipSuccess) fprintf(stderr, "kernel_launch: launch failed: %s\n", hipGetErrorName(le));
}
```

```cpp
#include <hip/hip_runtime.h>
#include <cstdio>
#include <cstdint>
namespace pg8 {
#define PG8_LAS __attribute__((address_space(3)))
typedef unsigned short bf16_t;
typedef short bf16x8 __attribute__((ext_vector_type(8)));
typedef float f32x4 __attribute__((ext_vector_type(4)));
typedef unsigned u32x4 __attribute__((ext_vector_type(4)));
constexpr int BM = 256, BK = 64, HALF = 128, HTB = HALF * BK * 2  , STAGE_BYTES = 8 * HTB, NXCD = 8, WGM = 4;

__host__ __device__ __forceinline__ int lds_byte(int r, int c) { const int st = (r >> 4) * 2 + (c >> 5), rr = r & 15, cc = c & 31, ob = rr * 64 + cc * 2; return st * 1024 + (ob ^ (((ob >> 9) & 1) << 5)); }
__host__ __device__ __forceinline__ void stage_rc(int b, int& R, int& C) { const int st = b / 1024, sb = b % 1024, swz = sb ^ (((sb >> 9) & 1) << 5); R = (st >> 1) * 16 + swz / 64; C = (st & 1) * 32 + (swz % 64) / 2; }
__host__ __device__ __forceinline__ int perm32(int rho) { const int n = rho >> 4, i = rho & 15; return 8 * (i >> 2) + 4 * n + (i & 3); }

struct Unit { int pm, pn; };
struct Gemm { const bf16_t* A; const bf16_t* Bt; int M, N, K; };

struct StaticOrder {
    int nM, nN, nwg, G, c;
    __host__ __device__ void init(int M, int N, int G_, int c_) { nM = M / BM; nN = N / BM; nwg = nM * nN; G = G_; c = c_; }
    __host__ __device__ bool next(int i, Unit& u) const {
        const long L = (long)i * G + c; if (L >= nwg) return false;
        int wgid = (int)L; { const int q = nwg / NXCD, r = nwg % NXCD, xcd = wgid % NXCD, off = wgid / NXCD; wgid = (xcd < r ? xcd * (q + 1) : r * (q + 1) + (xcd - r) * q) + off; }
        const int nig = WGM * nN, gid = wgid / nig, fm = gid * WGM, gsz = (nM - fm) < WGM ? (nM - fm) : WGM;
        u.pm = fm + ((wgid % nig) % gsz); u.pn = (wgid % nig) / gsz; return true;
    }
    __device__ __forceinline__ void a_ready(const Unit&) const {}
    __device__ __forceinline__ void done(const Unit&) const {}
};

__device__ __forceinline__ unsigned cvt_pk_bf16(float lo, float hi) { unsigned r; asm volatile("v_cvt_pk_bf16_f32 %0, %1, %2" : "=v"(r) : "v"(lo), "v"(hi)); return r; }
typedef float f32x2 __attribute__((ext_vector_type(2)));
typedef unsigned u32x2 __attribute__((ext_vector_type(2)));
typedef __bf16 bf16x2_t __attribute__((ext_vector_type(2)));
__device__ __forceinline__ unsigned pkbf(float lo, float hi) { f32x2 v = {lo, hi}; bf16x2_t b = __builtin_convertvector(v, bf16x2_t); return __builtin_bit_cast(unsigned, b); }

__device__ __forceinline__ float xor16_f(float v) { return __builtin_bit_cast(float, __builtin_amdgcn_ds_swizzle(__builtin_bit_cast(int, v), 0x401F)); }
__device__ __forceinline__ float sum_xor32(float v) { const unsigned a = __builtin_bit_cast(unsigned, v); auto r = __builtin_amdgcn_permlane32_swap(a, a, false, false);
    const unsigned r0 = r[0], r1 = r[1]; return __builtin_bit_cast(float, r0) + __builtin_bit_cast(float, r1); }
template <int CTRL> __device__ __forceinline__ float dpp_f(float v) { return __builtin_bit_cast(float, __builtin_amdgcn_update_dpp(0, __builtin_bit_cast(int, v), CTRL, 0xF, 0xF, true)); }
__device__ __forceinline__ float sum_row16(float v) { v += dpp_f<0x128>(v); v += dpp_f<0x124>(v); v += dpp_f<0x122>(v); v += dpp_f<0x121>(v); return v; }
__device__ __forceinline__ float sum_quad(float v) { v += dpp_f<0xB1>(v); v += dpp_f<0x4E>(v); return v; }
__device__ __forceinline__ float row_scale(const float* SS, int row) {
    const f32x4* p = (const f32x4*)(SS + (size_t)row * 16); const f32x4 a = p[0], b = p[1], c = p[2], d = p[3];
    const float s = ((a.x + a.y) + (a.z + a.w)) + ((b.x + b.y) + (b.z + b.w)) + ((c.x + c.y) + (c.z + c.w)) + ((d.x + d.y) + (d.z + d.w));
    return __builtin_amdgcn_rsqf(s * (1.0f / 1024.0f) + 1e-6f);
}
__device__ __forceinline__ void row_scales8(const float* SS, int row0, int fq, float (&rs)[2][4]) {
    f32x4 t[2][4];
#pragma unroll
    for (int ai = 0; ai < 2; ++ai)
#pragma unroll
        for (int m = 0; m < 4; ++m) t[ai][m] = *(const f32x4*)(SS + (size_t)(row0 + ai * HALF + m * 16) * 16 + 4 * fq);
#pragma unroll
    for (int ai = 0; ai < 2; ++ai)
#pragma unroll
        for (int m = 0; m < 4; ++m) { float s = (t[ai][m].x + t[ai][m].y) + (t[ai][m].z + t[ai][m].w); s += xor16_f(s); s = sum_xor32(s); rs[ai][m] = __builtin_amdgcn_rsqf(s * (1.0f / 1024.0f) + 1e-6f); }
}
__device__ __forceinline__ void row_scales8_ms(const float* SS, int row0, int fq, float (&rs)[2][4], float (&ms)[2][4]) {
    f32x4 t[2][4];
#pragma unroll
    for (int ai = 0; ai < 2; ++ai)
#pragma unroll
        for (int m = 0; m < 4; ++m) t[ai][m] = *(const f32x4*)(SS + (size_t)(row0 + ai * HALF + m * 16) * 16 + 4 * fq);
#pragma unroll
    for (int ai = 0; ai < 2; ++ai)
#pragma unroll
        for (int m = 0; m < 4; ++m) { float s = (t[ai][m].x + t[ai][m].y) + (t[ai][m].z + t[ai][m].w); s += xor16_f(s); s = sum_xor32(s); ms[ai][m] = s * (1.0f / 1024.0f) + 1e-6f; rs[ai][m] = __builtin_amdgcn_rsqf(ms[ai][m]); }
}
template <class Sched>
__device__ __forceinline__ void ms_prepass(PG8_LAS float* msl, const Sched& S, const float* SS, int tid) {
    f32x4 t[3][4]; bool ok[3]; Unit u;
#pragma unroll
    for (int k = 0; k < 3; ++k) { const int idx = tid + 512 * k; ok[k] = S.next(idx >> 8, u);
        if (ok[k]) { const f32x4* p = (const f32x4*)(SS + (size_t)(u.pm * BM + (idx & 255)) * 16); t[k][0] = p[0]; t[k][1] = p[1]; t[k][2] = p[2]; t[k][3] = p[3]; } }
#pragma unroll
    for (int k = 0; k < 3; ++k) if (ok[k]) { const f32x4 a = t[k][0], b = t[k][1], c = t[k][2], d = t[k][3];
        const float s = ((a.x + a.y) + (a.z + a.w)) + ((b.x + b.y) + (b.z + b.w)) + ((c.x + c.y) + (c.z + c.w)) + ((d.x + d.y) + (d.z + d.w));
        msl[tid + 512 * k] = s * (1.0f / 1024.0f) + 1e-6f; }
    asm volatile("s_waitcnt lgkmcnt(0)" ::: "memory"); __builtin_amdgcn_s_barrier();
}
struct EpiSwiGLU {
    static constexpr bool PERM = true, AFTER_DRAIN = false;
    bf16_t* act; int ldc; PG8_LAS float* msl; int mp; mutable int ord; const float* SS;
    template <class Sched> __device__ __forceinline__ void begin(const Sched& S, int tid) const { ms_prepass(msl, S, SS, tid); }
    __device__ __forceinline__ void operator()(const f32x4 (&acc)[2][2][4][2], const Unit& u, int wr, int wc, int fr, int fq) const {
        const int row0 = u.pm * BM + wr * 64 + fr, col0 = u.pn * HALF + wc * 32 + 8 * fq;
        const PG8_LAS float* mq = msl + ord * 256 + wr * 64 + fr; ++ord;
        float rsv[2][4], msv[2][4];
#pragma unroll
        for (int ai = 0; ai < 2; ++ai)
#pragma unroll
            for (int m = 0; m < 4; ++m) { msv[ai][m] = mq[ai * HALF + m * 16]; rsv[ai][m] = __builtin_amdgcn_rsqf(msv[ai][m]); }
#pragma unroll
        for (int ai = 0; ai < 2; ++ai)
#pragma unroll
            for (int m = 0; m < 4; ++m) {
                const int row = row0 + ai * HALF + m * 16; const float ms = msv[ai][m], ce = -1.4426950408889634f * rsv[ai][m];
                bf16_t* rowp = (u.pm * BM >= mp) ? act + (size_t)mp * ldc + ((size_t)((row - mp) >> 4) * (ldc >> 5) + (col0 >> 5)) * 512 + (fq * 16 + fr) * 8 : act + (size_t)row * ldc + col0;
                float o[8];
#pragma unroll
                for (int n = 0; n < 2; ++n)
#pragma unroll
                    for (int e = 0; e < 4; ++e) { const float g = acc[ai][0][m][n][e], up = acc[ai][1][m][n][e];
                        const float t = __builtin_amdgcn_exp2f(g * ce); const float s = __builtin_amdgcn_rcpf(__builtin_fmaf(t, ms, ms)); o[n * 4 + e] = (g * up) * s; }
                u32x4 w; w.x = pkbf(o[0], o[1]); w.y = pkbf(o[2], o[3]); w.z = pkbf(o[4], o[5]); w.w = pkbf(o[6], o[7]);
                *(u32x4*)rowp = w; }
    }
};
__device__ __forceinline__ float bflo(unsigned w) { return __builtin_bit_cast(float, w << 16); }
__device__ __forceinline__ float bfhi(unsigned w) { return __builtin_bit_cast(float, w & 0xffff0000u); }
struct EpiResid {
    static constexpr bool PERM = true, AFTER_DRAIN = false;
    bf16_t* xb; float* SS; float c;
    template <class Sched> __device__ __forceinline__ void begin(const Sched&, int) const {}
    __device__ __forceinline__ void operator()(const f32x4 (&acc)[2][2][4][2], const Unit& u, int wr, int wc, int fr, int fq) const {
        const int row0 = u.pm * BM + wr * 64 + fr, col0 = u.pn * BM + wc * 32 + 8 * fq;
        u32x4 in[2][4][2];
#pragma unroll
        for (int ai = 0; ai < 2; ++ai)
#pragma unroll
            for (int m = 0; m < 4; ++m)
#pragma unroll
                for (int bj = 0; bj < 2; ++bj) in[ai][m][bj] = *(const u32x4*)(xb + (size_t)(row0 + ai * HALF + m * 16) * 1024 + col0 + bj * HALF);
        asm volatile("" ::: "memory");
#pragma unroll
        for (int ai = 0; ai < 2; ++ai)
#pragma unroll
            for (int m = 0; m < 4; ++m) { const int row = row0 + ai * HALF + m * 16; bf16_t* p = xb + (size_t)row * 1024 + col0; float ss = 0.f;
#pragma unroll
                for (int bj = 0; bj < 2; ++bj) { const u32x4 iv = in[ai][m][bj]; const f32x4 a0 = acc[ai][bj][m][0], a1 = acc[ai][bj][m][1];
                    const float x0 = __builtin_fmaf(a0[0], c, bflo(iv.x)), x1 = __builtin_fmaf(a0[1], c, bfhi(iv.x)), x2 = __builtin_fmaf(a0[2], c, bflo(iv.y)), x3 = __builtin_fmaf(a0[3], c, bfhi(iv.y));
                    const float x4 = __builtin_fmaf(a1[0], c, bflo(iv.z)), x5 = __builtin_fmaf(a1[1], c, bfhi(iv.z)), x6 = __builtin_fmaf(a1[2], c, bflo(iv.w)), x7 = __builtin_fmaf(a1[3], c, bfhi(iv.w));
                    u32x4 w; w.x = pkbf(x0, x1); w.y = pkbf(x2, x3); w.z = pkbf(x4, x5); w.w = pkbf(x6, x7);
                    *(u32x4*)(p + bj * HALF) = w;
                    ss += ((x0 * x0 + x1 * x1) + (x2 * x2 + x3 * x3)) + ((x4 * x4 + x5 * x5) + (x6 * x6 + x7 * x7)); }
                ss += xor16_f(ss); ss = sum_xor32(ss);
                if (fq == 0) SS[(size_t)row * 16 + u.pn * 4 + wc] = ss; }
    }
};
struct EpiQKV {
    static constexpr bool PERM = true, AFTER_DRAIN = false;
    bf16_t* qkv; size_t tstride; float qscale;
    PG8_LAS float* msl; mutable int ord; const float* SS;
    template <class Sched> __device__ __forceinline__ void begin(const Sched& S, int tid) const { ms_prepass(msl, S, SS, tid); }
    __device__ __forceinline__ void operator()(const f32x4 (&acc)[2][2][4][2], const Unit& u, int wr, int wc, int fr, int fq) const {
        typedef __attribute__((address_space(1))) unsigned char gbyte;
        const int t = u.pn >> 2; const int colt = (u.pn & 3) * BM;
        gbyte* bb = (gbyte*)(qkv + (size_t)t * tstride + (size_t)u.pm * BM * 1024); const float sc = (t == 0) ? qscale : 1.0f;
        const PG8_LAS float* mq = msl + ord * 256 + wr * 64 + fr; ++ord;
        float rsv[2][4];
#pragma unroll
        for (int ai = 0; ai < 2; ++ai)
#pragma unroll
            for (int m = 0; m < 4; ++m) rsv[ai][m] = __builtin_amdgcn_rsqf(mq[ai * HALF + m * 16]);
        const unsigned loff = (unsigned)((wr * 64 + fr) * 1024 + colt + wc * 32 + 8 * fq);
#pragma unroll
        for (int ai = 0; ai < 2; ++ai)
#pragma unroll
            for (int m = 0; m < 4; ++m) { const unsigned o = loff + (unsigned)((ai * HALF + m * 16) * 1024); const float rs = rsv[ai][m], scq = sc * rs;
#pragma unroll
                for (int bj = 0; bj < 2; ++bj) { const f32x4 v0 = acc[ai][bj][m][0] * scq, v1 = acc[ai][bj][m][1] * scq;
                    u32x4 w; w.x = pkbf(v0[0], v0[1]); w.y = pkbf(v0[2], v0[3]); w.z = pkbf(v1[0], v1[1]); w.w = pkbf(v1[2], v1[3]);
                    *(__attribute__((address_space(1))) u32x4*)(bb + (size_t)(o + bj * HALF) * 2) = w;
                }
                if (m & 1) asm volatile("" ::: "memory"); }
    }
};
template <class Epi, class Sched, bool ALIGN_EPI = false, bool SP2 = false>
__device__ __forceinline__ void gemm_phase(PG8_LAS unsigned char* lds, const Gemm g, const Sched& S, const Epi& E, const int wv) {
    int lane; asm volatile("v_mbcnt_lo_u32_b32 %0, -1, 0\n\tv_mbcnt_hi_u32_b32 %0, -1, %0" : "=v"(lane)); int wid = wv; asm volatile("" : "+s"(wid)); const int tid = wid * 64 + lane, wr = wid >> 2, wc = wid & 3, fr = lane & 15, fq = lane >> 4;
    const int K = g.K, nt = K / BK;
    unsigned voffA[2], voffB[2];
#pragma unroll
    for (int i = 0; i < 2; ++i) { int R, C; stage_rc(tid * 16 + i * 8192, R, C); const int Rb = Epi::PERM ? ((R & ~31) + perm32(R & 31)) : R;
        voffA[i] = (unsigned)(R * K + C) * 2u; voffB[i] = (unsigned)(Rb * K + C) * 2u; }
    const size_t kstep = (size_t)(BK * 2);
    const size_t hstep = (size_t)HALF * K * 2;
    const size_t tstep = 2 * hstep;
    const unsigned ldsw = (unsigned)wid * 1024u;
    const int aoff = lds_byte(wr * 64 + fr, fq * 8), boff = lds_byte(wc * 32 + fr, fq * 8);
#define PG8_SA(b, h) (((b) * 2 + (h)) * HTB)
#define PG8_SB(b, h) ((4 + (b) * 2 + (h)) * HTB)
#define PG8_STAGE(bufoff, gbase, voff) do { _Pragma("unroll") for (int _i = 0; _i < 2; ++_i) \
        __builtin_amdgcn_global_load_lds((const unsigned*)((const char*)(gbase) + (voff)[_i]), (PG8_LAS unsigned*)(lds + (bufoff) + ldsw + _i * 8192), 16, 0, 0); } while (0)
#define PG8_LDA(dst, b, h) do { _Pragma("unroll") for (int m = 0; m < 4; ++m) _Pragma("unroll") for (int k = 0; k < 2; ++k) dst[m][k] = *(const PG8_LAS bf16x8*)(lds + PG8_SA(b, h) + aoff + m * 2048 + k * 1024); } while (0)
#define PG8_LDB(dst, b, h) do { _Pragma("unroll") for (int n = 0; n < 2; ++n) _Pragma("unroll") for (int k = 0; k < 2; ++k) dst[n][k] = *(const PG8_LAS bf16x8*)(lds + PG8_SB(b, h) + boff + n * 2048 + k * 1024); } while (0)
#define PG8_MMA(ai, bj, At, Bt) do { __builtin_amdgcn_s_setprio(1); _Pragma("unroll") for (int m = 0; m < 4; ++m) _Pragma("unroll") for (int n = 0; n < 2; ++n) _Pragma("unroll") for (int k = 0; k < 2; ++k) \
        acc[ai][bj][m][n] = __builtin_amdgcn_mfma_f32_16x16x32_bf16(Bt[n][k], At[m][k], acc[ai][bj][m][n], 0, 0, 0); __builtin_amdgcn_s_setprio(0); } while (0)
#define PG8_WAIT_V(n) asm volatile("s_waitcnt vmcnt(" #n ")" ::: "memory")
#define PG8_WAIT_L(n) asm volatile("s_waitcnt lgkmcnt(" #n ")" ::: "memory")
#define PG8_BAR __builtin_amdgcn_s_barrier()
#define PG8_SCHED __builtin_amdgcn_sched_barrier(0)
    Unit cur, nxt; int ui = 0;
    if (!S.next(0, cur)) return;
    f32x4 acc[2][2][4][2];
#pragma unroll
    for (int a = 0; a < 2; ++a)
#pragma unroll
        for (int b = 0; b < 2; ++b)
#pragma unroll
            for (int m = 0; m < 4; ++m)
#pragma unroll
                for (int n = 0; n < 2; ++n) acc[a][b][m][n] = (f32x4){0.f, 0.f, 0.f, 0.f};
    bf16x8 At[4][2], B0[2][2], B1[2][2];
    const char* cA = (const char*)g.A + (size_t)cur.pm * tstep; const char* cB = (const char*)g.Bt + (size_t)cur.pn * tstep;
    S.a_ready(cur);
    if constexpr (SP2) {
        PG8_STAGE(PG8_SB(0, 0), cB, voffB); PG8_STAGE(PG8_SB(0, 1), cB + hstep, voffB); PG8_STAGE(PG8_SA(0, 0), cA, voffA); PG8_STAGE(PG8_SA(0, 1), cA + hstep, voffA);
        E.begin(S, tid);
        if (wr == 1) PG8_BAR;
        PG8_WAIT_V(2); PG8_BAR;
        PG8_STAGE(PG8_SB(1, 0), cB + kstep, voffB); PG8_STAGE(PG8_SA(1, 0), cA + kstep, voffA); PG8_STAGE(PG8_SB(1, 1), cB + hstep + kstep, voffB);
        PG8_WAIT_V(6); PG8_BAR;
    } else {
        PG8_STAGE(PG8_SB(0, 0), cB, voffB); PG8_STAGE(PG8_SA(0, 0), cA, voffA); PG8_STAGE(PG8_SB(0, 1), cB + hstep, voffB); PG8_STAGE(PG8_SA(0, 1), cA + hstep, voffA);
        if (wr == 1) PG8_BAR;
        PG8_WAIT_V(4); PG8_BAR;
        PG8_STAGE(PG8_SB(1, 0), cB + kstep, voffB); PG8_STAGE(PG8_SA(1, 0), cA + kstep, voffA); PG8_STAGE(PG8_SB(1, 1), cB + hstep + kstep, voffB);
        PG8_WAIT_V(6); PG8_BAR;
    }
    for (;;) {
        const bool has_next = S.next(ui + 1, nxt);
        const char* nA = has_next ? (const char*)g.A + (size_t)nxt.pm * tstep : cA; const char* nB = has_next ? (const char*)g.Bt + (size_t)nxt.pn * tstep : cB;
        for (int t = 0; t < nt; t += 2) {
            const bool last = (t == nt - 2);
            const char* a1 = cA + (size_t)(t + 1) * kstep;
            const char* a2 = last ? nA : cA + (size_t)(t + 2) * kstep; const char* b2 = last ? nB : cB + (size_t)(t + 2) * kstep;
            const char* a3 = a2 + kstep; const char* b3 = b2 + kstep;
            if (last && has_next) S.a_ready(nxt);
            if constexpr (SP2) {
            PG8_LDB(B0, 0, 0); PG8_LDB(B1, 0, 1); PG8_SCHED; PG8_LDA(At, 0, 0); PG8_STAGE(PG8_SA(1, 1), a1 + hstep, voffA);
            PG8_WAIT_V(8); PG8_WAIT_L(0); PG8_BAR; PG8_MMA(0, 0, At, B0); PG8_MMA(0, 1, At, B1); PG8_BAR; PG8_SCHED;
            PG8_LDA(At, 0, 1); PG8_STAGE(PG8_SB(0, 0), b2, voffB); PG8_STAGE(PG8_SB(0, 1), b2 + hstep, voffB); PG8_STAGE(PG8_SA(0, 0), a2, voffA);
            PG8_WAIT_V(8); PG8_WAIT_L(0); PG8_BAR; PG8_MMA(1, 0, At, B0); PG8_MMA(1, 1, At, B1); PG8_BAR; PG8_SCHED;
            PG8_LDB(B0, 1, 0); PG8_LDB(B1, 1, 1); PG8_SCHED; PG8_LDA(At, 1, 0); PG8_STAGE(PG8_SA(0, 1), a2 + hstep, voffA);
            PG8_WAIT_V(8); PG8_WAIT_L(0); PG8_BAR; PG8_MMA(0, 0, At, B0); PG8_MMA(0, 1, At, B1); PG8_BAR; PG8_SCHED;
            PG8_LDA(At, 1, 1); PG8_STAGE(PG8_SB(1, 0), b3, voffB); PG8_STAGE(PG8_SB(1, 1), b3 + hstep, voffB); PG8_STAGE(PG8_SA(1, 0), a3, voffA);
            PG8_WAIT_V(8); PG8_WAIT_L(0); PG8_BAR; PG8_MMA(1, 0, At, B0); PG8_MMA(1, 1, At, B1); PG8_BAR; PG8_SCHED;
            } else {
            PG8_LDB(B0, 0, 0); PG8_SCHED; PG8_LDA(At, 0, 0); PG8_STAGE(PG8_SA(1, 1), a1 + hstep, voffA);
            PG8_WAIT_L(8); PG8_BAR; PG8_WAIT_L(0); PG8_MMA(0, 0, At, B0); PG8_BAR; PG8_SCHED;
            PG8_LDB(B1, 0, 1); PG8_STAGE(PG8_SB(0, 0), b2, voffB);
            PG8_BAR; PG8_WAIT_L(0); PG8_MMA(0, 1, At, B1); PG8_BAR;
            PG8_LDA(At, 0, 1); PG8_STAGE(PG8_SA(0, 0), a2, voffA);
            PG8_BAR; PG8_WAIT_L(0); PG8_MMA(1, 0, At, B0); PG8_BAR; PG8_SCHED;
            PG8_STAGE(PG8_SB(0, 1), b2 + hstep, voffB);
            PG8_WAIT_V(6); PG8_BAR; PG8_MMA(1, 1, At, B1); PG8_BAR;
            PG8_LDB(B0, 1, 0); PG8_SCHED; PG8_LDA(At, 1, 0); PG8_STAGE(PG8_SA(0, 1), a2 + hstep, voffA);
            PG8_WAIT_L(8); PG8_BAR; PG8_WAIT_L(0); PG8_MMA(0, 0, At, B0); PG8_BAR; PG8_SCHED;
            PG8_LDB(B1, 1, 1); PG8_STAGE(PG8_SB(1, 0), b3, voffB);
            PG8_BAR; PG8_WAIT_L(0); PG8_MMA(0, 1, At, B1); PG8_BAR;
            PG8_LDA(At, 1, 1); PG8_STAGE(PG8_SA(1, 0), a3, voffA);
            PG8_BAR; PG8_WAIT_L(0); PG8_MMA(1, 0, At, B0); PG8_BAR; PG8_SCHED;
            PG8_STAGE(PG8_SB(1, 1), b3 + hstep, voffB);
            PG8_WAIT_V(6); PG8_BAR; PG8_MMA(1, 1, At, B1); PG8_BAR;
            }
        }
        if constexpr (ALIGN_EPI) { if (wr == 0) PG8_BAR; }
        if constexpr (!Epi::AFTER_DRAIN) { E(acc, cur, wr, wc, fr, fq); S.done(cur); }
        if (!has_next) break;
#pragma unroll
        for (int a = 0; a < 2; ++a)
#pragma unroll
            for (int b = 0; b < 2; ++b)
#pragma unroll
                for (int m = 0; m < 4; ++m)
#pragma unroll
                    for (int n = 0; n < 2; ++n) acc[a][b][m][n] = (f32x4){0.f, 0.f, 0.f, 0.f};
        cur = nxt; cA = nA; cB = nB; ++ui;
        if constexpr (ALIGN_EPI) { if (wr == 1) PG8_BAR; }
    }
    PG8_WAIT_V(0);
    if constexpr (!ALIGN_EPI) { if (wr == 0) PG8_BAR; }
    PG8_BAR;
    if constexpr (Epi::AFTER_DRAIN) { E.fused(acc, cur, wr, wc, fr, fq, lds, wid, lane); S.done(cur); }
#undef PG8_SA
#undef PG8_SB
#undef PG8_STAGE
#undef PG8_LDA
#undef PG8_LDB
#undef PG8_MMA
#undef PG8_WAIT_V
#undef PG8_WAIT_L
#undef PG8_BAR
#undef PG8_SCHED
}
}
using pg8::bf16_t; using pg8::bf16x8; using pg8::f32x4; using pg8::u32x4; using pg8::pkbf;
typedef float f32x16 __attribute__((ext_vector_type(16)));
typedef short s16x4 __attribute__((ext_vector_type(4)));
typedef short v4i16_t __attribute__((ext_vector_type(4)));
typedef unsigned u32x2 __attribute__((ext_vector_type(2)));

constexpr int DM = 1024, NH = 16, HD = 64, FF = 2816, SEQ = 2048, NB = 8, DB = 32, DS = 16, PAST = 1024, ACACHE = 512, AKEEP = 512, DEPTH = 4;
constexpr int MP = NB * SEQ, MS = DB * DS, M = MP + MS;
constexpr int NREL = 513, TBLP = 520;
constexpr float RMS_EPS = 1e-6f, LOG2E = 1.4426950408889634f, QSCALE = 0.125f * 1.4426950408889634f;
constexpr int NWAVES = 8;
constexpr size_t O_YP = 0, O_YS = O_YP + (size_t)MP * DM, O_AKP = O_YS + (size_t)MS * DM, O_AVP = O_AKP + (size_t)2 * NB * AKEEP * DM, O_AKS = O_AVP + (size_t)2 * NB * AKEEP * DM,
    O_AVS = O_AKS + (size_t)2 * MS * DM, O_BKP = O_AVS + (size_t)2 * MS * DM, O_BVP = O_BKP + (size_t)MP * DM, O_BFP = O_BVP + (size_t)MP * DM, O_BKS = O_BFP + (size_t)MP * NH,
    O_BVS = O_BKS + (size_t)MS * DM, O_BFS = O_BVS + (size_t)MS * DM, O_CKP = O_BFS + (size_t)MS * NH, O_CVP = O_CKP + (size_t)MP * DM, O_CKS = O_CVP + (size_t)MP * DM,
    O_CVS = O_CKS + (size_t)MS * DM, O_END = O_CVS + (size_t)MS * DM;
constexpr size_t MiB = 1u << 20;
constexpr size_t WS_CTL = 0, CTL_ZERO_BYTES = 1 * MiB;
constexpr size_t W_GU = (size_t)2 * FF * DM * 2, W_DN = (size_t)DM * FF * 2, W_QKV = (size_t)3 * DM * DM * 2, W_WO = (size_t)DM * DM * 2;
constexpr size_t WL_GU1 = 0, WL_DN1 = WL_GU1 + W_GU, WL_QKV = WL_DN1 + W_DN, WL_WO = WL_QKV + W_QKV, WL_GU2 = WL_WO + W_WO, WL_DN2 = WL_GU2 + W_GU,
    WL_DN1F = WL_DN2 + W_DN, WL_DN2F = WL_DN1F + W_DN, WL_QKVF = WL_DN2F + W_DN, WL_WOF = WL_QKVF + W_QKV, WL_SIZE = WL_WOF + W_WO;
constexpr int WSLOTS = 2;
constexpr size_t WS_W = 1 * MiB;
constexpr size_t WS_HB = WS_W + WSLOTS * WL_SIZE;
constexpr size_t WS_ACT = WS_HB + (size_t)M * DM * 2;
constexpr size_t WS_QKV = WS_ACT + (size_t)M * FF * 2;
constexpr size_t QKV_T = (size_t)(M + 64) * DM;
constexpr size_t WS_O = WS_QKV + 3 * QKV_T * 2;
constexpr size_t WS_CUMP = WS_O + (size_t)M * DM * 2;
constexpr size_t WS_CUMS = WS_CUMP + (size_t)128 * SEQ * 4;
constexpr size_t WS_TBL = WS_CUMS + (size_t)512 * 1088 * 4;
constexpr size_t WS_SS = WS_TBL + (size_t)2 * 16 * TBLP * 4;
constexpr size_t WS_WFB = WS_SS + (size_t)M * 16 * 4;
constexpr size_t WS_XBF = WS_WFB + (size_t)NH * DM * 2;
constexpr size_t WS_END = WS_XBF + (size_t)MS * DM * 2;
static_assert(WS_W % 256 == 0 && WL_SIZE % 256 == 0 && WS_HB % 256 == 0 && WS_ACT % 256 == 0 && WS_QKV % 256 == 0 && WS_O % 256 == 0 && WS_CUMP % 256 == 0 && WS_CUMS % 256 == 0 && WS_TBL % 256 == 0 && WS_SS % 256 == 0 && WS_WFB % 256 == 0, "ws alignment");
constexpr int CW_BAR = 4096, CW_Q = 8192;
constexpr size_t WS_PTRS = 512 * 1024;
constexpr int RING_BYTES = 131072, MISC_OFF = RING_BYTES + 320, LDS_BYTES = 147456, MSL_OFF = RING_BYTES + 1024;
static_assert(MSL_OFF + 6 * 256 * 4 <= LDS_BYTES, "LDS map");
constexpr int KROWB = 144, KTILE = 64 * KROWB, VROWB = 192, VTILE = 64 * VROWB;

__device__ __forceinline__ size_t frag_off(int row, int k, int K) { return ((size_t)(row >> 4) * (K >> 5) + (k >> 5)) * 512 + ((((k & 31) >> 3) * 16 + (row & 15)) * 8 + (k & 7)); }
#define GAS __attribute__((address_space(1)))
#define LAS __attribute__((address_space(3)))
#define LDS_WAIT() asm volatile("s_waitcnt lgkmcnt(0)" ::: "memory")
#define XB_TMO      128
#define XB_XCNT(j)  (256  + 64 * (j))
#define XB_XSUB(j)  (1280 + 64 * (j))
#define XB_XGEN(j)  (2304 + 64 * (j))
#define XB_TOP      3328
#define XB_TOPGEN   3392
#define XCD_BAR_WORDS 3456
#define XB_SPIN_CAP (1u << 18)

__device__ __forceinline__ unsigned xb_ld(unsigned* p)              { return __hip_atomic_load(p, __ATOMIC_RELAXED, __HIP_MEMORY_SCOPE_AGENT); }
__device__ __forceinline__ unsigned xb_add(unsigned* p, unsigned v) { return __hip_atomic_fetch_add(p, v, __ATOMIC_RELAXED, __HIP_MEMORY_SCOPE_AGENT); }
__device__ __forceinline__ unsigned xb_xcc_id() { return (unsigned)__builtin_amdgcn_s_getreg((3 << 11) | 20) & 0xFu; }
#define XB_SPIN(cond, bar) do { unsigned _sp = 0; while (cond) { __builtin_amdgcn_s_sleep(1); \
    if ((++_sp & 255u) == 0u) { if (xb_ld(&(bar)[XB_TMO])) break; if (_sp > XB_SPIN_CAP) { atomicAdd(&(bar)[XB_TMO], 1u); break; } } } } while (0)

struct XcdBarrier {
    unsigned* bar; unsigned x;
    volatile LAS unsigned* st;
};

__device__ __forceinline__ XcdBarrier xcd_barrier_post(unsigned* bar, volatile LAS unsigned* st) {
    XcdBarrier b; b.bar = bar; b.x = xb_xcc_id(); b.st = st;
    if (threadIdx.x == 0) (void)xb_add(&bar[XB_XCNT(b.x)], 1u);
    return b;
}
__device__ __forceinline__ void xcd_barrier_complete(unsigned* bar, unsigned x, unsigned& nloc, unsigned& nx) {
    const unsigned G = gridDim.x * gridDim.y * gridDim.z;
    unsigned sum, cnt, mine, sp = 0u;
    for (;;) {
        sum = 0u; cnt = 0u; mine = 0u;
#pragma unroll
        for (unsigned j = 0; j < 16; ++j) { const unsigned c = xb_ld(&bar[XB_XCNT(j)]); sum += c; cnt += (c > 0u) ? 1u : 0u; mine = (j == x) ? c : mine; }
        if (sum == G) break;
        __builtin_amdgcn_s_sleep(1);
        if ((++sp & 255u) == 0u) { if (xb_ld(&bar[XB_TMO])) break; if (sp > XB_SPIN_CAP) { atomicAdd(&bar[XB_TMO], 1u); break; } }
    }
    nloc = mine > 0u ? mine : 1u; nx = cnt > 0u ? cnt : 1u;
}

__device__ __forceinline__ int xb_lane() { int l; asm volatile("v_mbcnt_lo_u32_b32 %0, -1, 0\n\tv_mbcnt_hi_u32_b32 %0, -1, %0" : "=v"(l)); return l; }
__device__ __forceinline__ void xcd_barrier(const XcdBarrier& b, const int wv) {
    asm volatile("s_waitcnt vmcnt(0)" ::: "memory");
    __syncthreads();
    if (wv == 0 && xb_lane() == 0) {
        unsigned* bar = b.bar; unsigned bx_id = __builtin_amdgcn_readfirstlane(b.x); asm volatile("" : "+s"(bx_id));
        __builtin_amdgcn_s_waitcnt(0);
        unsigned nloc = b.st[0], nx = b.st[1];
        if (nloc == 0u) { xcd_barrier_complete(bar, bx_id, nloc, nx); b.st[0] = nloc; b.st[1] = nx; }
        const unsigned old = xb_add(&bar[XB_XSUB(bx_id)], 1u);
        const unsigned gen = old / nloc;
        if (old + 1u == (gen + 1u) * nloc) {
            __builtin_amdgcn_fence(__ATOMIC_RELEASE, "agent");
            asm volatile("s_waitcnt vmcnt(0)" ::: "memory");
            const unsigned og = xb_add(&bar[XB_TOP], 1u);
            const unsigned tg = og / nx;
            if (og + 1u == (tg + 1u) * nx) xb_add(&bar[XB_TOPGEN], 1u);
            else XB_SPIN(xb_ld(&bar[XB_TOPGEN]) == tg, bar);
            __builtin_amdgcn_fence(__ATOMIC_ACQUIRE, "agent");
            xb_add(&bar[XB_XGEN(bx_id)], 1u);
            asm volatile("s_waitcnt vmcnt(0)" ::: "memory");
        } else {
            XB_SPIN(xb_ld(&bar[XB_XGEN(bx_id)]) == gen, bar);
            __builtin_amdgcn_fence(__ATOMIC_ACQUIRE, "agent");
            asm volatile("s_waitcnt vmcnt(0)" ::: "memory");
        }
    }
    __syncthreads();
}
__device__ __forceinline__ int opaque_lane() { int l; asm volatile("v_mbcnt_lo_u32_b32 %0, -1, 0\n\tv_mbcnt_hi_u32_b32 %0, -1, %0" : "=v"(l)); return l; }
#define PHASE_IDS() const int lane = opaque_lane(); int wave = wv; asm volatile("" : "+s"(wave)); const int tid_ = wave * 64 + lane; \
    const int G_ = gridDim.x, bx_ = blockIdx.x, vcu_ = (G_ % 8 == 0) ? (bx_ % 8) * (G_ / 8) + bx_ / 8 : bx_; const int gw = vcu_ * NWAVES + wave, NGW = G_ * NWAVES; (void)lane; (void)gw; (void)NGW
__device__ __forceinline__ float wave_sum(float v) {
    v = pg8::sum_row16(v); v += pg8::xor16_f(v); return pg8::sum_xor32(v);
}
struct TItem { f32x4 v[8]; float gk[8]; };
__device__ __forceinline__ void titem_load(TItem& T, const float* W, int N, int item, int lane, const float* gain) {
    const int nblk = N / 32, kb = item / nblk, nb = item % nblk, k0 = 64 * kb, n0 = 32 * nb; const int rg = lane >> 3, c4 = lane & 7;
#pragma unroll
    for (int i = 0; i < 8; ++i) T.v[i] = __builtin_nontemporal_load((const __attribute__((address_space(1))) f32x4*)(W + (size_t)(k0 + 8 * i + rg) * N + n0 + 4 * c4));
    if (gain) {
#pragma unroll
        for (int i = 0; i < 8; ++i) T.gk[i] = *(const __attribute__((address_space(1))) float*)(gain + k0 + 8 * i + rg);
    } else {
#pragma unroll
        for (int i = 0; i < 8; ++i) T.gk[i] = 1.0f; }
}
__device__ __forceinline__ void titem_finish(const TItem& T, int K, int N, bf16_t* WT, bf16_t* WTF, int mode, LAS float* scr, int item, int lane) {
    const int nblk = N / 32, kb = item / nblk, nb = item % nblk, k0 = 64 * kb, n0 = 32 * nb; const int rg = lane >> 3, c4 = lane & 7;
#pragma unroll
    for (int i = 0; i < 8; ++i) { LAS float* p = scr + (8 * i + rg) * 33 + 4 * c4; p[0] = T.v[i].x * T.gk[i]; p[1] = T.v[i].y * T.gk[i]; p[2] = T.v[i].z * T.gk[i]; p[3] = T.v[i].w * T.gk[i]; }
    LDS_WAIT(); asm volatile("" ::: "memory");
    const int c = lane & 7;
    const int rbase = (mode == 0) ? n0 : ((n0 >> 7) * 256 + (n0 & 127) + (mode == 2 ? 128 : 0));
#pragma unroll
    for (int j = 0; j < 4; ++j) { const int n = (lane >> 3) + 8 * j; const LAS float* s = scr + (8 * c) * 33 + n;
        u32x4 o; o.x = pkbf(s[0 * 33], s[1 * 33]); o.y = pkbf(s[2 * 33], s[3 * 33]); o.z = pkbf(s[4 * 33], s[5 * 33]); o.w = pkbf(s[6 * 33], s[7 * 33]);
        *(u32x4*)(WT + (size_t)(rbase + n) * K + k0 + 8 * c) = o;
        if (WTF) *(u32x4*)(WTF + frag_off(rbase + n, k0 + 8 * c, K)) = o; }
    LDS_WAIT(); asm volatile("" ::: "memory");
}
struct KArgs { const float* in[28]; float* out; unsigned char* ws; };
struct KA2 { float* out; unsigned char* ws; };
__device__ __forceinline__ const float* uniform_fptr(unsigned long long v) { const unsigned lo = __builtin_amdgcn_readfirstlane((unsigned)v), hi = __builtin_amdgcn_readfirstlane((unsigned)(v >> 32)); return (const float*)(((unsigned long long)hi << 32) | lo); }
#define INP(i) uniform_fptr(((const unsigned long long*)(A.ws + WS_PTRS))[i])

constexpr int CI_G = (DM / 64) * (FF / 32), CI_D = (FF / 64) * (DM / 32), CI_Q = (DM / 64) * (3 * DM / 32), CI_O = (DM / 64) * (DM / 32), CI_L = 4 * CI_G + 2 * CI_D + CI_Q + CI_O;
__device__ __forceinline__ const float* inp_of(const KArgs& A, int i) { return A.in[i]; }
__device__ __forceinline__ const float* inp_of(const KA2& A, int i) { return uniform_fptr(((const unsigned long long*)(A.ws + WS_PTRS))[i]); }
struct CItem { const float* W; const float* gain; bf16_t* WT; bf16_t* WTF; int K, N, mode, r; };
template <class AT>
__device__ __forceinline__ CItem citem_of(const AT& A, int L, int r) {
    const int kind = L % 3, slot = L / 3; unsigned char* wl = A.ws + WS_W + (size_t)(L % WSLOTS) * WL_SIZE; CItem c;
    if (r < CI_G) { c = CItem{inp_of(A, 10) + (size_t)L * DM * FF, inp_of(A, 9) + (size_t)L * DM, (bf16_t*)(wl + WL_GU1), nullptr, DM, FF, 1, r}; return c; } r -= CI_G;
    if (r < CI_G) { c = CItem{inp_of(A, 11) + (size_t)L * DM * FF, inp_of(A, 9) + (size_t)L * DM, (bf16_t*)(wl + WL_GU1), nullptr, DM, FF, 2, r}; return c; } r -= CI_G;
    if (r < CI_D) { c = CItem{inp_of(A, 12) + (size_t)L * FF * DM, nullptr, (bf16_t*)(wl + WL_DN1), (bf16_t*)(wl + WL_DN1F), FF, DM, 0, r}; return c; } r -= CI_D;
    if (r < CI_G) { c = CItem{inp_of(A, 15) + (size_t)L * DM * FF, inp_of(A, 14) + (size_t)L * DM, (bf16_t*)(wl + WL_GU2), nullptr, DM, FF, 1, r}; return c; } r -= CI_G;
    if (r < CI_G) { c = CItem{inp_of(A, 16) + (size_t)L * DM * FF, inp_of(A, 14) + (size_t)L * DM, (bf16_t*)(wl + WL_GU2), nullptr, DM, FF, 2, r}; return c; } r -= CI_G;
    if (r < CI_D) { c = CItem{inp_of(A, 17) + (size_t)L * FF * DM, nullptr, (bf16_t*)(wl + WL_DN2), (bf16_t*)(wl + WL_DN2F), FF, DM, 0, r}; return c; } r -= CI_D;
    const float* wq = (kind == 0) ? inp_of(A, 18) : (kind == 1) ? inp_of(A, 21) : inp_of(A, 25);
    const float* wo = (kind == 0) ? inp_of(A, 19) : (kind == 1) ? inp_of(A, 22) : inp_of(A, 26);
    if (r < CI_Q) { c = CItem{wq + (size_t)slot * DM * 3 * DM, inp_of(A, 13) + (size_t)L * DM, (bf16_t*)(wl + WL_QKV), (bf16_t*)(wl + WL_QKVF), DM, 3 * DM, 0, r}; return c; } r -= CI_Q;
    c = CItem{wo + (size_t)slot * DM * DM, nullptr, (bf16_t*)(wl + WL_WO), (bf16_t*)(wl + WL_WOF), DM, DM, 0, r}; return c;
}
constexpr int CR_D1 = 2 * CI_G, CR_G2 = 2 * CI_G + CI_D, CR_D2 = 4 * CI_G + CI_D, CR_Q = 4 * CI_G + 2 * CI_D, CR_O = CR_Q + CI_Q, CV_NA = CI_D + CI_Q + CI_O, CV_G1A = CI_L / 2 - CV_NA, CV_G1B = 2 * CI_G - CV_G1A;
static_assert(CV_G1A > 0 && CV_G1B > 0, "conversion schedule");
__device__ __forceinline__ int conv_list_len(int kind, int L) { return kind == 0 ? 4 * CI_G : kind == 1 ? CV_NA + (L + 1 < DEPTH ? CV_G1A : 0) : CI_D + (L + 1 < DEPTH ? CV_G1B + 2 * CI_G : 0); }
template <class AT>
__device__ __forceinline__ CItem citem_v(const AT& A, int kind, int L, int v) {
    if (kind == 0) return (v < 2 * CI_G) ? citem_of(A, L, v) : citem_of(A, L, CR_G2 + (v - 2 * CI_G));
    if (kind == 1) {
        if (v < CI_D) return citem_of(A, L, CR_D1 + v);
        if (v < CI_D + CI_Q) return citem_of(A, L, CR_Q + (v - CI_D));
        if (v < CV_NA) return citem_of(A, L, CR_O + (v - CI_D - CI_Q));
        return citem_of(A, L + 1, v - CV_NA); }
    if (v < CI_D) return citem_of(A, L, CR_D2 + v);
    if (v < CI_D + CV_G1B) return citem_of(A, L + 1, CV_G1A + (v - CI_D));
    return citem_of(A, L + 1, CR_G2 + (v - CI_D - CV_G1B));
}
template <class AT>
__device__ __forceinline__ void convert_items(const AT& A, int kind, int L, int first, int hi, int stride, LAS float* scr, int lane) {
    if (first >= hi) return;
    TItem Ta; CItem ca = citem_v(A, kind, L, first); titem_load(Ta, ca.W, ca.N, ca.r, lane, ca.gain);
#pragma unroll 1
    for (int it = first; it < hi; it += stride) {
        TItem Tb; CItem cb = ca; const bool more = it + stride < hi;
        if (more) { cb = citem_v(A, kind, L, it + stride); titem_load(Tb, cb.W, cb.N, cb.r, lane, cb.gain); }
        titem_finish(Ta, ca.K, ca.N, ca.WT, ca.WTF, ca.mode, scr, ca.r, lane);
        if (more) { Ta = Tb; ca = cb; }
    }
}
__device__ __forceinline__ void convert_tail(const KA2& A, LAS unsigned char* lds, int kind, int L, int c0, int nc, const int wv) {
    PHASE_IDS();
    LAS float* scr = (LAS float*)(lds + wave * 16384);
    convert_items(A, kind, L, (bx_ - c0) * NWAVES + wave, conv_list_len(kind, L), nc * NWAVES, scr, lane);
}
__device__ __forceinline__ void prologue_phase(const KArgs& A, LAS unsigned char* lds, const int wv) {
    PHASE_IDS();
    LAS float* scr = (LAS float*)(lds + wave * 16384);
    if (tid_ == 0) { const float** tab = (const float**)(A.ws + WS_PTRS);
#pragma unroll
        for (int i = 0; i < 28; ++i) tab[i] = A.in[i]; }
    convert_items(A, 0, 0, gw, conv_list_len(0, 0), NGW, scr, lane);
    bf16_t* XB = (bf16_t*)(A.ws + WS_HB); float* SS = (float*)(A.ws + WS_SS); bf16_t* XBF = (bf16_t*)(A.ws + WS_XBF);
    for (int m0 = 2 * gw; m0 < M; m0 += 2 * NGW) {
        f32x4 v[2][4];
#pragma unroll
        for (int q = 0; q < 2; ++q) { const int m = m0 + q; const float* src = (m < MP) ? A.in[0] + (size_t)m * DM : A.in[1] + (size_t)(m - MP) * DM;
#pragma unroll
            for (int j = 0; j < 4; ++j) v[q][j] = ((const f32x4*)src)[lane + 64 * j]; }
#pragma unroll
        for (int q = 0; q < 2; ++q) { const int m = m0 + q; u32x2* o8 = (u32x2*)(XB + (size_t)m * DM) + lane; float s = 0.f;
#pragma unroll
            for (int j = 0; j < 4; ++j) { u32x2 w; w.x = pkbf(v[q][j].x, v[q][j].y); w.y = pkbf(v[q][j].z, v[q][j].w); o8[64 * j] = w;
                if (m >= MP) *(u32x2*)(XBF + frag_off(m - MP, 4 * (lane + 64 * j), DM)) = w;
                s += (pg8::bflo(w.x) * pg8::bflo(w.x) + pg8::bfhi(w.x) * pg8::bfhi(w.x)) + (pg8::bflo(w.y) * pg8::bflo(w.y) + pg8::bfhi(w.y) * pg8::bfhi(w.y)); }
            s = wave_sum(s);
            if (lane < 16) SS[(size_t)m * 16 + lane] = (lane == 0) ? s : 0.f; }
    }
    { bf16_t* wfb = (bf16_t*)(A.ws + WS_WFB); const float* wf = A.in[23]; const float* gm = A.in[13] + DM;
      for (int i = gw * 64 + lane; i < NH * DM; i += NGW * 64) { const int hh = i / DM, kk = i % DM; wfb[i] = (bf16_t)(pkbf(wf[(size_t)kk * NH + hh] * gm[kk], 0.f) & 0xffffu); } }
    float* tbl = (float*)(A.ws + WS_TBL);
    for (int i = gw * 64 + lane; i < 2 * 16 * NREL; i += NGW * 64) { const int slot = i / (16 * NREL), rem = i % (16 * NREL), h = rem / NREL, idx = rem % NREL;
        tbl[(slot * 16 + h) * TBLP + idx] = A.in[20][((size_t)slot * NREL + idx) * 16 + h] * LOG2E; }
}

__device__ __forceinline__ void fgate_step(const KA2& A, const float* bfv, const int wv) {
    PHASE_IDS();
    const bf16_t* XB = (const bf16_t*)(A.ws + WS_HB); const bf16_t* WFB = (const bf16_t*)(A.ws + WS_WFB); const float* SS = (const float*)(A.ws + WS_SS);
    const float bias = bfv[lane & 15];
    for (int rb = gw; rb < M / 16; rb += NGW) {
        const bf16_t* ap = XB + (size_t)(rb * 16 + (lane & 15)) * DM + 8 * (lane >> 4); const bf16_t* bp = WFB + (size_t)(lane & 15) * DM + 8 * (lane >> 4);
        f32x4 acc = {0.f, 0.f, 0.f, 0.f};
#pragma unroll
        for (int k0 = 0; k0 < DM / 32; k0 += 8) { bf16x8 a[8], b[8];
#pragma unroll
            for (int kk = 0; kk < 8; ++kk) { a[kk] = *(const bf16x8*)(ap + (k0 + kk) * 32); b[kk] = *(const bf16x8*)(bp + (k0 + kk) * 32); }
#pragma unroll
            for (int kk = 0; kk < 8; ++kk) acc = __builtin_amdgcn_mfma_f32_16x16x32_bf16(a[kk], b[kk], acc, 0, 0, 0); }
#pragma unroll
        for (int e = 0; e < 4; ++e) { const int m = rb * 16 + 4 * (lane >> 4) + e; const float z = acc[e] * pg8::row_scale(SS, m) + bias;
            const float lf = fminf(z, 0.f) - 0.6931471805599453f * __builtin_amdgcn_logf(1.0f + __builtin_amdgcn_exp2f(-1.4426950408889634f * fabsf(z)));
            float* dst = (m < MP) ? A.out + O_BFP + (size_t)m * NH : A.out + O_BFS + (size_t)(m - MP) * NH; dst[lane & 15] = lf; }
    }
}
template <int K, int KSPLIT, int CW, int KB, class Epi>
__device__ __forceinline__ void small_gemm(LAS unsigned char* lds, const bf16_t* Af, const bf16_t* Bf, int N, const Epi& E, const int wv) {
    PHASE_IDS();
    constexpr int NCH = 8 / KSPLIT, TN = NCH * CW, KW = K / KSPLIT, NKS = KW / 32, NB = CW / 16, NE = TN / 64;
    static_assert(KW % 32 == 0 && CW % 16 == 0 && TN % 64 == 0 && 8 * 32 * CW * 4 <= RING_BYTES, "small_gemm geometry");
    const int ntn = N / TN, ntiles = (MS / 32) * ntn;
    const int kq = wave % KSPLIT, ch = wave / KSPLIT;
#pragma unroll 1
    for (int tile = bx_; tile < ntiles; tile += G_) {
        const int tm = tile / ntn, tn = tile % ntn;
        const int row = tid_ >> 4, c4 = (tid_ & 15) * 4;
        typename Epi::Pre pre[NE];
#pragma unroll
        for (int q = 0; q < NE; ++q) pre[q] = E.pre(tm * 32 + row, tn * TN + c4 + 64 * q);
        const bf16_t* ap = Af + ((size_t)(tm * 2) * (K / 32) + kq * NKS) * 512 + lane * 8;
        const bf16_t* bp = Bf + ((size_t)((tn * TN + ch * CW) / 16) * (K / 32) + kq * NKS) * 512 + lane * 8;
        f32x4 acc[2][NB];
#pragma unroll
        for (int i = 0; i < 2; ++i)
#pragma unroll
            for (int j = 0; j < NB; ++j) acc[i][j] = (f32x4){0.f, 0.f, 0.f, 0.f};
#pragma unroll
        for (int k0 = 0; k0 < NKS; k0 += KB) {
            bf16x8 a[KB][2], b[KB][NB];
#pragma unroll
            for (int kk = 0; kk < KB; ++kk) if (k0 + kk < NKS) {
#pragma unroll
                for (int i = 0; i < 2; ++i) a[kk][i] = *(const bf16x8*)(ap + (size_t)(i * (K / 32) + k0 + kk) * 512);
#pragma unroll
                for (int j = 0; j < NB; ++j) b[kk][j] = *(const bf16x8*)(bp + (size_t)(j * (K / 32) + k0 + kk) * 512); }
#pragma unroll
            for (int kk = 0; kk < KB; ++kk) if (k0 + kk < NKS) {
#pragma unroll
                for (int i = 0; i < 2; ++i)
#pragma unroll
                    for (int j = 0; j < NB; ++j) acc[i][j] = __builtin_amdgcn_mfma_f32_16x16x32_bf16(a[kk][i], b[kk][j], acc[i][j], 0, 0, 0); }
        }
        LAS float* part = (LAS float*)(lds + wave * (32 * CW * 4));
#pragma unroll
        for (int i = 0; i < 2; ++i)
#pragma unroll
            for (int j = 0; j < NB; ++j)
#pragma unroll
                for (int e = 0; e < 4; ++e) part[(16 * i + 4 * (lane >> 4) + e) * CW + 16 * j + (lane & 15)] = acc[i][j][e];
        __syncthreads();
#pragma unroll
        for (int q = 0; q < NE; ++q) { const int col = c4 + 64 * q, cch = col / CW, cin = col % CW;
            const LAS unsigned char* pb = lds + (size_t)(cch * KSPLIT) * (32 * CW * 4) + (row * CW + cin) * 4;
            f32x4 sum = *(const LAS f32x4*)pb;
#pragma unroll
            for (int w = 1; w < KSPLIT; ++w) sum += *(const LAS f32x4*)(pb + w * (32 * CW * 4));
            E.fin(tm * 32 + row, tn * TN + col, sum, pre[q]); }
        __syncthreads();
    }
}
struct SEpiResid {
    typedef u32x2 Pre;
    bf16_t* xb; float* SS; float c; bf16_t* xbf;
    __device__ __forceinline__ Pre pre(int row, int col) const { return *(const u32x2*)(xb + (size_t)row * DM + col); }
    __device__ __forceinline__ void fin(int row, int col, f32x4 v, const Pre& in) const {
        const size_t off = (size_t)row * DM + col;
        u32x2 w; w.x = pkbf(pg8::bflo(in.x) + v.x * c, pg8::bfhi(in.x) + v.y * c); w.y = pkbf(pg8::bflo(in.y) + v.z * c, pg8::bfhi(in.y) + v.w * c); *(u32x2*)(xb + off) = w; *(u32x2*)(xbf + frag_off(row, col, DM)) = w;
        float ss = (pg8::bflo(w.x) * pg8::bflo(w.x) + pg8::bfhi(w.x) * pg8::bfhi(w.x)) + (pg8::bflo(w.y) * pg8::bflo(w.y) + pg8::bfhi(w.y) * pg8::bfhi(w.y));
        ss = pg8::sum_row16(ss);
        if ((col & 63) == 0) SS[(size_t)row * 16 + (col >> 6)] = ss;
    }
};
struct SEpiQKV {
    typedef f32x4 Pre;
    bf16_t* qkv; size_t tstride; float qscale; float* oks; float* ovs; const float* SS;
    __device__ __forceinline__ Pre pre(int row, int col) const { return *(const f32x4*)(SS + (size_t)row * 16 + (col & 12)); }
    __device__ __forceinline__ void fin(int row, int col, f32x4 v, const Pre& p) const {
        float s = (p.x + p.y) + (p.z + p.w); s = pg8::sum_quad(s);
        const float rs = __builtin_amdgcn_rsqf(s * (1.0f / 1024.0f) + 1e-6f); const int t = col >> 10, c = col & 1023; const float sc = (t == 0) ? qscale * rs : rs;
        u32x2 w; w.x = pkbf(v.x * sc, v.y * sc); w.y = pkbf(v.z * sc, v.w * sc); *(u32x2*)(qkv + (size_t)t * tstride + (size_t)row * DM + c) = w;
        if (t >= 1) { float* o = (t == 1) ? oks : ovs; *(f32x4*)(o + (size_t)row * DM + c) = v * rs; }
    }
};
__device__ __forceinline__ void final_norm_phase(const KA2& A, const int wv) {
    PHASE_IDS();
    const bf16_t* XB = (const bf16_t*)(A.ws + WS_HB); const float* SS = (const float*)(A.ws + WS_SS); const float* gain = INP(27);
    f32x4 g[4];
#pragma unroll
    for (int j = 0; j < 4; ++j) g[j] = ((const f32x4*)gain)[lane + 64 * j];
    for (int m0 = 4 * gw; m0 < M; m0 += 4 * NGW) {
        const float part = SS[(size_t)(m0 + (lane >> 4)) * 16 + (lane & 15)];
        u32x2 w[4][4];
#pragma unroll
        for (int q = 0; q < 4; ++q)
#pragma unroll
            for (int j = 0; j < 4; ++j) w[q][j] = ((const u32x2*)(XB + (size_t)(m0 + q) * DM))[lane + 64 * j];
        const float tot = pg8::sum_row16(part); const float rl = __builtin_amdgcn_rsqf(tot * (1.0f / DM) + RMS_EPS);
#pragma unroll
        for (int q = 0; q < 4; ++q) { const float r = __builtin_bit_cast(float, __builtin_amdgcn_readlane(__builtin_bit_cast(int, rl), 16 * q));
            f32x4* o = (f32x4*)(A.out + O_YP + (size_t)(m0 + q) * DM) + lane;
#pragma unroll
            for (int j = 0; j < 4; ++j) { const f32x4 v = {pg8::bflo(w[q][j].x), pg8::bfhi(w[q][j].x), pg8::bflo(w[q][j].y), pg8::bfhi(w[q][j].y)}; o[64 * j] = v * r * g[j]; } }
    }
}
__device__ __forceinline__ float wave_incl_scan(float v, int lane) {
#pragma unroll
    for (int o = 1; o < 64; o <<= 1) { const float t = __builtin_bit_cast(float, __builtin_amdgcn_ds_bpermute(((lane - o) & 63) << 2, __builtin_bit_cast(int, v))); if (lane >= o) v += t; }
    return v;
}
__device__ __forceinline__ void scan_phase(const KA2& A, const int wv) {
    PHASE_IDS();
    float* cump = (float*)(A.ws + WS_CUMP); float* cums = (float*)(A.ws + WS_CUMS);
    for (int task = gw; task < 128 + 512; task += NGW) {
        if (task < 128) { const int b = task >> 4, h = task & 15; const float* f = A.out + O_BFP + ((size_t)b * SEQ) * NH + h;
            float loc[32]; float run = 0.f;
#pragma unroll
            for (int i = 0; i < 32; ++i) { run += f[(size_t)(32 * lane + i) * NH]; loc[i] = run; }
            const float incl = wave_incl_scan(run, lane); const float off = incl - run;
            float* dst = cump + (size_t)task * SEQ + 32 * lane;
#pragma unroll
            for (int i = 0; i < 32; ++i) dst[i] = (loc[i] + off) * LOG2E;
        } else { const int su = task - 128, b = su >> 4, h = su & 15; const float* f = INP(6) + ((size_t)b * PAST) * NH + h;
            float loc[16]; float run = 0.f;
#pragma unroll
            for (int i = 0; i < 16; ++i) { run += f[(size_t)(16 * lane + i) * NH]; loc[i] = run; }
            const float incl = wave_incl_scan(run, lane); const float off = incl - run;
            float* dst = cums + (size_t)su * 1088;
#pragma unroll
            for (int i = 0; i < 16; ++i) dst[16 * lane + i] = (loc[i] + off) * LOG2E;
            const float total = __builtin_bit_cast(float, __builtin_amdgcn_readlane(__builtin_bit_cast(int, incl), 63));
            const float fn = (lane < 16) ? A.out[O_BFS + (size_t)(b * 16 + lane) * NH + h] : 0.f;
            const float sc = wave_incl_scan(fn, lane);
            if (lane < 16) dst[1024 + lane] = (total + sc) * LOG2E;
        }
    }
}
__device__ __forceinline__ s16x4 vtr(const LAS unsigned char* p) { return __builtin_bit_cast(s16x4, __builtin_amdgcn_ds_read_tr16_b64_v4i16((LAS v4i16_t*)p)); }
struct AttnP {
    const bf16_t* Q; const bf16_t* K; const bf16_t* V; bf16_t* O;
    const float* ck; const float* cv;
    const float* tbl;
    const float* cump; const float* cums;
    unsigned* qctr;
    float* okp; float* ovp;
};
typedef float f32x2 __attribute__((ext_vector_type(2)));
struct AttState { f32x16 o0, o1; float mrun, lsum, R; };
constexpr int AL_KT = 0, AL_VT = 3 * KTILE, AL_AUXP = 3 * KTILE + 2 * VTILE, AL_VS = 0, AL_AUXS = 8 * VTILE, AL_CST = AL_AUXS + 4352, AL_KS1 = AL_CST + 1024, AL_KS2 = RING_BYTES + 1024, KHALF = 32 * KROWB;
static_assert(AL_AUXP + 8192 <= RING_BYTES && AL_KS1 + 5 * KHALF <= RING_BYTES && AL_KS2 + 3 * KHALF <= LDS_BYTES && AL_KS2 >= MISC_OFF + 512 && VTILE >= 4096, "attention LDS map");

__device__ __forceinline__ float max3f(float a, float b, float c) { float r; asm("v_max3_f32 %0, %1, %2, %3" : "=v"(r) : "v"(a), "v"(b), "v"(c)); return r; }
__device__ __forceinline__ float max2f(float a, float b) { float r; asm("v_max_f32_e32 %0, %1, %2" : "=v"(r) : "v"(a), "v"(b)); return r; }
template <int TYPE, bool MASK, bool KMASK, bool FAR>
__device__ __forceinline__ void attn_step(AttState& S, const bf16x8 (&kf)[2][4], const bf16x8 (&qr)[4], const LAS unsigned char* vrd, int kbase, int qpos, int qlim, int klim, int hi, const LAS float* aux, float cfar) {
    f32x16 p0, p1;
    if (TYPE == 0 && !FAR) {
        const LAS float* tb = aux + (384 - qpos + kbase);
#pragma unroll
        for (int r = 0; r < 16; ++r) { const int o = (r & 3) + 8 * (r >> 2); p0[r] = tb[o]; p1[r] = tb[o + 32]; }
    } else if (TYPE == 1) {
#pragma unroll
        for (int gi = 0; gi < 4; ++gi) { const f32x4 c0 = *(const LAS f32x4*)(aux + kbase + 8 * gi), c1 = *(const LAS f32x4*)(aux + kbase + 8 * gi + 32);
#pragma unroll
            for (int e = 0; e < 4; ++e) { p0[4 * gi + e] = c0[e]; p1[4 * gi + e] = c1[e]; } }
    } else if (TYPE == 0 && FAR) {
#pragma unroll
        for (int r = 0; r < 16; ++r) { p0[r] = cfar; p1[r] = cfar; }
    } else { p0 = f32x16{}; p1 = f32x16{}; }
#pragma unroll
    for (int d0 = 0; d0 < 4; ++d0) { p0 = __builtin_amdgcn_mfma_f32_32x32x16_bf16(kf[0][d0], qr[d0], p0, 0, 0, 0); p1 = __builtin_amdgcn_mfma_f32_32x32x16_bf16(kf[1][d0], qr[d0], p1, 0, 0, 0); }
    if (TYPE == 2) {
        float k0[16], k1[16];
#pragma unroll
        for (int r = 0; r < 16; ++r) { const int kp = kbase + (r & 3) + 8 * (r >> 2);
            { const float e = __builtin_amdgcn_exp2f(fminf(p0[r], 100.f)), k = __builtin_amdgcn_rcpf(1.f + e); if (MASK) { const bool v = kp < qlim; k0[r] = v ? k : 1.f; p0[r] = v ? e * k : 0.f; } else { k0[r] = k; p0[r] = e * k; } }
            { const float e = __builtin_amdgcn_exp2f(fminf(p1[r], 100.f)), k = __builtin_amdgcn_rcpf(1.f + e); if (MASK) { const bool v = kp + 32 < qlim; k1[r] = v ? k : 1.f; p1[r] = v ? e * k : 0.f; } else { k1[r] = k; p1[r] = e * k; } } }
        float all[16];
#pragma unroll
        for (int gi = 0; gi < 4; ++gi) {
            const float ga = (k0[4 * gi] * k0[4 * gi + 1]) * (k0[4 * gi + 2] * k0[4 * gi + 3]), gb = (k1[4 * gi] * k1[4 * gi + 1]) * (k1[4 * gi + 2] * k1[4 * gi + 3]);
            auto ra = __builtin_amdgcn_permlane32_swap(__float_as_uint(ga), __float_as_uint(ga), false, false); all[2 * gi] = __uint_as_float(ra[0]); all[2 * gi + 1] = __uint_as_float(ra[1]);
            auto rb = __builtin_amdgcn_permlane32_swap(__float_as_uint(gb), __float_as_uint(gb), false, false); all[8 + 2 * gi] = __uint_as_float(rb[0]); all[8 + 2 * gi + 1] = __uint_as_float(rb[1]); }
        float run = S.R;
#pragma unroll
        for (int gi = 3; gi >= 0; --gi) {
            const float above_odd = run, above_even = run * all[8 + 2 * gi + 1]; float s = hi ? above_odd : above_even; run = above_even * all[8 + 2 * gi];
            p1[4 * gi + 3] *= s; s *= k1[4 * gi + 3]; p1[4 * gi + 2] *= s; s *= k1[4 * gi + 2]; p1[4 * gi + 1] *= s; s *= k1[4 * gi + 1]; p1[4 * gi] *= s; }
#pragma unroll
        for (int gi = 3; gi >= 0; --gi) {
            const float above_odd = run, above_even = run * all[2 * gi + 1]; float s = hi ? above_odd : above_even; run = above_even * all[2 * gi];
            p0[4 * gi + 3] *= s; s *= k0[4 * gi + 3]; p0[4 * gi + 2] *= s; s *= k0[4 * gi + 2]; p0[4 * gi + 1] *= s; s *= k0[4 * gi + 1]; p0[4 * gi] *= s; }
        S.R = run;
    } else {
        if (TYPE == 0 && KMASK) {
#pragma unroll
            for (int r = 0; r < 16; ++r) { const int kp = kbase + (r & 3) + 8 * (r >> 2); p0[r] = (kp < klim) ? p0[r] : -1e30f; p1[r] = (kp + 32 < klim) ? p1[r] : -1e30f; }
        }
        if (TYPE == 1 && MASK) {
#pragma unroll
            for (int r = 0; r < 16; ++r) { const int kp = kbase + (r & 3) + 8 * (r >> 2); p0[r] = (kp <= qlim) ? p0[r] : -1e30f; p1[r] = (kp + 32 <= qlim) ? p1[r] : -1e30f; }
        }
        asm volatile("s_nop 15\n\ts_nop 7" : "+v"(p0), "+v"(p1));
        float tm = max3f(p0[0], p1[0], p0[1]);
#pragma unroll
        for (int r = 1; r < 15; ++r) tm = max3f(tm, p1[r], p0[r + 1]);
        tm = max2f(tm, p1[15]);
        { auto rr = __builtin_amdgcn_permlane32_swap(__float_as_uint(tm), __float_as_uint(tm), false, false); tm = max2f(__uint_as_float(rr[0]), __uint_as_float(rr[1])); }
        if (__any(tm > S.mrun + 8.0f)) {
            const float mt = max2f(S.mrun, tm), alpha = __builtin_amdgcn_exp2f(S.mrun - mt); S.mrun = mt; S.lsum *= alpha;
#pragma unroll
            for (int r = 0; r < 16; ++r) { S.o0[r] *= alpha; S.o1[r] *= alpha; }
        }
        const float mref = S.mrun; float ps = 0.f; const f32x2 m2 = {mref, mref};
#pragma unroll
        for (int r = 0; r < 16; r += 2) { const f32x2 a = (f32x2){p0[r], p0[r + 1]} - m2, bq = (f32x2){p1[r], p1[r + 1]} - m2;
            p0[r] = __builtin_amdgcn_exp2f(a.x); p0[r + 1] = __builtin_amdgcn_exp2f(a.y); p1[r] = __builtin_amdgcn_exp2f(bq.x); p1[r + 1] = __builtin_amdgcn_exp2f(bq.y); }
#pragma unroll
        for (int r = 0; r < 16; ++r) ps += p0[r] + p1[r];
        S.lsum += ps;
    }
    bf16x8 pa[4];
#pragma unroll
    for (int s = 0; s < 2; ++s) {
        u32x4 w0; w0.x = pkbf(p0[8 * s], p0[8 * s + 1]); w0.y = pkbf(p0[8 * s + 2], p0[8 * s + 3]); w0.z = pkbf(p0[8 * s + 4], p0[8 * s + 5]); w0.w = pkbf(p0[8 * s + 6], p0[8 * s + 7]); pa[s] = __builtin_bit_cast(bf16x8, w0);
        u32x4 w1; w1.x = pkbf(p1[8 * s], p1[8 * s + 1]); w1.y = pkbf(p1[8 * s + 2], p1[8 * s + 3]); w1.z = pkbf(p1[8 * s + 4], p1[8 * s + 5]); w1.w = pkbf(p1[8 * s + 6], p1[8 * s + 7]); pa[2 + s] = __builtin_bit_cast(bf16x8, w1); }
#pragma unroll
    for (int ks = 0; ks < 4; ++ks) {
        const s16x4 a0 = vtr(vrd + (16 * ks) * VROWB), a1 = vtr(vrd + (16 * ks + 8) * VROWB), c0 = vtr(vrd + (16 * ks) * VROWB + 64), c1 = vtr(vrd + (16 * ks + 8) * VROWB + 64);
        const bf16x8 v0 = {a0[0], a0[1], a0[2], a0[3], a1[0], a1[1], a1[2], a1[3]}, v1 = {c0[0], c0[1], c0[2], c0[3], c1[0], c1[1], c1[2], c1[3]};
        S.o0 = __builtin_amdgcn_mfma_f32_32x32x16_bf16(v0, pa[ks], S.o0, 0, 0, 0);
        S.o1 = __builtin_amdgcn_mfma_f32_32x32x16_bf16(v1, pa[ks], S.o1, 0, 0, 0); }
}
__device__ __forceinline__ void fill_bias_table(LAS float* aux, const float* tb, int tid) {
    for (int i = tid; i < 640; i += NWAVES * 64) { int d = 384 - i; d = d < -256 ? -256 : (d > 256 ? 256 : d); aux[i] = tb[d + 256]; }
}

template <int TYPE>
__device__ __forceinline__ void kv_out(const AttnP& P, int b, int h, int U, int jt, int srow, int sch, const u32x4 kreg, const u32x4 vreg) {
    if (jt < 4 * U) return;
    if (TYPE == 0 && jt < (SEQ - AKEEP) / 64) return;
    const size_t row = (TYPE == 0) ? (size_t)b * AKEEP + (64 * jt - (SEQ - AKEEP)) + srow : (size_t)b * SEQ + 64 * jt + srow;
    __attribute__((address_space(1))) f32x4* ko = (__attribute__((address_space(1))) f32x4*)(P.okp + row * DM + h * HD + 8 * sch);
    __attribute__((address_space(1))) f32x4* vo = (__attribute__((address_space(1))) f32x4*)(P.ovp + row * DM + h * HD + 8 * sch);
    ko[0] = (f32x4){pg8::bflo(kreg.x), pg8::bfhi(kreg.x), pg8::bflo(kreg.y), pg8::bfhi(kreg.y)}; ko[1] = (f32x4){pg8::bflo(kreg.z), pg8::bfhi(kreg.z), pg8::bflo(kreg.w), pg8::bfhi(kreg.w)};
    vo[0] = (f32x4){pg8::bflo(vreg.x), pg8::bfhi(vreg.x), pg8::bflo(vreg.y), pg8::bfhi(vreg.y)}; vo[1] = (f32x4){pg8::bflo(vreg.z), pg8::bfhi(vreg.z), pg8::bflo(vreg.w), pg8::bfhi(vreg.w)};
}
template <int TYPE>
__device__ __forceinline__ void row_out(float* obase, int b, int h, int U, int jt, int srow, int sch, const u32x4 reg) {
    if (jt < 4 * U) return;
    if (TYPE == 0 && jt < (SEQ - AKEEP) / 64) return;
    const size_t row = (TYPE == 0) ? (size_t)b * AKEEP + (64 * jt - (SEQ - AKEEP)) + srow : (size_t)b * SEQ + 64 * jt + srow;
    __attribute__((address_space(1))) f32x4* o = (__attribute__((address_space(1))) f32x4*)(obase + row * DM + h * HD + 8 * sch);
    o[0] = (f32x4){pg8::bflo(reg.x), pg8::bfhi(reg.x), pg8::bflo(reg.y), pg8::bfhi(reg.y)}; o[1] = (f32x4){pg8::bflo(reg.z), pg8::bfhi(reg.z), pg8::bflo(reg.w), pg8::bfhi(reg.w)};
}
template <int TYPE>
__device__ __forceinline__ void attn_prompt_unit(const AttnP& P, int b, int h, int U, LAS unsigned char* lds, int wave, unsigned nxt, volatile LAS unsigned* slot) {
    const int lane = opaque_lane(), tid = wave * 64 + lane;
    const int r32 = lane & 31, hi = lane >> 5, li = lane & 15;
    const int qblk = 8 * U + wave, c = qblk >> 1, qpos = 32 * qblk + r32;
    const int jlast = 4 * U + 3, jfirst = (TYPE == 0) ? (4 * U > 8 ? 4 * U - 8 : 0) : 0, nt = jlast - jfirst + 1;
    LAS float* aux = (LAS float*)(lds + AL_AUXP);
    if (TYPE == 1) { const float* src = P.cump + (size_t)(b * NH + h) * SEQ; for (int i = tid; i < 256 * (U + 1); i += NWAVES * 64) aux[i] = -src[i]; }
    if (TYPE == 0) fill_bias_table(aux, P.tbl + h * TBLP, tid);
    const float cfar = (TYPE == 0) ? P.tbl[h * TBLP + 512] : 0.f;
    volatile LAS unsigned* dflag = (volatile LAS unsigned*)(lds + MISC_OFF + 256);
    bf16x8 qr[4];
    { const __attribute__((address_space(1))) unsigned char* qb = (const __attribute__((address_space(1))) unsigned char*)(P.Q + (size_t)b * SEQ * DM + h * HD); const unsigned qo = (unsigned)((qpos * DM + 8 * hi) * 2);
#pragma unroll
      for (int d0 = 0; d0 < 4; ++d0) qr[d0] = *(const __attribute__((address_space(1))) bf16x8*)(qb + qo + 32 * d0); }
    const int srow = tid >> 3, sch = tid & 7;
    typedef __attribute__((address_space(1))) const unsigned char gcb;
    gcb* kg = (gcb*)(P.K + (size_t)b * SEQ * DM + h * HD); gcb* vg = (gcb*)(P.V + (size_t)b * SEQ * DM + h * HD);
    const unsigned goff = (unsigned)((srow * DM + 8 * sch) * 2);
#define TILE_LD(base, jj) (*(__attribute__((address_space(1))) const u32x4*)((base) + (size_t)(jj) * (64 * DM * 2) + goff))
    const int soffk = srow * KROWB + 16 * sch, soffv = srow * VROWB + 16 * sch;
#define TIDX(tau) ((TYPE == 2) ? jlast - (tau) : jfirst + (tau))
    { const u32x4 kr0 = TILE_LD(kg, TIDX(0)), kr1 = TILE_LD(kg, TIDX(1)), vr0 = TILE_LD(vg, TIDX(0));
      *(LAS u32x4*)(lds + AL_KT + soffk) = kr0; *(LAS u32x4*)(lds + AL_KT + KTILE + soffk) = kr1; *(LAS u32x4*)(lds + AL_VT + soffv) = vr0;
      row_out<TYPE>(P.okp, b, h, U, TIDX(0), srow, sch, kr0); row_out<TYPE>(P.okp, b, h, U, TIDX(1), srow, sch, kr1); row_out<TYPE>(P.ovp, b, h, U, TIDX(0), srow, sch, vr0); }
    const int grp = wave >> 2, gt = tid & 255, grow = gt >> 3;
    const unsigned ggoff = (unsigned)((grow * DM + 8 * sch) * 2);
#define TILE_LD2(base, jj, half) (*(__attribute__((address_space(1))) const u32x4*)((base) + (size_t)(jj) * (64 * DM * 2) + ggoff + (half) * (32 * DM * 2)))
    const int gsk = grow * KROWB + 16 * sch, gsv = grow * VROWB + 16 * sch;
    u32x4 rk0 = {}, rk1 = {}, rv0 = {}, rv1 = {};
    if (grp == 1) { rk0 = TILE_LD2(kg, TIDX(2), 0); rk1 = TILE_LD2(kg, TIDX(2), 1); rv0 = TILE_LD2(vg, TIDX(1), 0); rv1 = TILE_LD2(vg, TIDX(1), 1); }
    if (tid == 0) slot[1] = nxt;
    __syncthreads();
    AttState S; S.o0 = f32x16{}; S.o1 = f32x16{}; S.mrun = -1e30f; S.lsum = 0.f; S.R = 1.f;
    const int vro = (4 * hi + (li >> 2)) * VROWB + (16 * ((lane >> 4) & 1) + 4 * (li & 3)) * 2, kro = r32 * KROWB + 16 * hi;
    bool done = false;
    bf16x8 kf[2][4];
#pragma unroll
    for (int sub = 0; sub < 2; ++sub)
#pragma unroll
        for (int d0 = 0; d0 < 4; ++d0) kf[sub][d0] = *(const LAS bf16x8*)(lds + AL_KT + kro + sub * 32 * KROWB + 32 * d0);
    int ksl = 0;
#pragma unroll 1
    for (int t = 0; t < nt; ++t) {
        const int j = TIDX(t), bufv = (t & 1) * VTILE;
        const bool mine = ((t ^ grp) & 1) == 0;
        if (mine) __builtin_amdgcn_s_setprio(0); else __builtin_amdgcn_s_setprio(1);
        if (mine) { if (t + 3 < nt) { rk0 = TILE_LD2(kg, TIDX(t + 3), 0); rk1 = TILE_LD2(kg, TIDX(t + 3), 1); }
                    if (t + 2 < nt) { rv0 = TILE_LD2(vg, TIDX(t + 2), 0); rv1 = TILE_LD2(vg, TIDX(t + 2), 1); } }
        const bool active = ((TYPE == 0) ? (j >= c - 8 && j <= c) : (j <= c)) && !done;
        if (active) {
            const LAS unsigned char* vrd = lds + AL_VT + bufv + vro; const int kbase = 64 * j + 4 * hi;
            if (TYPE == 0) { if (64 * c - (64 * j + 63) >= 256) attn_step<0, false, false, true>(S, kf, qr, vrd, kbase, qpos, 0, 0, hi, aux, cfar); else attn_step<0, false, false, false>(S, kf, qr, vrd, kbase, qpos, 0, 0, hi, aux, cfar); }
            else { if (j == c) attn_step<TYPE, true, false, false>(S, kf, qr, vrd, kbase, qpos, qpos, 0, hi, aux, 0.f); else attn_step<TYPE, false, false, false>(S, kf, qr, vrd, kbase, qpos, 0, 0, hi, aux, 0.f); }
            if (TYPE == 2) done = __all(S.R == 0.f);
        }
        const int ksn = (ksl == 2) ? 0 : ksl + 1, ksw = (ksn == 2) ? 0 : ksn + 1;
        if (t + 1 < nt) {
#pragma unroll
            for (int sub = 0; sub < 2; ++sub)
#pragma unroll
                for (int d0 = 0; d0 < 4; ++d0) kf[sub][d0] = *(const LAS bf16x8*)(lds + AL_KT + ksn * KTILE + kro + sub * 32 * KROWB + 32 * d0); }
        if (!mine) {
            if (t + 2 < nt) { *(LAS u32x4*)(lds + AL_KT + ksw * KTILE + gsk) = rk0; *(LAS u32x4*)(lds + AL_KT + ksw * KTILE + gsk + 32 * KROWB) = rk1;
                row_out<TYPE>(P.okp, b, h, U, TIDX(t + 2), grow, sch, rk0); row_out<TYPE>(P.okp, b, h, U, TIDX(t + 2), grow + 32, sch, rk1); }
            if (t + 1 < nt) { *(LAS u32x4*)(lds + AL_VT + (VTILE - bufv) + gsv) = rv0; *(LAS u32x4*)(lds + AL_VT + (VTILE - bufv) + gsv + 32 * VROWB) = rv1;
                row_out<TYPE>(P.ovp, b, h, U, TIDX(t + 1), grow, sch, rv0); row_out<TYPE>(P.ovp, b, h, U, TIDX(t + 1), grow + 32, sch, rv1); } }
        ksl = ksn;
        if (TYPE == 2 && lane == 0) dflag[wave] = done ? 1u : 0u;
        __syncthreads();
        if (TYPE == 2) { unsigned alld = 1u;
#pragma unroll
            for (int w = 0; w < NWAVES; ++w) alld &= dflag[w];
            if (alld && t >= 2) break; }
    }
#undef TIDX
    if (grp) __builtin_amdgcn_s_setprio(1); else __builtin_amdgcn_s_setprio(0);
    float inv = 1.f;
    if (TYPE != 2) { auto rr = __builtin_amdgcn_permlane32_swap(__float_as_uint(S.lsum), __float_as_uint(S.lsum), false, false); inv = 1.0f / (__uint_as_float(rr[0]) + __uint_as_float(rr[1])); }
#undef TILE_LD
#undef TILE_LD2
    { __attribute__((address_space(1))) unsigned char* ob = (__attribute__((address_space(1))) unsigned char*)(P.O + (size_t)b * SEQ * DM + h * HD);
      const int lane2 = opaque_lane(); const unsigned oo = (unsigned)(((32 * qblk + (lane2 & 31)) * DM) * 2 + ((lane2 >> 5) ? 16 : 0));
      u32x2 grp[8];
#pragma unroll
      for (int g = 0; g < 4; ++g) { grp[g].x = pkbf(S.o0[4 * g] * inv, S.o0[4 * g + 1] * inv); grp[g].y = pkbf(S.o0[4 * g + 2] * inv, S.o0[4 * g + 3] * inv);
        grp[4 + g].x = pkbf(S.o1[4 * g] * inv, S.o1[4 * g + 1] * inv); grp[4 + g].y = pkbf(S.o1[4 * g + 2] * inv, S.o1[4 * g + 3] * inv); }
#pragma unroll
      for (int k = 0; k < 8; k += 2) {
          auto rx = __builtin_amdgcn_permlane32_swap(grp[k].x, grp[k + 1].x, false, false); auto ry = __builtin_amdgcn_permlane32_swap(grp[k].y, grp[k + 1].y, false, false);
          const unsigned ax = rx[0], bx2 = rx[1], ay = ry[0], by2 = ry[1];
          u32x4 w; w.x = ax; w.y = ay; w.z = bx2; w.w = by2;
          *(__attribute__((address_space(1))) u32x4*)(ob + oo + 16 * k) = w; } }
}

template <int TYPE>
__device__ __forceinline__ void attn_sample_unit(const AttnP& P, int b, int h, LAS unsigned char* lds, int wave, unsigned nxt, volatile LAS unsigned* slot) {
    const int lane = opaque_lane(), tid = wave * 64 + lane;
    constexpr int NCACHE = (TYPE == 0) ? ACACHE : PAST, NTC = NCACHE / 64, TPW = NTC / 8;
    const int r32 = lane & 31, hi = lane >> 5, li = lane & 15, q16 = r32 & 15;
    const size_t qrow = (size_t)MP + b * DS + q16; const int qpos = NCACHE + q16;
    LAS float* aux = (LAS float*)(lds + AL_AUXS); LAS unsigned char* vl = lds + AL_VS + wave * VTILE; LAS unsigned char* kl = lds + (wave < 5 ? AL_KS1 + wave * KHALF : AL_KS2 + (wave - 5) * KHALF);
    if (TYPE == 1) { const float* src = P.cums + (size_t)(b * NH + h) * 1088; for (int i = tid; i < 1088; i += NWAVES * 64) aux[i] = -src[i]; }
    if (TYPE == 0) fill_bias_table(aux, P.tbl + h * TBLP, tid);
    const float cfar = (TYPE == 0) ? P.tbl[h * TBLP + 512] : 0.f;
    bf16x8 qr[4];
    { const bf16_t* qp = P.Q + qrow * DM + h * HD + 8 * hi;
#pragma unroll
      for (int d0 = 0; d0 < 4; ++d0) qr[d0] = *(const bf16x8*)(qp + 16 * d0); }
    if (tid == 0) slot[1] = nxt;
    __syncthreads();
    AttState S; S.o0 = f32x16{}; S.o1 = f32x16{}; S.mrun = -1e30f; S.lsum = 0.f; S.R = 1.f;
    const int vro = (4 * hi + (li >> 2)) * VROWB + (16 * ((lane >> 4) & 1) + 4 * (li & 3)) * 2;
    const int ntw = TPW + (wave == 7 ? 1 : 0);
#pragma unroll 1
    for (int t = 0; t < ntw; ++t) {
        const int j = (TYPE == 2) ? ((wave + 1) * TPW - 1 + (wave == 7 ? 1 : 0) - t) : (wave * TPW + t);
        bf16x8 kf[2][4];
        if (j == NTC) {
            typedef __attribute__((address_space(1))) const unsigned char gcb2;
            gcb2* kb2 = (gcb2*)(P.K + ((size_t)MP + b * DS) * DM + h * HD); gcb2* vb2 = (gcb2*)(P.V + ((size_t)MP + b * DS) * DM + h * HD);
#pragma unroll
            for (int sub = 0; sub < 2; ++sub) { const int kr = 32 * sub + r32; const unsigned ko = (unsigned)(((kr < DS - 1 ? kr : DS - 1) * DM + 8 * hi) * 2);
#pragma unroll
                for (int d0 = 0; d0 < 4; ++d0) kf[sub][d0] = *(__attribute__((address_space(1))) const bf16x8*)(kb2 + ko + 32 * d0); }
            u32x4 vv[8];
#pragma unroll
            for (int i = 0; i < 8; ++i) { const int row = 8 * i + (lane >> 3); vv[i] = *(__attribute__((address_space(1))) const u32x4*)(vb2 + (unsigned)(((row < DS - 1 ? row : DS - 1) * DM + 8 * (lane & 7)) * 2)); }
#pragma unroll
            for (int i = 0; i < 8; ++i) { const int row = 8 * i + (lane >> 3); *(LAS u32x4*)(vl + row * VROWB + 16 * (lane & 7)) = vv[i]; }
        } else {
            typedef __attribute__((address_space(1))) const unsigned char gcb;
            gcb* kb = (gcb*)(P.ck + (((size_t)b * NCACHE + 64 * j) * NH + h) * HD); gcb* vb = (gcb*)(P.cv + (((size_t)b * NCACHE + 64 * j) * NH + h) * HD);
            const unsigned voff = (unsigned)((lane >> 4) * (NH * HD * 4) + li * 16);
            f32x4 kk[16], vv[16];
#pragma unroll
            for (int i = 0; i < 16; ++i) { gcb* kbi = kb + i * 4 * (NH * HD * 4); kk[i] = *(__attribute__((address_space(1))) const f32x4*)(kbi + voff); }
#pragma unroll
            for (int i = 0; i < 16; ++i) { gcb* vbi = vb + i * 4 * (NH * HD * 4); vv[i] = *(__attribute__((address_space(1))) const f32x4*)(vbi + voff); }
#pragma unroll
            for (int sub = 0; sub < 2; ++sub) {
#pragma unroll
                for (int i = 0; i < 8; ++i) { const int row = 4 * i + (lane >> 4); u32x2 w; w.x = pkbf(kk[8 * sub + i].x, kk[8 * sub + i].y); w.y = pkbf(kk[8 * sub + i].z, kk[8 * sub + i].w); *(LAS u32x2*)(kl + row * KROWB + 8 * li) = w; }
#pragma unroll
                for (int d0 = 0; d0 < 4; ++d0) kf[sub][d0] = *(const LAS bf16x8*)(kl + r32 * KROWB + 16 * hi + 32 * d0);
            }
#pragma unroll
            for (int i = 0; i < 16; ++i) { const int row = 4 * i + (lane >> 4); u32x2 w; w.x = pkbf(vv[i].x, vv[i].y); w.y = pkbf(vv[i].z, vv[i].w); *(LAS u32x2*)(vl + row * VROWB + 8 * li) = w; }
        }
        { const int kbase = 64 * j + 4 * hi; const bool isnew = (j == NTC);
          if (TYPE == 0) { const bool far = (NCACHE - (64 * j + 63)) >= 256;
              if (isnew) attn_step<0, false, true, false>(S, kf, qr, vl + vro, kbase, qpos, 0, NCACHE + DS, hi, aux, cfar);
              else if (far) attn_step<0, false, false, true>(S, kf, qr, vl + vro, kbase, qpos, 0, 0, hi, aux, cfar);
              else attn_step<0, false, false, false>(S, kf, qr, vl + vro, kbase, qpos, 0, 0, hi, aux, cfar); }
          else { if (isnew) attn_step<TYPE, true, false, false>(S, kf, qr, vl + vro, kbase, qpos, qpos, 0, hi, aux, 0.f); else attn_step<TYPE, false, false, false>(S, kf, qr, vl + vro, kbase, qpos, 0, 0, hi, aux, 0.f); } }
    }
    LAS float* comb = (LAS float*)(lds + AL_VS + wave * VTILE); LAS float* cst = (LAS float*)(lds + AL_CST) + wave * 32;
    float ltot = 0.f;
    if (TYPE != 2) { auto rr = __builtin_amdgcn_permlane32_swap(__float_as_uint(S.lsum), __float_as_uint(S.lsum), false, false); ltot = __uint_as_float(rr[0]) + __uint_as_float(rr[1]); }
    if (r32 < 16) {
#pragma unroll
        for (int r = 0; r < 16; ++r) { const int d = (r & 3) + 8 * (r >> 2) + 4 * hi; comb[q16 * 64 + d] = S.o0[r]; comb[q16 * 64 + 32 + d] = S.o1[r]; }
        if (hi == 0) { cst[q16] = (TYPE == 2) ? S.R : S.mrun; cst[16 + q16] = ltot; }
    }
    __syncthreads();
    { const int tid2 = wave * 64 + opaque_lane(); const int q = tid2 >> 5, d2 = (tid2 & 31) * 2; const LAS float* cb = (const LAS float*)(lds + AL_VS); const LAS float* cs = (const LAS float*)(lds + AL_CST);
      float n0 = 0.f, n1 = 0.f;
      if (TYPE == 2) { float f = 1.f;
#pragma unroll
          for (int w = 7; w >= 0; --w) { n0 += f * cb[w * (VTILE / 4) + q * 64 + d2]; n1 += f * cb[w * (VTILE / 4) + q * 64 + d2 + 1]; f *= cs[w * 32 + q]; } }
      else { float mx = cs[q];
#pragma unroll
          for (int w = 1; w < 8; ++w) mx = fmaxf(mx, cs[w * 32 + q]);
          float den = 0.f;
#pragma unroll
          for (int w = 0; w < 8; ++w) { const float f = __builtin_amdgcn_exp2f(cs[w * 32 + q] - mx); den += f * cs[w * 32 + 16 + q]; n0 += f * cb[w * (VTILE / 4) + q * 64 + d2]; n1 += f * cb[w * (VTILE / 4) + q * 64 + d2 + 1]; }
          const float inv = 1.0f / den; n0 *= inv; n1 *= inv; }
      *(unsigned*)(P.O + (size_t)MP * DM + frag_off(b * DS + q, h * HD + d2, DM)) = pkbf(n0, n1); }
    __syncthreads();
}

template <int TYPE>
__device__ __forceinline__ void attn_phase(const AttnP& P, LAS unsigned char* lds, const int wv) {
    PHASE_IDS();
    volatile LAS unsigned* slot = (volatile LAS unsigned*)(lds + MISC_OFF) + 16;
    if (wave >= 4) __builtin_amdgcn_s_setprio(1);
    constexpr unsigned NU = 3 * DB * NH / 8, NS2 = 2 * DB * NH / 8;
    const int xq = bx_ & 7; unsigned* qc = P.qctr + 64 * xq;
    if (tid_ == 0) slot[1] = atomicAdd(qc, 1u);
    __syncthreads();
#pragma unroll 1
    for (;;) {
        const unsigned n = slot[1];
        if (n >= NU) break;
        unsigned nxt = 0u;
        if (tid_ == 0) nxt = atomicAdd(qc, 1u);
        __syncthreads();
        if (n < NS2 && (n & 1u)) { const int s = (int)(n >> 1); attn_sample_unit<TYPE>(P, s >> 1, (s & 1) * 8 + xq, lds, wave, nxt, slot); }
        else { const int p = (n < NS2) ? (int)(n >> 1) : (int)(n - NS2 / 2); const int U = 7 - (p >> 4), bhl = p & 15; attn_prompt_unit<TYPE>(P, bhl >> 1, (bhl & 1) * 8 + xq, U, lds, wave, nxt, slot); }
        __syncthreads();
    }
    __builtin_amdgcn_s_setprio(0);
}
__global__ void __launch_bounds__(NWAVES * 64, 2) fwd_kernel(KArgs A0) {
    extern __shared__ __attribute__((aligned(16))) unsigned char lds_raw[];
    LAS unsigned char* lds = (LAS unsigned char*)lds_raw;
    volatile LAS unsigned* MISC = (volatile LAS unsigned*)(lds + MISC_OFF);
    const int tid = threadIdx.x; const int G0 = gridDim.x, bx0 = blockIdx.x; const int wv = __builtin_amdgcn_readfirstlane(tid >> 6);
    for (int u = tid; u < (LDS_BYTES - RING_BYTES) / 4; u += NWAVES * 64) ((LAS unsigned*)(lds + RING_BYTES))[u] = 0u;
    __syncthreads();
    unsigned* ctl = (unsigned*)(A0.ws + WS_CTL);
    XcdBarrier bar = xcd_barrier_post(ctl + CW_BAR, MISC + 8);
    unsigned char* ws = A0.ws;
    bf16_t* HB = (bf16_t*)(ws + WS_HB); bf16_t* ACT = (bf16_t*)(ws + WS_ACT); bf16_t* QKV = (bf16_t*)(ws + WS_QKV); bf16_t* OB = (bf16_t*)(ws + WS_O);

    float* SS = (float*)(ws + WS_SS);
    prologue_phase(A0, lds, wv);
    xcd_barrier(bar, wv);
    KA2 A; A.out = A0.out; A.ws = A0.ws;

#pragma unroll 1
    for (int step = 0; step < 3 * DEPTH; ++step) {
        const int L = step / 3, sb = step % 3, kind = L % 3, slot = L / 3;
        int G = G0, bx = bx0; asm volatile("" : "+s"(G), "+s"(bx));
        unsigned char* wl = ws + WS_W + (size_t)(L % WSLOTS) * WL_SIZE;
        if (sb != 1) {
            { pg8::Gemm g{HB, (const bf16_t*)(wl + (sb == 0 ? WL_GU1 : WL_GU2)), M, 2 * FF, DM}; pg8::StaticOrder S; S.init(M, 2 * FF, G, bx);
              pg8::EpiSwiGLU E{ACT, FF, (LAS float*)(lds + MSL_OFF), MP, 0, SS};
              pg8::gemm_phase<pg8::EpiSwiGLU, pg8::StaticOrder, true, true>(lds, g, S, E, wv);
              {
                  const int nwg = S.nwg, umax = (nwg + G - 1) / G; int c0 = (nwg % G == 0) ? G : nwg - (umax - 1) * G, nc = G - c0; if (nc < 32) { c0 = 0; nc = G; }
                  if (bx >= c0) convert_tail(A, lds, (sb == 0) ? 1 : 2, L, c0, nc, wv); } }
            xcd_barrier(bar, wv);
            { const bf16_t* wd = (const bf16_t*)(wl + (sb == 0 ? WL_DN1 : WL_DN2));
              pg8::Gemm g{ACT, wd, MP, DM, FF}; pg8::StaticOrder S; S.init(MP, DM, G, bx);
              pg8::EpiResid E{HB, SS, 0.5f};
              pg8::gemm_phase<pg8::EpiResid, pg8::StaticOrder, true, true>(lds, g, S, E, wv);
              SEpiResid SE{HB + (size_t)MP * DM, SS + (size_t)MP * 16, 0.5f, (bf16_t*)(ws + WS_XBF)};
              small_gemm<FF, 8, 64, 6, SEpiResid>(lds, ACT + (size_t)MP * FF, (const bf16_t*)(wl + (sb == 0 ? WL_DN1F : WL_DN2F)), DM, SE, wv); }
            xcd_barrier(bar, wv);
        } else {
            if (kind == 1) fgate_step(A, INP(24) + (size_t)slot * NH, wv);
            { const bf16_t* wq = (const bf16_t*)(wl + WL_QKV);
              float *oks, *ovs;
              if (kind == 0) { oks = A.out + O_AKS + (size_t)slot * MS * DM; ovs = A.out + O_AVS + (size_t)slot * MS * DM; }
              else if (kind == 1) { oks = A.out + O_BKS; ovs = A.out + O_BVS; }
              else { oks = A.out + O_CKS; ovs = A.out + O_CVS; }
              pg8::Gemm g{HB, wq, MP, 3 * DM, DM}; pg8::StaticOrder S; S.init(MP, 3 * DM, G, bx);
              pg8::EpiQKV E;
              E.qkv = QKV; E.tstride = QKV_T; E.qscale = QSCALE; E.msl = (LAS float*)(lds + MSL_OFF); E.ord = 0; E.SS = SS;
              pg8::gemm_phase<pg8::EpiQKV, pg8::StaticOrder, true, true>(lds, g, S, E, wv);
              SEpiQKV SE{QKV + (size_t)MP * DM, QKV_T, QSCALE, oks, ovs, SS + (size_t)MP * 16};
              small_gemm<DM, 4, 96, 4, SEpiQKV>(lds, (const bf16_t*)(ws + WS_XBF), (const bf16_t*)(wl + WL_QKVF), 3 * DM, SE, wv); }
            xcd_barrier(bar, wv);
            if (kind == 1) { scan_phase(A, wv); xcd_barrier(bar, wv); }
            { AttnP P; P.Q = QKV; P.K = QKV + QKV_T; P.V = QKV + 2 * QKV_T; P.O = OB;
              P.tbl = (const float*)(ws + WS_TBL) + (size_t)slot * NH * TBLP; P.cump = (const float*)(ws + WS_CUMP); P.cums = (const float*)(ws + WS_CUMS); P.qctr = ctl + CW_Q + 512 * L;
              if (kind == 0) { P.okp = A.out + O_AKP + (size_t)slot * NB * AKEEP * DM; P.ovp = A.out + O_AVP + (size_t)slot * NB * AKEEP * DM; } else if (kind == 1) { P.okp = A.out + O_BKP; P.ovp = A.out + O_BVP; } else { P.okp = A.out + O_CKP; P.ovp = A.out + O_CVP; }
              if (kind == 0) { P.ck = INP(2) + (size_t)slot * DB * ACACHE * DM; P.cv = INP(3) + (size_t)slot * DB * ACACHE * DM; attn_phase<0>(P, lds, wv); }
              else if (kind == 1) { P.ck = INP(4); P.cv = INP(5); attn_phase<1>(P, lds, wv); }
              else { P.ck = INP(7); P.cv = INP(8); attn_phase<2>(P, lds, wv); } }
            xcd_barrier(bar, wv);
            { const bf16_t* wo = (const bf16_t*)(wl + WL_WO);
              pg8::Gemm g{OB, wo, MP, DM, DM}; pg8::StaticOrder S; S.init(MP, DM, G, bx);
              pg8::EpiResid E{HB, SS, 1.0f};
              pg8::gemm_phase<pg8::EpiResid, pg8::StaticOrder, true, true>(lds, g, S, E, wv);
              SEpiResid SE{HB + (size_t)MP * DM, SS + (size_t)MP * 16, 1.0f, (bf16_t*)(ws + WS_XBF)};
              small_gemm<DM, 8, 64, 4, SEpiResid>(lds, OB + (size_t)MP * DM, (const bf16_t*)(wl + WL_WOF), DM, SE, wv); }
            xcd_barrier(bar, wv);
        }
    }
    final_norm_phase(A, wv);
}

extern "C" void kernel_launch(void* const* d_in, const int* in_sizes, int n_in, void* d_out, int out_size, void* d_ws, size_t ws_size, hipStream_t stream) {
    static int grid = 0;
    if (grid == 0) {
        if (n_in != 28 || (size_t)out_size != O_END || ws_size < WS_END) { fprintf(stderr, "kernel_launch: unexpected shapes: n_in %d out %d (want %zu) ws %zu (want %zu)\n", n_in, out_size, (size_t)O_END, ws_size, (size_t)WS_END); grid = -1; return; }
        int dev = 0, cus = 0, per_cu = 0;
        if (hipGetDevice(&dev) != hipSuccess || hipDeviceGetAttribute(&cus, hipDeviceAttributeMultiprocessorCount, dev) != hipSuccess) { grid = -1; return; }
        if (hipFuncSetAttribute((const void*)fwd_kernel, hipFuncAttributeMaxDynamicSharedMemorySize, LDS_BYTES) != hipSuccess) { fprintf(stderr, "kernel_launch: hipFuncSetAttribute failed\n"); grid = -1; return; }
        if (hipOccupancyMaxActiveBlocksPerMultiprocessor(&per_cu, (const void*)fwd_kernel, NWAVES * 64, LDS_BYTES) != hipSuccess || per_cu < 1) fprintf(stderr, "kernel_launch: occupancy query reports %d blocks per CU\n", per_cu);
        (void)hipGetLastError();
        if (cus < 243) { fprintf(stderr, "kernel_launch: %d CUs: the per-phase LDS row table holds 6 units per workgroup (needs >= 243 workgroups)\n", cus); grid = -1; return; }
        grid = cus;
    }
    if (grid < 0) return;
    if (hipMemsetAsync((char*)d_ws + WS_CTL, 0, CTL_ZERO_BYTES, stream) != hipSuccess) { fprintf(stderr, "kernel_launch: memset failed\n"); return; }
    KArgs a{};
    for (int i = 0; i < 28; ++i) a.in[i] = (const float*)d_in[i];
    a.out = (float*)d_out; a.ws = (unsigned char*)d_ws;
    hipLaunchKernelGGL(fwd_kernel, dim3(grid), dim3(NWAVES * 64), LDS_BYTES, stream, a);
    const hipError_t le = hipPeekAtLastError();
    if (le != hipSuccess) fprintf(stderr, "kernel_launch: launch failed: %s\n", hipGetErrorName(le));
}
```

```cpp
#include <hip/hip_runtime.h>
#include <cstdio>
#include <cstdint>
namespace pg8 {
#define PG8_LAS __attribute__((address_space(3)))
typedef unsigned short bf16_t;
typedef short bf16x8 __attribute__((ext_vector_type(8)));
typedef float f32x4 __attribute__((ext_vector_type(4)));
typedef unsigned u32x4 __attribute__((ext_vector_type(4)));
constexpr int BM = 256, BK = 64, HALF = 128, HTB = HALF * BK * 2  , STAGE_BYTES = 8 * HTB, NXCD = 8, WGM = 4;

__host__ __device__ __forceinline__ int lds_byte(int r, int c) { const int st = (r >> 4) * 2 + (c >> 5), rr = r & 15, cc = c & 31, ob = rr * 64 + cc * 2; return st * 1024 + (ob ^ (((ob >> 9) & 1) << 5)); }
__host__ __device__ __forceinline__ void stage_rc(int b, int& R, int& C) { const int st = b / 1024, sb = b % 1024, swz = sb ^ (((sb >> 9) & 1) << 5); R = (st >> 1) * 16 + swz / 64; C = (st & 1) * 32 + (swz % 64) / 2; }
__host__ __device__ __forceinline__ int perm32(int rho) { const int n = rho >> 4, i = rho & 15; return 8 * (i >> 2) + 4 * n + (i & 3); }

struct Unit { int pm, pn; };
struct Gemm { const bf16_t* A; const bf16_t* Bt; int M, N, K; };

struct StaticOrder {
    int nM, nN, nwg, G, c;
    __host__ __device__ void init(int M, int N, int G_, int c_) { nM = M / BM; nN = N / BM; nwg = nM * nN; G = G_; c = c_; }
    __host__ __device__ bool next(int i, Unit& u) const {
        const long L = (long)i * G + c; if (L >= nwg) return false;
        int wgid = (int)L; { const int q = nwg / NXCD, r = nwg % NXCD, xcd = wgid % NXCD, off = wgid / NXCD; wgid = (xcd < r ? xcd * (q + 1) : r * (q + 1) + (xcd - r) * q) + off; }
        const int nig = WGM * nN, gid = wgid / nig, fm = gid * WGM, gsz = (nM - fm) < WGM ? (nM - fm) : WGM;
        u.pm = fm + ((wgid % nig) % gsz); u.pn = (wgid % nig) / gsz; return true;
    }
    __device__ __forceinline__ void a_ready(const Unit&) const {}
    __device__ __forceinline__ void done(const Unit&) const {}
};

__device__ __forceinline__ unsigned cvt_pk_bf16(float lo, float hi) { unsigned r; asm volatile("v_cvt_pk_bf16_f32 %0, %1, %2" : "=v"(r) : "v"(lo), "v"(hi)); return r; }
typedef float f32x2 __attribute__((ext_vector_type(2)));
typedef unsigned u32x2 __attribute__((ext_vector_type(2)));
typedef __bf16 bf16x2_t __attribute__((ext_vector_type(2)));
__device__ __forceinline__ unsigned pkbf(float lo, float hi) { f32x2 v = {lo, hi}; bf16x2_t b = __builtin_convertvector(v, bf16x2_t); return __builtin_bit_cast(unsigned, b); }

__device__ __forceinline__ float xor16_f(float v) { return __builtin_bit_cast(float, __builtin_amdgcn_ds_swizzle(__builtin_bit_cast(int, v), 0x401F)); }
__device__ __forceinline__ float sum_xor32(float v) { const unsigned a = __builtin_bit_cast(unsigned, v); auto r = __builtin_amdgcn_permlane32_swap(a, a, false, false);
    const unsigned r0 = r[0], r1 = r[1]; return __builtin_bit_cast(float, r0) + __builtin_bit_cast(float, r1); }
template <int CTRL> __device__ __forceinline__ float dpp_f(float v) { return __builtin_bit_cast(float, __builtin_amdgcn_update_dpp(0, __builtin_bit_cast(int, v), CTRL, 0xF, 0xF, true)); }
__device__ __forceinline__ float sum_row16(float v) { v += dpp_f<0x128>(v); v += dpp_f<0x124>(v); v += dpp_f<0x122>(v); v += dpp_f<0x121>(v); return v; }
__device__ __forceinline__ float sum_quad(float v) { v += dpp_f<0xB1>(v); v += dpp_f<0x4E>(v); return v; }
__device__ __forceinline__ float row_scale(const float* SS, int row) {
    const f32x4* p = (const f32x4*)(SS + (size_t)row * 16); const f32x4 a = p[0], b = p[1], c = p[2], d = p[3];
    const float s = ((a.x + a.y) + (a.z + a.w)) + ((b.x + b.y) + (b.z + b.w)) + ((c.x + c.y) + (c.z + c.w)) + ((d.x + d.y) + (d.z + d.w));
    return __builtin_amdgcn_rsqf(s * (1.0f / 1024.0f) + 1e-6f);
}
__device__ __forceinline__ void row_scales8(const float* SS, int row0, int fq, float (&rs)[2][4]) {
    f32x4 t[2][4];
#pragma unroll
    for (int ai = 0; ai < 2; ++ai)
#pragma unroll
        for (int m = 0; m < 4; ++m) t[ai][m] = *(const f32x4*)(SS + (size_t)(row0 + ai * HALF + m * 16) * 16 + 4 * fq);
#pragma unroll
    for (int ai = 0; ai < 2; ++ai)
#pragma unroll
        for (int m = 0; m < 4; ++m) { float s = (t[ai][m].x + t[ai][m].y) + (t[ai][m].z + t[ai][m].w); s += xor16_f(s); s = sum_xor32(s); rs[ai][m] = __builtin_amdgcn_rsqf(s * (1.0f / 1024.0f) + 1e-6f); }
}
__device__ __forceinline__ void row_scales8_ms(const float* SS, int row0, int fq, float (&rs)[2][4], float (&ms)[2][4]) {
    f32x4 t[2][4];
#pragma unroll
    for (int ai = 0; ai < 2; ++ai)
#pragma unroll
        for (int m = 0; m < 4; ++m) t[ai][m] = *(const f32x4*)(SS + (size_t)(row0 + ai * HALF + m * 16) * 16 + 4 * fq);
#pragma unroll
    for (int ai = 0; ai < 2; ++ai)
#pragma unroll
        for (int m = 0; m < 4; ++m) { float s = (t[ai][m].x + t[ai][m].y) + (t[ai][m].z + t[ai][m].w); s += xor16_f(s); s = sum_xor32(s); ms[ai][m] = s * (1.0f / 1024.0f) + 1e-6f; rs[ai][m] = __builtin_amdgcn_rsqf(ms[ai][m]); }
}
template <class Sched>
__device__ __forceinline__ void ms_prepass(PG8_LAS float* msl, const Sched& S, const float* SS, int tid) {
    f32x4 t[3][4]; bool ok[3]; Unit u;
#pragma unroll
    for (int k = 0; k < 3; ++k) { const int idx = tid + 512 * k; ok[k] = S.next(idx >> 8, u);
        if (ok[k]) { const f32x4* p = (const f32x4*)(SS + (size_t)(u.pm * BM + (idx & 255)) * 16); t[k][0] = p[0]; t[k][1] = p[1]; t[k][2] = p[2]; t[k][3] = p[3]; } }
#pragma unroll
    for (int k = 0; k < 3; ++k) if (ok[k]) { const f32x4 a = t[k][0], b = t[k][1], c = t[k][2], d = t[k][3];
        const float s = ((a.x + a.y) + (a.z + a.w)) + ((b.x + b.y) + (b.z + b.w)) + ((c.x + c.y) + (c.z + c.w)) + ((d.x + d.y) + (d.z + d.w));
        msl[tid + 512 * k] = s * (1.0f / 1024.0f) + 1e-6f; }
    asm volatile("s_waitcnt lgkmcnt(0)" ::: "memory"); __builtin_amdgcn_s_barrier();
}
struct EpiSwiGLU {
    static constexpr bool PERM = true, AFTER_DRAIN = false;
    bf16_t* act; int ldc; PG8_LAS float* msl; int mp; mutable int ord; const float* SS;
    template <class Sched> __device__ __forceinline__ void begin(const Sched& S, int tid) const { ms_prepass(msl, S, SS, tid); }
    __device__ __forceinline__ void operator()(const f32x4 (&acc)[2][2][4][2], const Unit& u, int wr, int wc, int fr, int fq) const {
        const int row0 = u.pm * BM + wr * 64 + fr, col0 = u.pn * HALF + wc * 32 + 8 * fq;
        const PG8_LAS float* mq = msl + ord * 256 + wr * 64 + fr; ++ord;
        float rsv[2][4], msv[2][4];
#pragma unroll
        for (int ai = 0; ai < 2; ++ai)
#pragma unroll
            for (int m = 0; m < 4; ++m) { msv[ai][m] = mq[ai * HALF + m * 16]; rsv[ai][m] = __builtin_amdgcn_rsqf(msv[ai][m]); }
#pragma unroll
        for (int ai = 0; ai < 2; ++ai)
#pragma unroll
            for (int m = 0; m < 4; ++m) {
                const int row = row0 + ai * HALF + m * 16; const float ms = msv[ai][m], ce = -1.4426950408889634f * rsv[ai][m];
                bf16_t* rowp = (u.pm * BM >= mp) ? act + (size_t)mp * ldc + ((size_t)((row - mp) >> 4) * (ldc >> 5) + (col0 >> 5)) * 512 + (fq * 16 + fr) * 8 : act + (size_t)row * ldc + col0;
                float o[8];
#pragma unroll
                for (int n = 0; n < 2; ++n)
#pragma unroll
                    for (int e = 0; e < 4; ++e) { const float g = acc[ai][0][m][n][e], up = acc[ai][1][m][n][e];
                        const float t = __builtin_amdgcn_exp2f(g * ce); const float s = __builtin_amdgcn_rcpf(__builtin_fmaf(t, ms, ms)); o[n * 4 + e] = (g * up) * s; }
                u32x4 w; w.x = pkbf(o[0], o[1]); w.y = pkbf(o[2], o[3]); w.z = pkbf(o[4], o[5]); w.w = pkbf(o[6], o[7]);
                *(u32x4*)rowp = w; }
    }
};
__device__ __forceinline__ float bflo(unsigned w) { return __builtin_bit_cast(float, w << 16); }
__device__ __forceinline__ float bfhi(unsigned w) { return __builtin_bit_cast(float, w & 0xffff0000u); }
struct EpiResid {
    static constexpr bool PERM = true, AFTER_DRAIN = false;
    bf16_t* xb; float* SS; float c;
    template <class Sched> __device__ __forceinline__ void begin(const Sched&, int) const {}
    __device__ __forceinline__ void operator()(const f32x4 (&acc)[2][2][4][2], const Unit& u, int wr, int wc, int fr, int fq) const {
        const int row0 = u.pm * BM + wr * 64 + fr, col0 = u.pn * BM + wc * 32 + 8 * fq;
        u32x4 in[2][4][2];
#pragma unroll
        for (int ai = 0; ai < 2; ++ai)
#pragma unroll
            for (int m = 0; m < 4; ++m)
#pragma unroll
                for (int bj = 0; bj < 2; ++bj) in[ai][m][bj] = *(const u32x4*)(xb + (size_t)(row0 + ai * HALF + m * 16) * 1024 + col0 + bj * HALF);
        asm volatile("" ::: "memory");
#pragma unroll
        for (int ai = 0; ai < 2; ++ai)
#pragma unroll
            for (int m = 0; m < 4; ++m) { const int row = row0 + ai * HALF + m * 16; bf16_t* p = xb + (size_t)row * 1024 + col0; float ss = 0.f;
#pragma unroll
                for (int bj = 0; bj < 2; ++bj) { const u32x4 iv = in[ai][m][bj]; const f32x4 a0 = acc[ai][bj][m][0], a1 = acc[ai][bj][m][1];
                    const float x0 = __builtin_fmaf(a0[0], c, bflo(iv.x)), x1 = __builtin_fmaf(a0[1], c, bfhi(iv.x)), x2 = __builtin_fmaf(a0[2], c, bflo(iv.y)), x3 = __builtin_fmaf(a0[3], c, bfhi(iv.y));
                    const float x4 = __builtin_fmaf(a1[0], c, bflo(iv.z)), x5 = __builtin_fmaf(a1[1], c, bfhi(iv.z)), x6 = __builtin_fmaf(a1[2], c, bflo(iv.w)), x7 = __builtin_fmaf(a1[3], c, bfhi(iv.w));
                    u32x4 w; w.x = pkbf(x0, x1); w.y = pkbf(x2, x3); w.z = pkbf(x4, x5); w.w = pkbf(x6, x7);
                    *(u32x4*)(p + bj * HALF) = w;
                    ss += ((x0 * x0 + x1 * x1) + (x2 * x2 + x3 * x3)) + ((x4 * x4 + x5 * x5) + (x6 * x6 + x7 * x7)); }
                ss += xor16_f(ss); ss = sum_xor32(ss);
                if (fq == 0) SS[(size_t)row * 16 + u.pn * 4 + wc] = ss; }
    }
};
struct EpiQKV {
    static constexpr bool PERM = true, AFTER_DRAIN = false;
    bf16_t* qkv; size_t tstride; float qscale;
    PG8_LAS float* msl; mutable int ord; const float* SS;
    template <class Sched> __device__ __forceinline__ void begin(const Sched& S, int tid) const { ms_prepass(msl, S, SS, tid); }
    __device__ __forceinline__ void operator()(const f32x4 (&acc)[2][2][4][2], const Unit& u, int wr, int wc, int fr, int fq) const {
        typedef __attribute__((address_space(1))) unsigned char gbyte;
        const int t = u.pn >> 2; const int colt = (u.pn & 3) * BM;
        gbyte* bb = (gbyte*)(qkv + (size_t)t * tstride + (size_t)u.pm * BM * 1024); const float sc = (t == 0) ? qscale : 1.0f;
        const PG8_LAS float* mq = msl + ord * 256 + wr * 64 + fr; ++ord;
        float rsv[2][4];
#pragma unroll
        for (int ai = 0; ai < 2; ++ai)
#pragma unroll
            for (int m = 0; m < 4; ++m) rsv[ai][m] = __builtin_amdgcn_rsqf(mq[ai * HALF + m * 16]);
        const unsigned loff = (unsigned)((wr * 64 + fr) * 1024 + colt + wc * 32 + 8 * fq);
#pragma unroll
        for (int ai = 0; ai < 2; ++ai)
#pragma unroll
            for (int m = 0; m < 4; ++m) { const unsigned o = loff + (unsigned)((ai * HALF + m * 16) * 1024); const float rs = rsv[ai][m], scq = sc * rs;
#pragma unroll
                for (int bj = 0; bj < 2; ++bj) { const f32x4 v0 = acc[ai][bj][m][0] * scq, v1 = acc[ai][bj][m][1] * scq;
                    u32x4 w; w.x = pkbf(v0[0], v0[1]); w.y = pkbf(v0[2], v0[3]); w.z = pkbf(v1[0], v1[1]); w.w = pkbf(v1[2], v1[3]);
                    *(__attribute__((address_space(1))) u32x4*)(bb + (size_t)(o + bj * HALF) * 2) = w;
                }
                if (m & 1) asm volatile("" ::: "memory"); }
    }
};
template <class Epi, class Sched, bool ALIGN_EPI = false, bool SP2 = false>
__device__ __forceinline__ void gemm_phase(PG8_LAS unsigned char* lds, const Gemm g, const Sched& S, const Epi& E, const int wv) {
    int lane; asm volatile("v_mbcnt_lo_u32_b32 %0, -1, 0\n\tv_mbcnt_hi_u32_b32 %0, -1, %0" : "=v"(lane)); int wid = wv; asm volatile("" : "+s"(wid)); const int tid = wid * 64 + lane, wr = wid >> 2, wc = wid & 3, fr = lane & 15, fq = lane >> 4;
    const int K = g.K, nt = K / BK;
    unsigned voffA[2], voffB[2];
#pragma unroll
    for (int i = 0; i < 2; ++i) { int R, C; stage_rc(tid * 16 + i * 8192, R, C); const int Rb = Epi::PERM ? ((R & ~31) + perm32(R & 31)) : R;
        voffA[i] = (unsigned)(R * K + C) * 2u; voffB[i] = (unsigned)(Rb * K + C) * 2u; }
    const size_t kstep = (size_t)(BK * 2);
    const size_t hstep = (size_t)HALF * K * 2;
    const size_t tstep = 2 * hstep;
    const unsigned ldsw = (unsigned)wid * 1024u;
    const int aoff = lds_byte(wr * 64 + fr, fq * 8), boff = lds_byte(wc * 32 + fr, fq * 8);
#define PG8_SA(b, h) (((b) * 2 + (h)) * HTB)
#define PG8_SB(b, h) ((4 + (b) * 2 + (h)) * HTB)
#define PG8_STAGE(bufoff, gbase, voff) do { _Pragma("unroll") for (int _i = 0; _i < 2; ++_i) \
        __builtin_amdgcn_global_load_lds((const unsigned*)((const char*)(gbase) + (voff)[_i]), (PG8_LAS unsigned*)(lds + (bufoff) + ldsw + _i * 8192), 16, 0, 0); } while (0)
#define PG8_LDA(dst, b, h) do { _Pragma("unroll") for (int m = 0; m < 4; ++m) _Pragma("unroll") for (int k = 0; k < 2; ++k) dst[m][k] = *(const PG8_LAS bf16x8*)(lds + PG8_SA(b, h) + aoff + m * 2048 + k * 1024); } while (0)
#define PG8_LDB(dst, b, h) do { _Pragma("unroll") for (int n = 0; n < 2; ++n) _Pragma("unroll") for (int k = 0; k < 2; ++k) dst[n][k] = *(const PG8_LAS bf16x8*)(lds + PG8_SB(b, h) + boff + n * 2048 + k * 1024); } while (0)
#define PG8_MMA(ai, bj, At, Bt) do { __builtin_amdgcn_s_setprio(1); _Pragma("unroll") for (int m = 0; m < 4; ++m) _Pragma("unroll") for (int n = 0; n < 2; ++n) _Pragma("unroll") for (int k = 0; k < 2; ++k) \
        acc[ai][bj][m][n] = __builtin_amdgcn_mfma_f32_16x16x32_bf16(Bt[n][k], At[m][k], acc[ai][bj][m][n], 0, 0, 0); __builtin_amdgcn_s_setprio(0); } while (0)
#define PG8_WAIT_V(n) asm volatile("s_waitcnt vmcnt(" #n ")" ::: "memory")
#define PG8_WAIT_L(n) asm volatile("s_waitcnt lgkmcnt(" #n ")" ::: "memory")
#define PG8_BAR __builtin_amdgcn_s_barrier()
#define PG8_SCHED __builtin_amdgcn_sched_barrier(0)
    Unit cur, nxt; int ui = 0;
    if (!S.next(0, cur)) return;
    f32x4 acc[2][2][4][2];
#pragma unroll
    for (int a = 0; a < 2; ++a)
#pragma unroll
        for (int b = 0; b < 2; ++b)
#pragma unroll
            for (int m = 0; m < 4; ++m)
#pragma unroll
                for (int n = 0; n < 2; ++n) acc[a][b][m][n] = (f32x4){0.f, 0.f, 0.f, 0.f};
    bf16x8 At[4][2], B0[2][2], B1[2][2];
    const char* cA = (const char*)g.A + (size_t)cur.pm * tstep; const char* cB = (const char*)g.Bt + (size_t)cur.pn * tstep;
    S.a_ready(cur);
    if constexpr (SP2) {
        PG8_STAGE(PG8_SB(0, 0), cB, voffB); PG8_STAGE(PG8_SB(0, 1), cB + hstep, voffB); PG8_STAGE(PG8_SA(0, 0), cA, voffA); PG8_STAGE(PG8_SA(0, 1), cA + hstep, voffA);
        E.begin(S, tid);
        if (wr == 1) PG8_BAR;
        PG8_WAIT_V(2); PG8_BAR;
        PG8_STAGE(PG8_SB(1, 0), cB + kstep, voffB); PG8_STAGE(PG8_SA(1, 0), cA + kstep, voffA); PG8_STAGE(PG8_SB(1, 1), cB + hstep + kstep, voffB);
        PG8_WAIT_V(6); PG8_BAR;
    } else {
        PG8_STAGE(PG8_SB(0, 0), cB, voffB); PG8_STAGE(PG8_SA(0, 0), cA, voffA); PG8_STAGE(PG8_SB(0, 1), cB + hstep, voffB); PG8_STAGE(PG8_SA(0, 1), cA + hstep, voffA);
        if (wr == 1) PG8_BAR;
        PG8_WAIT_V(4); PG8_BAR;
        PG8_STAGE(PG8_SB(1, 0), cB + kstep, voffB); PG8_STAGE(PG8_SA(1, 0), cA + kstep, voffA); PG8_STAGE(PG8_SB(1, 1), cB + hstep + kstep, voffB);
        PG8_WAIT_V(6); PG8_BAR;
    }
    for (;;) {
        const bool has_next = S.next(ui + 1, nxt);
        const char* nA = has_next ? (const char*)g.A + (size_t)nxt.pm * tstep : cA; const char* nB = has_next ? (const char*)g.Bt + (size_t)nxt.pn * tstep : cB;
        for (int t = 0; t < nt; t += 2) {
            const bool last = (t == nt - 2);
            const char* a1 = cA + (size_t)(t + 1) * kstep;
            const char* a2 = last ? nA : cA + (size_t)(t + 2) * kstep; const char* b2 = last ? nB : cB + (size_t)(t + 2) * kstep;
            const char* a3 = a2 + kstep; const char* b3 = b2 + kstep;
            if (last && has_next) S.a_ready(nxt);
            if constexpr (SP2) {
            PG8_LDB(B0, 0, 0); PG8_LDB(B1, 0, 1); PG8_SCHED; PG8_LDA(At, 0, 0); PG8_STAGE(PG8_SA(1, 1), a1 + hstep, voffA);
            PG8_WAIT_V(8); PG8_WAIT_L(0); PG8_BAR; PG8_MMA(0, 0, At, B0); PG8_MMA(0, 1, At, B1); PG8_BAR; PG8_SCHED;
            PG8_LDA(At, 0, 1); PG8_STAGE(PG8_SB(0, 0), b2, voffB); PG8_STAGE(PG8_SB(0, 1), b2 + hstep, voffB); PG8_STAGE(PG8_SA(0, 0), a2, voffA);
            PG8_WAIT_V(8); PG8_WAIT_L(0); PG8_BAR; PG8_MMA(1, 0, At, B0); PG8_MMA(1, 1, At, B1); PG8_BAR; PG8_SCHED;
            PG8_LDB(B0, 1, 0); PG8_LDB(B1, 1, 1); PG8_SCHED; PG8_LDA(At, 1, 0); PG8_STAGE(PG8_SA(0, 1), a2 + hstep, voffA);
            PG8_WAIT_V(8); PG8_WAIT_L(0); PG8_BAR; PG8_MMA(0, 0, At, B0); PG8_MMA(0, 1, At, B1); PG8_BAR; PG8_SCHED;
            PG8_LDA(At, 1, 1); PG8_STAGE(PG8_SB(1, 0), b3, voffB); PG8_STAGE(PG8_SB(1, 1), b3 + hstep, voffB); PG8_STAGE(PG8_SA(1, 0), a3, voffA);
            PG8_WAIT_V(8); PG8_WAIT_L(0); PG8_BAR; PG8_MMA(1, 0, At, B0); PG8_MMA(1, 1, At, B1); PG8_BAR; PG8_SCHED;
            } else {
            PG8_LDB(B0, 0, 0); PG8_SCHED; PG8_LDA(At, 0, 0); PG8_STAGE(PG8_SA(1, 1), a1 + hstep, voffA);
            PG8_WAIT_L(8); PG8_BAR; PG8_WAIT_L(0); PG8_MMA(0, 0, At, B0); PG8_BAR; PG8_SCHED;
            PG8_LDB(B1, 0, 1); PG8_STAGE(PG8_SB(0, 0), b2, voffB);
            PG8_BAR; PG8_WAIT_L(0); PG8_MMA(0, 1, At, B1); PG8_BAR;
            PG8_LDA(At, 0, 1); PG8_STAGE(PG8_SA(0, 0), a2, voffA);
            PG8_BAR; PG8_WAIT_L(0); PG8_MMA(1, 0, At, B0); PG8_BAR; PG8_SCHED;
            PG8_STAGE(PG8_SB(0, 1), b2 + hstep, voffB);
            PG8_WAIT_V(6); PG8_BAR; PG8_MMA(1, 1, At, B1); PG8_BAR;
            PG8_LDB(B0, 1, 0); PG8_SCHED; PG8_LDA(At, 1, 0); PG8_STAGE(PG8_SA(0, 1), a2 + hstep, voffA);
            PG8_WAIT_L(8); PG8_BAR; PG8_WAIT_L(0); PG8_MMA(0, 0, At, B0); PG8_BAR; PG8_SCHED;
            PG8_LDB(B1, 1, 1); PG8_STAGE(PG8_SB(1, 0), b3, voffB);
            PG8_BAR; PG8_WAIT_L(0); PG8_MMA(0, 1, At, B1); PG8_BAR;
            PG8_LDA(At, 1, 1); PG8_STAGE(PG8_SA(1, 0), a3, voffA);
            PG8_BAR; PG8_WAIT_L(0); PG8_MMA(1, 0, At, B0); PG8_BAR; PG8_SCHED;
            PG8_STAGE(PG8_SB(1, 1), b3 + hstep, voffB);
            PG8_WAIT_V(6); PG8_BAR; PG8_MMA(1, 1, At, B1); PG8_BAR;
            }
        }
        if constexpr (ALIGN_EPI) { if (wr == 0) PG8_BAR; }
        if constexpr (!Epi::AFTER_DRAIN) { E(acc, cur, wr, wc, fr, fq); S.done(cur); }
        if (!has_next) break;
#pragma unroll
        for (int a = 0; a < 2; ++a)
#pragma unroll
            for (int b = 0; b < 2; ++b)
#pragma unroll
                for (int m = 0; m < 4; ++m)
#pragma unroll
                    for (int n = 0; n < 2; ++n) acc[a][b][m][n] = (f32x4){0.f, 0.f, 0.f, 0.f};
        cur = nxt; cA = nA; cB = nB; ++ui;
        if constexpr (ALIGN_EPI) { if (wr == 1) PG8_BAR; }
    }
    PG8_WAIT_V(0);
    if constexpr (!ALIGN_EPI) { if (wr == 0) PG8_BAR; }
    PG8_BAR;
    if constexpr (Epi::AFTER_DRAIN) { E.fused(acc, cur, wr, wc, fr, fq, lds, wid, lane); S.done(cur); }
#undef PG8_SA
#undef PG8_SB
#undef PG8_STAGE
#undef PG8_LDA
#undef PG8_LDB
#undef PG8_MMA
#undef PG8_WAIT_V
#undef PG8_WAIT_L
#undef PG8_BAR
#undef PG8_SCHED
}
}
using pg8::bf16_t; using pg8::bf16x8; using pg8::f32x4; using pg8::u32x4; using pg8::pkbf;
typedef float f32x16 __attribute__((ext_vector_type(16)));
typedef short s16x4 __attribute__((ext_vector_type(4)));
typedef short v4i16_t __attribute__((ext_vector_type(4)));
typedef unsigned u32x2 __attribute__((ext_vector_type(2)));

constexpr int DM = 1024, NH = 16, HD = 64, FF = 2816, SEQ = 2048, NB = 8, DB = 32, DS = 16, PAST = 1024, ACACHE = 512, AKEEP = 512, DEPTH = 4;
constexpr int MP = NB * SEQ, MS = DB * DS, M = MP + MS;
constexpr int NREL = 513, TBLP = 520;
constexpr float RMS_EPS = 1e-6f, LOG2E = 1.4426950408889634f, QSCALE = 0.125f * 1.4426950408889634f;
constexpr int NWAVES = 8;
constexpr size_t O_YP = 0, O_YS = O_YP + (size_t)MP * DM, O_AKP = O_YS + (size_t)MS * DM, O_AVP = O_AKP + (size_t)2 * NB * AKEEP * DM, O_AKS = O_AVP + (size_t)2 * NB * AKEEP * DM,
    O_AVS = O_AKS + (size_t)2 * MS * DM, O_BKP = O_AVS + (size_t)2 * MS * DM, O_BVP = O_BKP + (size_t)MP * DM, O_BFP = O_BVP + (size_t)MP * DM, O_BKS = O_BFP + (size_t)MP * NH,
    O_BVS = O_BKS + (size_t)MS * DM, O_BFS = O_BVS + (size_t)MS * DM, O_CKP = O_BFS + (size_t)MS * NH, O_CVP = O_CKP + (size_t)MP * DM, O_CKS = O_CVP + (size_t)MP * DM,
    O_CVS = O_CKS + (size_t)MS * DM, O_END = O_CVS + (size_t)MS * DM;
constexpr size_t MiB = 1u << 20;
constexpr size_t WS_CTL = 0, CTL_ZERO_BYTES = 1 * MiB;
constexpr size_t W_GU = (size_t)2 * FF * DM * 2, W_DN = (size_t)DM * FF * 2, W_QKV = (size_t)3 * DM * DM * 2, W_WO = (size_t)DM * DM * 2;
constexpr size_t WL_GU1 = 0, WL_DN1 = WL_GU1 + W_GU, WL_QKV = WL_DN1 + W_DN, WL_WO = WL_QKV + W_QKV, WL_GU2 = WL_WO + W_WO, WL_DN2 = WL_GU2 + W_GU,
    WL_DN1F = WL_DN2 + W_DN, WL_DN2F = WL_DN1F + W_DN, WL_QKVF = WL_DN2F + W_DN, WL_WOF = WL_QKVF + W_QKV, WL_SIZE = WL_WOF + W_WO;
constexpr int WSLOTS = 2;
constexpr size_t WS_W = 1 * MiB;
constexpr size_t WS_HB = WS_W + WSLOTS * WL_SIZE;
constexpr size_t WS_ACT = WS_HB + (size_t)M * DM * 2;
constexpr size_t WS_QKV = WS_ACT + (size_t)M * FF * 2;
constexpr size_t QKV_T = (size_t)(M + 64) * DM;
constexpr size_t WS_O = WS_QKV + 3 * QKV_T * 2;
constexpr size_t WS_CUMP = WS_O + (size_t)M * DM * 2;
constexpr size_t WS_CUMS = WS_CUMP + (size_t)128 * SEQ * 4;
constexpr size_t WS_TBL = WS_CUMS + (size_t)512 * 1088 * 4;
constexpr size_t WS_SS = WS_TBL + (size_t)2 * 16 * TBLP * 4;
constexpr size_t WS_WFB = WS_SS + (size_t)M * 16 * 4;
constexpr size_t WS_XBF = WS_WFB + (size_t)NH * DM * 2;
constexpr size_t WS_END = WS_XBF + (size_t)MS * DM * 2;
static_assert(WS_W % 256 == 0 && WL_SIZE % 256 == 0 && WS_HB % 256 == 0 && WS_ACT % 256 == 0 && WS_QKV % 256 == 0 && WS_O % 256 == 0 && WS_CUMP % 256 == 0 && WS_CUMS % 256 == 0 && WS_TBL % 256 == 0 && WS_SS % 256 == 0 && WS_WFB % 256 == 0, "ws alignment");
constexpr int CW_BAR = 4096, CW_Q = 8192;
constexpr size_t WS_PTRS = 512 * 1024;
constexpr int RING_BYTES = 131072, MISC_OFF = RING_BYTES + 320, LDS_BYTES = 147456, MSL_OFF = RING_BYTES + 1024;
static_assert(MSL_OFF + 6 * 256 * 4 <= LDS_BYTES, "LDS map");
constexpr int KROWB = 144, KTILE = 64 * KROWB, VROWB = 192, VTILE = 64 * VROWB;

__device__ __forceinline__ size_t frag_off(int row, int k, int K) { return ((size_t)(row >> 4) * (K >> 5) + (k >> 5)) * 512 + ((((k & 31) >> 3) * 16 + (row & 15)) * 8 + (k & 7)); }
#define GAS __attribute__((address_space(1)))
#define LAS __attribute__((address_space(3)))
#define LDS_WAIT() asm volatile("s_waitcnt lgkmcnt(0)" ::: "memory")
#define XB_TMO      128
#define XB_XCNT(j)  (256  + 64 * (j))
#define XB_XSUB(j)  (1280 + 64 * (j))
#define XB_XGEN(j)  (2304 + 64 * (j))
#define XB_TOP      3328
#define XB_TOPGEN   3392
#define XCD_BAR_WORDS 3456
#define XB_SPIN_CAP (1u << 18)

__device__ __forceinline__ unsigned xb_ld(unsigned* p)              { return __hip_atomic_load(p, __ATOMIC_RELAXED, __HIP_MEMORY_SCOPE_AGENT); }
__device__ __forceinline__ unsigned xb_add(unsigned* p, unsigned v) { return __hip_atomic_fetch_add(p, v, __ATOMIC_RELAXED, __HIP_MEMORY_SCOPE_AGENT); }
__device__ __forceinline__ unsigned xb_xcc_id() { return (unsigned)__builtin_amdgcn_s_getreg((3 << 11) | 20) & 0xFu; }
#define XB_SPIN(cond, bar) do { unsigned _sp = 0; while (cond) { __builtin_amdgcn_s_sleep(1); \
    if ((++_sp & 255u) == 0u) { if (xb_ld(&(bar)[XB_TMO])) break; if (_sp > XB_SPIN_CAP) { atomicAdd(&(bar)[XB_TMO], 1u); break; } } } } while (0)

struct XcdBarrier {
    unsigned* bar; unsigned x;
    volatile LAS unsigned* st;
};

__device__ __forceinline__ XcdBarrier xcd_barrier_post(unsigned* bar, volatile LAS unsigned* st) {
    XcdBarrier b; b.bar = bar; b.x = xb_xcc_id(); b.st = st;
    if (threadIdx.x == 0) (void)xb_add(&bar[XB_XCNT(b.x)], 1u);
    return b;
}
__device__ __forceinline__ void xcd_barrier_complete(unsigned* bar, unsigned x, unsigned& nloc, unsigned& nx) {
    const unsigned G = gridDim.x * gridDim.y * gridDim.z;
    unsigned sum, cnt, mine, sp = 0u;
    for (;;) {
        sum = 0u; cnt = 0u; mine = 0u;
#pragma unroll
        for (unsigned j = 0; j < 16; ++j) { const unsigned c = xb_ld(&bar[XB_XCNT(j)]); sum += c; cnt += (c > 0u) ? 1u : 0u; mine = (j == x) ? c : mine; }
        if (sum == G) break;
        __builtin_amdgcn_s_sleep(1);
        if ((++sp & 255u) == 0u) { if (xb_ld(&bar[XB_TMO])) break; if (sp > XB_SPIN_CAP) { atomicAdd(&bar[XB_TMO], 1u); break; } }
    }
    nloc = mine > 0u ? mine : 1u; nx = cnt > 0u ? cnt : 1u;
}

__device__ __forceinline__ int xb_lane() { int l; asm volatile("v_mbcnt_lo_u32_b32 %0, -1, 0\n\tv_mbcnt_hi_u32_b32 %0, -1, %0" : "=v"(l)); return l; }
__device__ __forceinline__ void xcd_barrier(const XcdBarrier& b, const int wv) {
    asm volatile("s_waitcnt vmcnt(0)" ::: "memory");
    __syncthreads();
    if (wv == 0 && xb_lane() == 0) {
        unsigned* bar = b.bar; unsigned bx_id = __builtin_amdgcn_readfirstlane(b.x); asm volatile("" : "+s"(bx_id));
        __builtin_amdgcn_s_waitcnt(0);
        unsigned nloc = b.st[0], nx = b.st[1];
        if (nloc == 0u) { xcd_barrier_complete(bar, bx_id, nloc, nx); b.st[0] = nloc; b.st[1] = nx; }
        const unsigned old = xb_add(&bar[XB_XSUB(bx_id)], 1u);
        const unsigned gen = old / nloc;
        if (old + 1u == (gen + 1u) * nloc) {
            __builtin_amdgcn_fence(__ATOMIC_RELEASE, "agent");
            asm volatile("s_waitcnt vmcnt(0)" ::: "memory");
            const unsigned og = xb_add(&bar[XB_TOP], 1u);
            const unsigned tg = og / nx;
            if (og + 1u == (tg + 1u) * nx) xb_add(&bar[XB_TOPGEN], 1u);
            else XB_SPIN(xb_ld(&bar[XB_TOPGEN]) == tg, bar);
            __builtin_amdgcn_fence(__ATOMIC_ACQUIRE, "agent");
            xb_add(&bar[XB_XGEN(bx_id)], 1u);
            asm volatile("s_waitcnt vmcnt(0)" ::: "memory");
        } else {
            XB_SPIN(xb_ld(&bar[XB_XGEN(bx_id)]) == gen, bar);
            __builtin_amdgcn_fence(__ATOMIC_ACQUIRE, "agent");
            asm volatile("s_waitcnt vmcnt(0)" ::: "memory");
        }
    }
    __syncthreads();
}
__device__ __forceinline__ int opaque_lane() { int l; asm volatile("v_mbcnt_lo_u32_b32 %0, -1, 0\n\tv_mbcnt_hi_u32_b32 %0, -1, %0" : "=v"(l)); return l; }
#define PHASE_IDS() const int lane = opaque_lane(); int wave = wv; asm volatile("" : "+s"(wave)); const int tid_ = wave * 64 + lane; \
    const int G_ = gridDim.x, bx_ = blockIdx.x, vcu_ = (G_ % 8 == 0) ? (bx_ % 8) * (G_ / 8) + bx_ / 8 : bx_; const int gw = vcu_ * NWAVES + wave, NGW = G_ * NWAVES; (void)lane; (void)gw; (void)NGW
__device__ __forceinline__ float wave_sum(float v) {
    v = pg8::sum_row16(v); v += pg8::xor16_f(v); return pg8::sum_xor32(v);
}
struct TItem { f32x4 v[8]; float gk[8]; };
__device__ __forceinline__ void titem_load(TItem& T, const float* W, int N, int item, int lane, const float* gain) {
    const int nblk = N / 32, kb = item / nblk, nb = item % nblk, k0 = 64 * kb, n0 = 32 * nb; const int rg = lane >> 3, c4 = lane & 7;
#pragma unroll
    for (int i = 0; i < 8; ++i) T.v[i] = __builtin_nontemporal_load((const __attribute__((address_space(1))) f32x4*)(W + (size_t)(k0 + 8 * i + rg) * N + n0 + 4 * c4));
    if (gain) {
#pragma unroll
        for (int i = 0; i < 8; ++i) T.gk[i] = *(const __attribute__((address_space(1))) float*)(gain + k0 + 8 * i + rg);
    } else {
#pragma unroll
        for (int i = 0; i < 8; ++i) T.gk[i] = 1.0f; }
}
__device__ __forceinline__ void titem_finish(const TItem& T, int K, int N, bf16_t* WT, bf16_t* WTF, int mode, LAS float* scr, int item, int lane) {
    const int nblk = N / 32, kb = item / nblk, nb = item % nblk, k0 = 64 * kb, n0 = 32 * nb; const int rg = lane >> 3, c4 = lane & 7;
#pragma unroll
    for (int i = 0; i < 8; ++i) { LAS float* p = scr + (8 * i + rg) * 33 + 4 * c4; p[0] = T.v[i].x * T.gk[i]; p[1] = T.v[i].y * T.gk[i]; p[2] = T.v[i].z * T.gk[i]; p[3] = T.v[i].w * T.gk[i]; }
    LDS_WAIT(); asm volatile("" ::: "memory");
    const int c = lane & 7;
    const int rbase = (mode == 0) ? n0 : ((n0 >> 7) * 256 + (n0 & 127) + (mode == 2 ? 128 : 0));
#pragma unroll
    for (int j = 0; j < 4; ++j) { const int n = (lane >> 3) + 8 * j; const LAS float* s = scr + (8 * c) * 33 + n;
        u32x4 o; o.x = pkbf(s[0 * 33], s[1 * 33]); o.y = pkbf(s[2 * 33], s[3 * 33]); o.z = pkbf(s[4 * 33], s[5 * 33]); o.w = pkbf(s[6 * 33], s[7 * 33]);
        *(u32x4*)(WT + (size_t)(rbase + n) * K + k0 + 8 * c) = o;
        if (WTF) *(u32x4*)(WTF + frag_off(rbase + n, k0 + 8 * c, K)) = o; }
    LDS_WAIT(); asm volatile("" ::: "memory");
}
struct KArgs { const float* in[28]; float* out; unsigned char* ws; };
struct KA2 { float* out; unsigned char* ws; };
__device__ __forceinline__ const float* uniform_fptr(unsigned long long v) { const unsigned lo = __builtin_amdgcn_readfirstlane((unsigned)v), hi = __builtin_amdgcn_readfirstlane((unsigned)(v >> 32)); return (const float*)(((unsigned long long)hi << 32) | lo); }
#define INP(i) uniform_fptr(((const unsigned long long*)(A.ws + WS_PTRS))[i])

constexpr int CI_G = (DM / 64) * (FF / 32), CI_D = (FF / 64) * (DM / 32), CI_Q = (DM / 64) * (3 * DM / 32), CI_O = (DM / 64) * (DM / 32), CI_L = 4 * CI_G + 2 * CI_D + CI_Q + CI_O;
__device__ __forceinline__ const float* inp_of(const KArgs& A, int i) { return A.in[i]; }
__device__ __forceinline__ const float* inp_of(const KA2& A, int i) { return uniform_fptr(((const unsigned long long*)(A.ws + WS_PTRS))[i]); }
struct CItem { const float* W; const float* gain; bf16_t* WT; bf16_t* WTF; int K, N, mode, r; };
template <class AT>
__device__ __forceinline__ CItem citem_of(const AT& A, int L, int r) {
    const int kind = L % 3, slot = L / 3; unsigned char* wl = A.ws + WS_W + (size_t)(L % WSLOTS) * WL_SIZE; CItem c;
    if (r < CI_G) { c = CItem{inp_of(A, 10) + (size_t)L * DM * FF, inp_of(A, 9) + (size_t)L * DM, (bf16_t*)(wl + WL_GU1), nullptr, DM, FF, 1, r}; return c; } r -= CI_G;
    if (r < CI_G) { c = CItem{inp_of(A, 11) + (size_t)L * DM * FF, inp_of(A, 9) + (size_t)L * DM, (bf16_t*)(wl + WL_GU1), nullptr, DM, FF, 2, r}; return c; } r -= CI_G;
    if (r < CI_D) { c = CItem{inp_of(A, 12) + (size_t)L * FF * DM, nullptr, (bf16_t*)(wl + WL_DN1), (bf16_t*)(wl + WL_DN1F), FF, DM, 0, r}; return c; } r -= CI_D;
    if (r < CI_G) { c = CItem{inp_of(A, 15) + (size_t)L * DM * FF, inp_of(A, 14) + (size_t)L * DM, (bf16_t*)(wl + WL_GU2), nullptr, DM, FF, 1, r}; return c; } r -= CI_G;
    if (r < CI_G) { c = CItem{inp_of(A, 16) + (size_t)L * DM * FF, inp_of(A, 14) + (size_t)L * DM, (bf16_t*)(wl + WL_GU2), nullptr, DM, FF, 2, r}; return c; } r -= CI_G;
    if (r < CI_D) { c = CItem{inp_of(A, 17) + (size_t)L * FF * DM, nullptr, (bf16_t*)(wl + WL_DN2), (bf16_t*)(wl + WL_DN2F), FF, DM, 0, r}; return c; } r -= CI_D;
    const float* wq = (kind == 0) ? inp_of(A, 18) : (kind == 1) ? inp_of(A, 21) : inp_of(A, 25);
    const float* wo = (kind == 0) ? inp_of(A, 19) : (kind == 1) ? inp_of(A, 22) : inp_of(A, 26);
    if (r < CI_Q) { c = CItem{wq + (size_t)slot * DM * 3 * DM, inp_of(A, 13) + (size_t)L * DM, (bf16_t*)(wl + WL_QKV), (bf16_t*)(wl + WL_QKVF), DM, 3 * DM, 0, r}; return c; } r -= CI_Q;
    c = CItem{wo + (size_t)slot * DM * DM, nullptr, (bf16_t*)(wl + WL_WO), (bf16_t*)(wl + WL_WOF), DM, DM, 0, r}; return c;
}
constexpr int CR_D1 = 2 * CI_G, CR_G2 = 2 * CI_G + CI_D, CR_D2 = 4 * CI_G + CI_D, CR_Q = 4 * CI_G + 2 * CI_D, CR_O = CR_Q + CI_Q, CV_NA = CI_D + CI_Q + CI_O, CV_G1A = CI_L / 2 - CV_NA, CV_G1B = 2 * CI_G - CV_G1A;
static_assert(CV_G1A > 0 && CV_G1B > 0, "conversion schedule");
__device__ __forceinline__ int conv_list_len(int kind, int L) { return kind == 0 ? 4 * CI_G : kind == 1 ? CV_NA + (L + 1 < DEPTH ? CV_G1A : 0) : CI_D + (L + 1 < DEPTH ? CV_G1B + 2 * CI_G : 0); }
template <class AT>
__device__ __forceinline__ CItem citem_v(const AT& A, int kind, int L, int v) {
    if (kind == 0) return (v < 2 * CI_G) ? citem_of(A, L, v) : citem_of(A, L, CR_G2 + (v - 2 * CI_G));
    if (kind == 1) {
        if (v < CI_D) return citem_of(A, L, CR_D1 + v);
        if (v < CI_D + CI_Q) return citem_of(A, L, CR_Q + (v - CI_D));
        if (v < CV_NA) return citem_of(A, L, CR_O + (v - CI_D - CI_Q));
        return citem_of(A, L + 1, v - CV_NA); }
    if (v < CI_D) return citem_of(A, L, CR_D2 + v);
    if (v < CI_D + CV_G1B) return citem_of(A, L + 1, CV_G1A + (v - CI_D));
    return citem_of(A, L + 1, CR_G2 + (v - CI_D - CV_G1B));
}
template <class AT>
__device__ __forceinline__ void convert_items(const AT& A, int kind, int L, int first, int hi, int stride, LAS float* scr, int lane) {
    if (first >= hi) return;
    TItem Ta; CItem ca = citem_v(A, kind, L, first); titem_load(Ta, ca.W, ca.N, ca.r, lane, ca.gain);
#pragma unroll 1
    for (int it = first; it < hi; it += stride) {
        TItem Tb; CItem cb = ca; const bool more = it + stride < hi;
        if (more) { cb = citem_v(A, kind, L, it + stride); titem_load(Tb, cb.W, cb.N, cb.r, lane, cb.gain); }
        titem_finish(Ta, ca.K, ca.N, ca.WT, ca.WTF, ca.mode, scr, ca.r, lane);
        if (more) { Ta = Tb; ca = cb; }
    }
}
__device__ __forceinline__ void convert_tail(const KA2& A, LAS unsigned char* lds, int kind, int L, int c0, int nc, const int wv) {
    PHASE_IDS();
    LAS float* scr = (LAS float*)(lds + wave * 16384);
    convert_items(A, kind, L, (bx_ - c0) * NWAVES + wave, conv_list_len(kind, L), nc * NWAVES, scr, lane);
}
__device__ __forceinline__ void prologue_phase(const KArgs& A, LAS unsigned char* lds, const int wv) {
    PHASE_IDS();
    LAS float* scr = (LAS float*)(lds + wave * 16384);
    if (tid_ == 0) { const float** tab = (const float**)(A.ws + WS_PTRS);
#pragma unroll
        for (int i = 0; i < 28; ++i) tab[i] = A.in[i]; }
    convert_items(A, 0, 0, gw, conv_list_len(0, 0), NGW, scr, lane);
    bf16_t* XB = (bf16_t*)(A.ws + WS_HB); float* SS = (float*)(A.ws + WS_SS); bf16_t* XBF = (bf16_t*)(A.ws + WS_XBF);
    for (int m0 = 2 * gw; m0 < M; m0 += 2 * NGW) {
        f32x4 v[2][4];
#pragma unroll
        for (int q = 0; q < 2; ++q) { const int m = m0 + q; const float* src = (m < MP) ? A.in[0] + (size_t)m * DM : A.in[1] + (size_t)(m - MP) * DM;
#pragma unroll
            for (int j = 0; j < 4; ++j) v[q][j] = ((const f32x4*)src)[lane + 64 * j]; }
#pragma unroll
        for (int q = 0; q < 2; ++q) { const int m = m0 + q; u32x2* o8 = (u32x2*)(XB + (size_t)m * DM) + lane; float s = 0.f;
#pragma unroll
            for (int j = 0; j < 4; ++j) { u32x2 w; w.x = pkbf(v[q][j].x, v[q][j].y); w.y = pkbf(v[q][j].z, v[q][j].w); o8[64 * j] = w;
                if (m >= MP) *(u32x2*)(XBF + frag_off(m - MP, 4 * (lane + 64 * j), DM)) = w;
                s += (pg8::bflo(w.x) * pg8::bflo(w.x) + pg8::bfhi(w.x) * pg8::bfhi(w.x)) + (pg8::bflo(w.y) * pg8::bflo(w.y) + pg8::bfhi(w.y) * pg8::bfhi(w.y)); }
            s = wave_sum(s);
            if (lane < 16) SS[(size_t)m * 16 + lane] = (lane == 0) ? s : 0.f; }
    }
    { bf16_t* wfb = (bf16_t*)(A.ws + WS_WFB); const float* wf = A.in[23]; const float* gm = A.in[13] + DM;
      for (int i = gw * 64 + lane; i < NH * DM; i += NGW * 64) { const int hh = i / DM, kk = i % DM; wfb[i] = (bf16_t)(pkbf(wf[(size_t)kk * NH + hh] * gm[kk], 0.f) & 0xffffu); } }
    float* tbl = (float*)(A.ws + WS_TBL);
    for (int i = gw * 64 + lane; i < 2 * 16 * NREL; i += NGW * 64) { const int slot = i / (16 * NREL), rem = i % (16 * NREL), h = rem / NREL, idx = rem % NREL;
        tbl[(slot * 16 + h) * TBLP + idx] = A.in[20][((size_t)slot * NREL + idx) * 16 + h] * LOG2E; }
}

__device__ __forceinline__ void fgate_step(const KA2& A, const float* bfv, const int wv) {
    PHASE_IDS();
    const bf16_t* XB = (const bf16_t*)(A.ws + WS_HB); const bf16_t* WFB = (const bf16_t*)(A.ws + WS_WFB); const float* SS = (const float*)(A.ws + WS_SS);
    const float bias = bfv[lane & 15];
    for (int rb = gw; rb < M / 16; rb += NGW) {
        const bf16_t* ap = XB + (size_t)(rb * 16 + (lane & 15)) * DM + 8 * (lane >> 4); const bf16_t* bp = WFB + (size_t)(lane & 15) * DM + 8 * (lane >> 4);
        f32x4 acc = {0.f, 0.f, 0.f, 0.f};
#pragma unroll
        for (int k0 = 0; k0 < DM / 32; k0 += 8) { bf16x8 a[8], b[8];
#pragma unroll
            for (int kk = 0; kk < 8; ++kk) { a[kk] = *(const bf16x8*)(ap + (k0 + kk) * 32); b[kk] = *(const bf16x8*)(bp + (k0 + kk) * 32); }
#pragma unroll
            for (int kk = 0; kk < 8; ++kk) acc = __builtin_amdgcn_mfma_f32_16x16x32_bf16(a[kk], b[kk], acc, 0, 0, 0); }
#pragma unroll
        for (int e = 0; e < 4; ++e) { const int m = rb * 16 + 4 * (lane >> 4) + e; const float z = acc[e] * pg8::row_scale(SS, m) + bias;
            const float lf = fminf(z, 0.f) - 0.6931471805599453f * __builtin_amdgcn_logf(1.0f + __builtin_amdgcn_exp2f(-1.4426950408889634f * fabsf(z)));
            float* dst = (m < MP) ? A.out + O_BFP + (size_t)m * NH : A.out + O_BFS + (size_t)(m - MP) * NH; dst[lane & 15] = lf; }
    }
}
template <int K, int KSPLIT, int CW, int KB, class Epi>
__device__ __forceinline__ void small_gemm(LAS unsigned char* lds, const bf16_t* Af, const bf16_t* Bf, int N, const Epi& E, const int wv) {
    PHASE_IDS();
    constexpr int NCH = 8 / KSPLIT, TN = NCH * CW, KW = K / KSPLIT, NKS = KW / 32, NB = CW / 16, NE = TN / 64;
    static_assert(KW % 32 == 0 && CW % 16 == 0 && TN % 64 == 0 && 8 * 32 * CW * 4 <= RING_BYTES, "small_gemm geometry");
    const int ntn = N / TN, ntiles = (MS / 32) * ntn;
    const int kq = wave % KSPLIT, ch = wave / KSPLIT;
#pragma unroll 1
    for (int tile = bx_; tile < ntiles; tile += G_) {
        const int tm = tile / ntn, tn = tile % ntn;
        const int row = tid_ >> 4, c4 = (tid_ & 15) * 4;
        typename Epi::Pre pre[NE];
#pragma unroll
        for (int q = 0; q < NE; ++q) pre[q] = E.pre(tm * 32 + row, tn * TN + c4 + 64 * q);
        const bf16_t* ap = Af + ((size_t)(tm * 2) * (K / 32) + kq * NKS) * 512 + lane * 8;
        const bf16_t* bp = Bf + ((size_t)((tn * TN + ch * CW) / 16) * (K / 32) + kq * NKS) * 512 + lane * 8;
        f32x4 acc[2][NB];
#pragma unroll
        for (int i = 0; i < 2; ++i)
#pragma unroll
            for (int j = 0; j < NB; ++j) acc[i][j] = (f32x4){0.f, 0.f, 0.f, 0.f};
#pragma unroll
        for (int k0 = 0; k0 < NKS; k0 += KB) {
            bf16x8 a[KB][2], b[KB][NB];
#pragma unroll
            for (int kk = 0; kk < KB; ++kk) if (k0 + kk < NKS) {
#pragma unroll
                for (int i = 0; i < 2; ++i) a[kk][i] = *(const bf16x8*)(ap + (size_t)(i * (K / 32) + k0 + kk) * 512);
#pragma unroll
                for (int j = 0; j < NB; ++j) b[kk][j] = *(const bf16x8*)(bp + (size_t)(j * (K / 32) + k0 + kk) * 512); }
#pragma unroll
            for (int kk = 0; kk < KB; ++kk) if (k0 + kk < NKS) {
#pragma unroll
                for (int i = 0; i < 2; ++i)
#pragma unroll
                    for (int j = 0; j < NB; ++j) acc[i][j] = __builtin_amdgcn_mfma_f32_16x16x32_bf16(a[kk][i], b[kk][j], acc[i][j], 0, 0, 0); }
        }
        LAS float* part = (LAS float*)(lds + wave * (32 * CW * 4));
#pragma unroll
        for (int i = 0; i < 2; ++i)
#pragma unroll
            for (int j = 0; j < NB; ++j)
#pragma unroll
                for (int e = 0; e < 4; ++e) part[(16 * i + 4 * (lane >> 4) + e) * CW + 16 * j + (lane & 15)] = acc[i][j][e];
        __syncthreads();
#pragma unroll
        for (int q = 0; q < NE; ++q) { const int col = c4 + 64 * q, cch = col / CW, cin = col % CW;
            const LAS unsigned char* pb = lds + (size_t)(cch * KSPLIT) * (32 * CW * 4) + (row * CW + cin) * 4;
            f32x4 sum = *(const LAS f32x4*)pb;
#pragma unroll
            for (int w = 1; w < KSPLIT; ++w) sum += *(const LAS f32x4*)(pb + w * (32 * CW * 4));
            E.fin(tm * 32 + row, tn * TN + col, sum, pre[q]); }
        __syncthreads();
    }
}
struct SEpiResid {
    typedef u32x2 Pre;
    bf16_t* xb; float* SS; float c; bf16_t* xbf;
    __device__ __forceinline__ Pre pre(int row, int col) const { return *(const u32x2*)(xb + (size_t)row * DM + col); }
    __device__ __forceinline__ void fin(int row, int col, f32x4 v, const Pre& in) const {
        const size_t off = (size_t)row * DM + col;
        u32x2 w; w.x = pkbf(pg8::bflo(in.x) + v.x * c, pg8::bfhi(in.x) + v.y * c); w.y = pkbf(pg8::bflo(in.y) + v.z * c, pg8::bfhi(in.y) + v.w * c); *(u32x2*)(xb + off) = w; *(u32x2*)(xbf + frag_off(row, col, DM)) = w;
        float ss = (pg8::bflo(w.x) * pg8::bflo(w.x) + pg8::bfhi(w.x) * pg8::bfhi(w.x)) + (pg8::bflo(w.y) * pg8::bflo(w.y) + pg8::bfhi(w.y) * pg8::bfhi(w.y));
        ss = pg8::sum_row16(ss);
        if ((col & 63) == 0) SS[(size_t)row * 16 + (col >> 6)] = ss;
    }
};
struct SEpiQKV {
    typedef f32x4 Pre;
    bf16_t* qkv; size_t tstride; float qscale; float* oks; float* ovs; const float* SS;
    __device__ __forceinline__ Pre pre(int row, int col) const { return *(const f32x4*)(SS + (size_t)row * 16 + (col & 12)); }
    __device__ __forceinline__ void fin(int row, int col, f32x4 v, const Pre& p) const {
        float s = (p.x + p.y) + (p.z + p.w); s = pg8::sum_quad(s);
        const float rs = __builtin_amdgcn_rsqf(s * (1.0f / 1024.0f) + 1e-6f); const int t = col >> 10, c = col & 1023; const float sc = (t == 0) ? qscale * rs : rs;
        u32x2 w; w.x = pkbf(v.x * sc, v.y * sc); w.y = pkbf(v.z * sc, v.w * sc); *(u32x2*)(qkv + (size_t)t * tstride + (size_t)row * DM + c) = w;
        if (t >= 1) { float* o = (t == 1) ? oks : ovs; *(f32x4*)(o + (size_t)row * DM + c) = v * rs; }
    }
};
__device__ __forceinline__ void final_norm_phase(const KA2& A, const int wv) {
    PHASE_IDS();
    const bf16_t* XB = (const bf16_t*)(A.ws + WS_HB); const float* SS = (const float*)(A.ws + WS_SS); const float* gain = INP(27);
    f32x4 g[4];
#pragma unroll
    for (int j = 0; j < 4; ++j) g[j] = ((const f32x4*)gain)[lane + 64 * j];
    for (int m0 = 4 * gw; m0 < M; m0 += 4 * NGW) {
        const float part = SS[(size_t)(m0 + (lane >> 4)) * 16 + (lane & 15)];
        u32x2 w[4][4];
#pragma unroll
        for (int q = 0; q < 4; ++q)
#pragma unroll
            for (int j = 0; j < 4; ++j) w[q][j] = ((const u32x2*)(XB + (size_t)(m0 + q) * DM))[lane + 64 * j];
        const float tot = pg8::sum_row16(part); const float rl = __builtin_amdgcn_rsqf(tot * (1.0f / DM) + RMS_EPS);
#pragma unroll
        for (int q = 0; q < 4; ++q) { const float r = __builtin_bit_cast(float, __builtin_amdgcn_readlane(__builtin_bit_cast(int, rl), 16 * q));
            f32x4* o = (f32x4*)(A.out + O_YP + (size_t)(m0 + q) * DM) + lane;
#pragma unroll
            for (int j = 0; j < 4; ++j) { const f32x4 v = {pg8::bflo(w[q][j].x), pg8::bfhi(w[q][j].x), pg8::bflo(w[q][j].y), pg8::bfhi(w[q][j].y)}; o[64 * j] = v * r * g[j]; } }
    }
}
__device__ __forceinline__ float wave_incl_scan(float v, int lane) {
#pragma unroll
    for (int o = 1; o < 64; o <<= 1) { const float t = __builtin_bit_cast(float, __builtin_amdgcn_ds_bpermute(((lane - o) & 63) << 2, __builtin_bit_cast(int, v))); if (lane >= o) v += t; }
    return v;
}
__device__ __forceinline__ void scan_phase(const KA2& A, const int wv) {
    PHASE_IDS();
    float* cump = (float*)(A.ws + WS_CUMP); float* cums = (float*)(A.ws + WS_CUMS);
    for (int task = gw; task < 128 + 512; task += NGW) {
        if (task < 128) { const int b = task >> 4, h = task & 15; const float* f = A.out + O_BFP + ((size_t)b * SEQ) * NH + h;
            float loc[32]; float run = 0.f;
#pragma unroll
            for (int i = 0; i < 32; ++i) { run += f[(size_t)(32 * lane + i) * NH]; loc[i] = run; }
            const float incl = wave_incl_scan(run, lane); const float off = incl - run;
            float* dst = cump + (size_t)task * SEQ + 32 * lane;
#pragma unroll
            for (int i = 0; i < 32; ++i) dst[i] = (loc[i] + off) * LOG2E;
        } else { const int su = task - 128, b = su >> 4, h = su & 15; const float* f = INP(6) + ((size_t)b * PAST) * NH + h;
            float loc[16]; float run = 0.f;
#pragma unroll
            for (int i = 0; i < 16; ++i) { run += f[(size_t)(16 * lane + i) * NH]; loc[i] = run; }
            const float incl = wave_incl_scan(run, lane); const float off = incl - run;
            float* dst = cums + (size_t)su * 1088;
#pragma unroll
            for (int i = 0; i < 16; ++i) dst[16 * lane + i] = (loc[i] + off) * LOG2E;
            const float total = __builtin_bit_cast(float, __builtin_amdgcn_readlane(__builtin_bit_cast(int, incl), 63));
            const float fn = (lane < 16) ? A.out[O_BFS + (size_t)(b * 16 + lane) * NH + h] : 0.f;
            const float sc = wave_incl_scan(fn, lane);
            if (lane < 16) dst[1024 + lane] = (total + sc) * LOG2E;
        }
    }
}
__device__ __forceinline__ s16x4 vtr(const LAS unsigned char* p) { return __builtin_bit_cast(s16x4, __builtin_amdgcn_ds_read_tr16_b64_v4i16((LAS v4i16_t*)p)); }
struct AttnP {
    const bf16_t* Q; const bf16_t* K; const bf16_t* V; bf16_t* O;
    const float* ck; const float* cv;
    const float* tbl;
    const float* cump; const float* cums;
    unsigned* qctr;
    float* okp; float* ovp;
};
typedef float f32x2 __attribute__((ext_vector_type(2)));
struct AttState { f32x16 o0, o1; float mrun, lsum, R; int basep; };
constexpr int AL_KT = 0, AL_VT = 3 * KTILE, AL_AUXP = 3 * KTILE + 2 * VTILE, AL_VS = 0, AL_AUXS = 8 * VTILE, AL_CST = AL_AUXS + 4352, AL_KS1 = AL_CST + 1024, AL_KS2 = RING_BYTES + 1024, KHALF = 32 * KROWB;
static_assert(AL_AUXP + 8192 <= RING_BYTES && AL_KS1 + 5 * KHALF <= RING_BYTES && AL_KS2 + 3 * KHALF <= LDS_BYTES && AL_KS2 >= MISC_OFF + 512 && VTILE >= 4096, "attention LDS map");

__device__ __forceinline__ float max3f(float a, float b, float c) { float r; asm("v_max3_f32 %0, %1, %2, %3" : "=v"(r) : "v"(a), "v"(b), "v"(c)); return r; }
__device__ __forceinline__ float max2f(float a, float b) { float r; asm("v_max_f32_e32 %0, %1, %2" : "=v"(r) : "v"(a), "v"(b)); return r; }
template <int TYPE, bool MASK, bool KMASK, bool FAR>
__device__ __forceinline__ void attn_step(AttState& S, const bf16x8 (&kf)[2][4], const bf16x8 (&qr)[4], const LAS unsigned char* vrd, int kbase, int qpos, int qlim, int klim, int hi, const LAS float* aux, float cfar) {
    f32x16 p0, p1;
    if (TYPE == 0 && !FAR) {
        const LAS float* tb = aux + (384 - qpos + kbase);
#pragma unroll
        for (int r = 0; r < 16; ++r) { const int o = (r & 3) + 8 * (r >> 2); p0[r] = tb[o]; p1[r] = tb[o + 32]; }
    } else if (TYPE == 1) {
#pragma unroll
        for (int gi = 0; gi < 4; ++gi) { const f32x4 c0 = *(const LAS f32x4*)(aux + kbase + 8 * gi), c1 = *(const LAS f32x4*)(aux + kbase + 8 * gi + 32);
#pragma unroll
            for (int e = 0; e < 4; ++e) { p0[4 * gi + e] = c0[e]; p1[4 * gi + e] = c1[e]; } }
    } else if (TYPE == 0 && FAR) {
#pragma unroll
        for (int r = 0; r < 16; ++r) { p0[r] = cfar; p1[r] = cfar; }
    } else { p0 = f32x16{}; p1 = f32x16{}; }
    __builtin_amdgcn_s_setprio(3);
#pragma unroll
    for (int d0 = 0; d0 < 4; ++d0) { p0 = __builtin_amdgcn_mfma_f32_32x32x16_bf16(kf[0][d0], qr[d0], p0, 0, 0, 0); p1 = __builtin_amdgcn_mfma_f32_32x32x16_bf16(kf[1][d0], qr[d0], p1, 0, 0, 0); }
    if (S.basep) __builtin_amdgcn_s_setprio(1); else __builtin_amdgcn_s_setprio(0);
    if (TYPE == 2) {
        float k0[16], k1[16];
#pragma unroll
        for (int r = 0; r < 16; ++r) { const int kp = kbase + (r & 3) + 8 * (r >> 2);
            { const float e = __builtin_amdgcn_exp2f(fminf(p0[r], 100.f)), k = __builtin_amdgcn_rcpf(1.f + e); if (MASK) { const bool v = kp < qlim; k0[r] = v ? k : 1.f; p0[r] = v ? e * k : 0.f; } else { k0[r] = k; p0[r] = e * k; } }
            { const float e = __builtin_amdgcn_exp2f(fminf(p1[r], 100.f)), k = __builtin_amdgcn_rcpf(1.f + e); if (MASK) { const bool v = kp + 32 < qlim; k1[r] = v ? k : 1.f; p1[r] = v ? e * k : 0.f; } else { k1[r] = k; p1[r] = e * k; } } }
        float all[16];
#pragma unroll
        for (int gi = 0; gi < 4; ++gi) {
            const float ga = (k0[4 * gi] * k0[4 * gi + 1]) * (k0[4 * gi + 2] * k0[4 * gi + 3]), gb = (k1[4 * gi] * k1[4 * gi + 1]) * (k1[4 * gi + 2] * k1[4 * gi + 3]);
            auto ra = __builtin_amdgcn_permlane32_swap(__float_as_uint(ga), __float_as_uint(ga), false, false); all[2 * gi] = __uint_as_float(ra[0]); all[2 * gi + 1] = __uint_as_float(ra[1]);
            auto rb = __builtin_amdgcn_permlane32_swap(__float_as_uint(gb), __float_as_uint(gb), false, false); all[8 + 2 * gi] = __uint_as_float(rb[0]); all[8 + 2 * gi + 1] = __uint_as_float(rb[1]); }
        float run = S.R;
#pragma unroll
        for (int gi = 3; gi >= 0; --gi) {
            const float above_odd = run, above_even = run * all[8 + 2 * gi + 1]; float s = hi ? above_odd : above_even; run = above_even * all[8 + 2 * gi];
            p1[4 * gi + 3] *= s; s *= k1[4 * gi + 3]; p1[4 * gi + 2] *= s; s *= k1[4 * gi + 2]; p1[4 * gi + 1] *= s; s *= k1[4 * gi + 1]; p1[4 * gi] *= s; }
#pragma unroll
        for (int gi = 3; gi >= 0; --gi) {
            const float above_odd = run, above_even = run * all[2 * gi + 1]; float s = hi ? above_odd : above_even; run = above_even * all[2 * gi];
            p0[4 * gi + 3] *= s; s *= k0[4 * gi + 3]; p0[4 * gi + 2] *= s; s *= k0[4 * gi + 2]; p0[4 * gi + 1] *= s; s *= k0[4 * gi + 1]; p0[4 * gi] *= s; }
        S.R = run;
    } else {
        if (TYPE == 0 && KMASK) {
#pragma unroll
            for (int r = 0; r < 16; ++r) { const int kp = kbase + (r & 3) + 8 * (r >> 2); p0[r] = (kp < klim) ? p0[r] : -1e30f; p1[r] = (kp + 32 < klim) ? p1[r] : -1e30f; }
        }
        if (TYPE == 1 && MASK) {
#pragma unroll
            for (int r = 0; r < 16; ++r) { const int kp = kbase + (r & 3) + 8 * (r >> 2); p0[r] = (kp <= qlim) ? p0[r] : -1e30f; p1[r] = (kp + 32 <= qlim) ? p1[r] : -1e30f; }
        }
        asm volatile("s_nop 15\n\ts_nop 7" : "+v"(p0), "+v"(p1));
        float tm = max3f(p0[0], p1[0], p0[1]);
#pragma unroll
        for (int r = 1; r < 15; ++r) tm = max3f(tm, p1[r], p0[r + 1]);
        tm = max2f(tm, p1[15]);
        { auto rr = __builtin_amdgcn_permlane32_swap(__float_as_uint(tm), __float_as_uint(tm), false, false); tm = max2f(__uint_as_float(rr[0]), __uint_as_float(rr[1])); }
        if (__any(tm > S.mrun + 8.0f)) {
            const float mt = max2f(S.mrun, tm), alpha = __builtin_amdgcn_exp2f(S.mrun - mt); S.mrun = mt; S.lsum *= alpha;
#pragma unroll
            for (int r = 0; r < 16; ++r) { S.o0[r] *= alpha; S.o1[r] *= alpha; }
        }
        const float mref = S.mrun; float ps = 0.f; const f32x2 m2 = {mref, mref};
#pragma unroll
        for (int r = 0; r < 16; r += 2) { const f32x2 a = (f32x2){p0[r], p0[r + 1]} - m2, bq = (f32x2){p1[r], p1[r + 1]} - m2;
            p0[r] = __builtin_amdgcn_exp2f(a.x); p0[r + 1] = __builtin_amdgcn_exp2f(a.y); p1[r] = __builtin_amdgcn_exp2f(bq.x); p1[r + 1] = __builtin_amdgcn_exp2f(bq.y); }
#pragma unroll
        for (int r = 0; r < 16; ++r) ps += p0[r] + p1[r];
        S.lsum += ps;
    }
    bf16x8 pa[4];
#pragma unroll
    for (int s = 0; s < 2; ++s) {
        u32x4 w0; w0.x = pkbf(p0[8 * s], p0[8 * s + 1]); w0.y = pkbf(p0[8 * s + 2], p0[8 * s + 3]); w0.z = pkbf(p0[8 * s + 4], p0[8 * s + 5]); w0.w = pkbf(p0[8 * s + 6], p0[8 * s + 7]); pa[s] = __builtin_bit_cast(bf16x8, w0);
        u32x4 w1; w1.x = pkbf(p1[8 * s], p1[8 * s + 1]); w1.y = pkbf(p1[8 * s + 2], p1[8 * s + 3]); w1.z = pkbf(p1[8 * s + 4], p1[8 * s + 5]); w1.w = pkbf(p1[8 * s + 6], p1[8 * s + 7]); pa[2 + s] = __builtin_bit_cast(bf16x8, w1); }
    __builtin_amdgcn_s_setprio(3);
#pragma unroll
    for (int ks = 0; ks < 4; ++ks) {
        const s16x4 a0 = vtr(vrd + (16 * ks) * VROWB), a1 = vtr(vrd + (16 * ks + 8) * VROWB), c0 = vtr(vrd + (16 * ks) * VROWB + 64), c1 = vtr(vrd + (16 * ks + 8) * VROWB + 64);
        const bf16x8 v0 = {a0[0], a0[1], a0[2], a0[3], a1[0], a1[1], a1[2], a1[3]}, v1 = {c0[0], c0[1], c0[2], c0[3], c1[0], c1[1], c1[2], c1[3]};
        S.o0 = __builtin_amdgcn_mfma_f32_32x32x16_bf16(v0, pa[ks], S.o0, 0, 0, 0);
        S.o1 = __builtin_amdgcn_mfma_f32_32x32x16_bf16(v1, pa[ks], S.o1, 0, 0, 0); }
    if (S.basep) __builtin_amdgcn_s_setprio(1); else __builtin_amdgcn_s_setprio(0);
}
__device__ __forceinline__ void fill_bias_table(LAS float* aux, const float* tb, int tid) {
    for (int i = tid; i < 640; i += NWAVES * 64) { int d = 384 - i; d = d < -256 ? -256 : (d > 256 ? 256 : d); aux[i] = tb[d + 256]; }
}

template <int TYPE>
__device__ __forceinline__ void kv_out(const AttnP& P, int b, int h, int U, int jt, int srow, int sch, const u32x4 kreg, const u32x4 vreg) {
    if (jt < 4 * U) return;
    if (TYPE == 0 && jt < (SEQ - AKEEP) / 64) return;
    const size_t row = (TYPE == 0) ? (size_t)b * AKEEP + (64 * jt - (SEQ - AKEEP)) + srow : (size_t)b * SEQ + 64 * jt + srow;
    __attribute__((address_space(1))) f32x4* ko = (__attribute__((address_space(1))) f32x4*)(P.okp + row * DM + h * HD + 8 * sch);
    __attribute__((address_space(1))) f32x4* vo = (__attribute__((address_space(1))) f32x4*)(P.ovp + row * DM + h * HD + 8 * sch);
    ko[0] = (f32x4){pg8::bflo(kreg.x), pg8::bfhi(kreg.x), pg8::bflo(kreg.y), pg8::bfhi(kreg.y)}; ko[1] = (f32x4){pg8::bflo(kreg.z), pg8::bfhi(kreg.z), pg8::bflo(kreg.w), pg8::bfhi(kreg.w)};
    vo[0] = (f32x4){pg8::bflo(vreg.x), pg8::bfhi(vreg.x), pg8::bflo(vreg.y), pg8::bfhi(vreg.y)}; vo[1] = (f32x4){pg8::bflo(vreg.z), pg8::bfhi(vreg.z), pg8::bflo(vreg.w), pg8::bfhi(vreg.w)};
}
template <int TYPE>
__device__ __forceinline__ void row_out(float* obase, int b, int h, int U, int jt, int srow, int sch, const u32x4 reg) {
    if (jt < 4 * U) return;
    if (TYPE == 0 && jt < (SEQ - AKEEP) / 64) return;
    const size_t row = (TYPE == 0) ? (size_t)b * AKEEP + (64 * jt - (SEQ - AKEEP)) + srow : (size_t)b * SEQ + 64 * jt + srow;
    __attribute__((address_space(1))) f32x4* o = (__attribute__((address_space(1))) f32x4*)(obase + row * DM + h * HD + 8 * sch);
    o[0] = (f32x4){pg8::bflo(reg.x), pg8::bfhi(reg.x), pg8::bflo(reg.y), pg8::bfhi(reg.y)}; o[1] = (f32x4){pg8::bflo(reg.z), pg8::bfhi(reg.z), pg8::bflo(reg.w), pg8::bfhi(reg.w)};
}
template <int TYPE>
__device__ __forceinline__ void attn_prompt_unit(const AttnP& P, int b, int h, int U, LAS unsigned char* lds, int wave, unsigned nxt, volatile LAS unsigned* slot) {
    const int lane = opaque_lane(), tid = wave * 64 + lane;
    const int r32 = lane & 31, hi = lane >> 5, li = lane & 15;
    const int qblk = 8 * U + wave, c = qblk >> 1, qpos = 32 * qblk + r32;
    const int jlast = 4 * U + 3, jfirst = (TYPE == 0) ? (4 * U > 8 ? 4 * U - 8 : 0) : 0, nt = jlast - jfirst + 1;
    LAS float* aux = (LAS float*)(lds + AL_AUXP);
    if (TYPE == 1) { const float* src = P.cump + (size_t)(b * NH + h) * SEQ; for (int i = tid; i < 256 * (U + 1); i += NWAVES * 64) aux[i] = -src[i]; }
    if (TYPE == 0) fill_bias_table(aux, P.tbl + h * TBLP, tid);
    const float cfar = (TYPE == 0) ? P.tbl[h * TBLP + 512] : 0.f;
    volatile LAS unsigned* dflag = (volatile LAS unsigned*)(lds + MISC_OFF + 256);
    bf16x8 qr[4];
    { const __attribute__((address_space(1))) unsigned char* qb = (const __attribute__((address_space(1))) unsigned char*)(P.Q + (size_t)b * SEQ * DM + h * HD); const unsigned qo = (unsigned)((qpos * DM + 8 * hi) * 2);
#pragma unroll
      for (int d0 = 0; d0 < 4; ++d0) qr[d0] = *(const __attribute__((address_space(1))) bf16x8*)(qb + qo + 32 * d0); }
    const int srow = tid >> 3, sch = tid & 7;
    typedef __attribute__((address_space(1))) const unsigned char gcb;
    gcb* kg = (gcb*)(P.K + (size_t)b * SEQ * DM + h * HD); gcb* vg = (gcb*)(P.V + (size_t)b * SEQ * DM + h * HD);
    const unsigned goff = (unsigned)((srow * DM + 8 * sch) * 2);
#define TILE_LD(base, jj) (*(__attribute__((address_space(1))) const u32x4*)((base) + (size_t)(jj) * (64 * DM * 2) + goff))
    const int soffk = srow * KROWB + 16 * sch, soffv = srow * VROWB + 16 * sch;
#define TIDX(tau) ((TYPE == 2) ? jlast - (tau) : jfirst + (tau))
    { const u32x4 kr0 = TILE_LD(kg, TIDX(0)), kr1 = TILE_LD(kg, TIDX(1)), vr0 = TILE_LD(vg, TIDX(0));
      *(LAS u32x4*)(lds + AL_KT + soffk) = kr0; *(LAS u32x4*)(lds + AL_KT + KTILE + soffk) = kr1; *(LAS u32x4*)(lds + AL_VT + soffv) = vr0;
      row_out<TYPE>(P.okp, b, h, U, TIDX(0), srow, sch, kr0); row_out<TYPE>(P.okp, b, h, U, TIDX(1), srow, sch, kr1); row_out<TYPE>(P.ovp, b, h, U, TIDX(0), srow, sch, vr0); }
    const int grp = wave >> 2, gt = tid & 255, grow = gt >> 3;
    const unsigned ggoff = (unsigned)((grow * DM + 8 * sch) * 2);
#define TILE_LD2(base, jj, half) (*(__attribute__((address_space(1))) const u32x4*)((base) + (size_t)(jj) * (64 * DM * 2) + ggoff + (half) * (32 * DM * 2)))
    const int gsk = grow * KROWB + 16 * sch, gsv = grow * VROWB + 16 * sch;
    u32x4 rk0 = {}, rk1 = {}, rv0 = {}, rv1 = {};
    if (grp == 1) { rk0 = TILE_LD2(kg, TIDX(2), 0); rk1 = TILE_LD2(kg, TIDX(2), 1); rv0 = TILE_LD2(vg, TIDX(1), 0); rv1 = TILE_LD2(vg, TIDX(1), 1); }
    if (tid == 0) slot[1] = nxt;
    __syncthreads();
    AttState S; S.o0 = f32x16{}; S.o1 = f32x16{}; S.mrun = -1e30f; S.lsum = 0.f; S.R = 1.f; S.basep = wave >> 2;
    const int vro = (4 * hi + (li >> 2)) * VROWB + (16 * ((lane >> 4) & 1) + 4 * (li & 3)) * 2, kro = r32 * KROWB + 16 * hi;
    bool done = false;
    bf16x8 kf[2][4];
#pragma unroll
    for (int sub = 0; sub < 2; ++sub)
#pragma unroll
        for (int d0 = 0; d0 < 4; ++d0) kf[sub][d0] = *(const LAS bf16x8*)(lds + AL_KT + kro + sub * 32 * KROWB + 32 * d0);
    int ksl = 0;
#pragma unroll 1
    for (int t = 0; t < nt; ++t) {
        const int j = TIDX(t), bufv = (t & 1) * VTILE;
        const bool mine = ((t ^ grp) & 1) == 0;
        if (mine) { if (t + 3 < nt) { rk0 = TILE_LD2(kg, TIDX(t + 3), 0); rk1 = TILE_LD2(kg, TIDX(t + 3), 1); }
                    if (t + 2 < nt) { rv0 = TILE_LD2(vg, TIDX(t + 2), 0); rv1 = TILE_LD2(vg, TIDX(t + 2), 1); } }
        const bool active = ((TYPE == 0) ? (j >= c - 8 && j <= c) : (j <= c)) && !done;
        if (active) {
            const LAS unsigned char* vrd = lds + AL_VT + bufv + vro; const int kbase = 64 * j + 4 * hi;
            if (TYPE == 0) { if (64 * c - (64 * j + 63) >= 256) attn_step<0, false, false, true>(S, kf, qr, vrd, kbase, qpos, 0, 0, hi, aux, cfar); else attn_step<0, false, false, false>(S, kf, qr, vrd, kbase, qpos, 0, 0, hi, aux, cfar); }
            else { if (j == c) attn_step<TYPE, true, false, false>(S, kf, qr, vrd, kbase, qpos, qpos, 0, hi, aux, 0.f); else attn_step<TYPE, false, false, false>(S, kf, qr, vrd, kbase, qpos, 0, 0, hi, aux, 0.f); }
            if (TYPE == 2) done = __all(S.R == 0.f);
        }
        const int ksn = (ksl == 2) ? 0 : ksl + 1, ksw = (ksn == 2) ? 0 : ksn + 1;
        if (t + 1 < nt) {
#pragma unroll
            for (int sub = 0; sub < 2; ++sub)
#pragma unroll
                for (int d0 = 0; d0 < 4; ++d0) kf[sub][d0] = *(const LAS bf16x8*)(lds + AL_KT + ksn * KTILE + kro + sub * 32 * KROWB + 32 * d0); }
        if (!mine) {
            if (t + 2 < nt) { *(LAS u32x4*)(lds + AL_KT + ksw * KTILE + gsk) = rk0; *(LAS u32x4*)(lds + AL_KT + ksw * KTILE + gsk + 32 * KROWB) = rk1;
                row_out<TYPE>(P.okp, b, h, U, TIDX(t + 2), grow, sch, rk0); row_out<TYPE>(P.okp, b, h, U, TIDX(t + 2), grow + 32, sch, rk1); }
            if (t + 1 < nt) { *(LAS u32x4*)(lds + AL_VT + (VTILE - bufv) + gsv) = rv0; *(LAS u32x4*)(lds + AL_VT + (VTILE - bufv) + gsv + 32 * VROWB) = rv1;
                row_out<TYPE>(P.ovp, b, h, U, TIDX(t + 1), grow, sch, rv0); row_out<TYPE>(P.ovp, b, h, U, TIDX(t + 1), grow + 32, sch, rv1); } }
        ksl = ksn;
        if (TYPE == 2 && lane == 0) dflag[wave] = done ? 1u : 0u;
        __syncthreads();
        if (TYPE == 2) { unsigned alld = 1u;
#pragma unroll
            for (int w = 0; w < NWAVES; ++w) alld &= dflag[w];
            if (alld && t >= 2) break; }
    }
#undef TIDX
    float inv = 1.f;
    if (TYPE != 2) { auto rr = __builtin_amdgcn_permlane32_swap(__float_as_uint(S.lsum), __float_as_uint(S.lsum), false, false); inv = 1.0f / (__uint_as_float(rr[0]) + __uint_as_float(rr[1])); }
#undef TILE_LD
#undef TILE_LD2
    { __attribute__((address_space(1))) unsigned char* ob = (__attribute__((address_space(1))) unsigned char*)(P.O + (size_t)b * SEQ * DM + h * HD);
      const int lane2 = opaque_lane(); const unsigned oo = (unsigned)(((32 * qblk + (lane2 & 31)) * DM) * 2 + ((lane2 >> 5) ? 16 : 0));
      u32x2 grp[8];
#pragma unroll
      for (int g = 0; g < 4; ++g) { grp[g].x = pkbf(S.o0[4 * g] * inv, S.o0[4 * g + 1] * inv); grp[g].y = pkbf(S.o0[4 * g + 2] * inv, S.o0[4 * g + 3] * inv);
        grp[4 + g].x = pkbf(S.o1[4 * g] * inv, S.o1[4 * g + 1] * inv); grp[4 + g].y = pkbf(S.o1[4 * g + 2] * inv, S.o1[4 * g + 3] * inv); }
#pragma unroll
      for (int k = 0; k < 8; k += 2) {
          auto rx = __builtin_amdgcn_permlane32_swap(grp[k].x, grp[k + 1].x, false, false); auto ry = __builtin_amdgcn_permlane32_swap(grp[k].y, grp[k + 1].y, false, false);
          const unsigned ax = rx[0], bx2 = rx[1], ay = ry[0], by2 = ry[1];
          u32x4 w; w.x = ax; w.y = ay; w.z = bx2; w.w = by2;
          *(__attribute__((address_space(1))) u32x4*)(ob + oo + 16 * k) = w; } }
}

template <int TYPE>
__device__ __forceinline__ void attn_sample_unit(const AttnP& P, int b, int h, LAS unsigned char* lds, int wave, unsigned nxt, volatile LAS unsigned* slot) {
    const int lane = opaque_lane(), tid = wave * 64 + lane;
    constexpr int NCACHE = (TYPE == 0) ? ACACHE : PAST, NTC = NCACHE / 64, TPW = NTC / 8;
    const int r32 = lane & 31, hi = lane >> 5, li = lane & 15, q16 = r32 & 15;
    const size_t qrow = (size_t)MP + b * DS + q16; const int qpos = NCACHE + q16;
    LAS float* aux = (LAS float*)(lds + AL_AUXS); LAS unsigned char* vl = lds + AL_VS + wave * VTILE; LAS unsigned char* kl = lds + (wave < 5 ? AL_KS1 + wave * KHALF : AL_KS2 + (wave - 5) * KHALF);
    if (TYPE == 1) { const float* src = P.cums + (size_t)(b * NH + h) * 1088; for (int i = tid; i < 1088; i += NWAVES * 64) aux[i] = -src[i]; }
    if (TYPE == 0) fill_bias_table(aux, P.tbl + h * TBLP, tid);
    const float cfar = (TYPE == 0) ? P.tbl[h * TBLP + 512] : 0.f;
    bf16x8 qr[4];
    { const bf16_t* qp = P.Q + qrow * DM + h * HD + 8 * hi;
#pragma unroll
      for (int d0 = 0; d0 < 4; ++d0) qr[d0] = *(const bf16x8*)(qp + 16 * d0); }
    if (tid == 0) slot[1] = nxt;
    __syncthreads();
    AttState S; S.o0 = f32x16{}; S.o1 = f32x16{}; S.mrun = -1e30f; S.lsum = 0.f; S.R = 1.f; S.basep = wave >> 2;
    const int vro = (4 * hi + (li >> 2)) * VROWB + (16 * ((lane >> 4) & 1) + 4 * (li & 3)) * 2;
    const int ntw = TPW + (wave == 7 ? 1 : 0);
#pragma unroll 1
    for (int t = 0; t < ntw; ++t) {
        const int j = (TYPE == 2) ? ((wave + 1) * TPW - 1 + (wave == 7 ? 1 : 0) - t) : (wave * TPW + t);
        bf16x8 kf[2][4];
        if (j == NTC) {
            typedef __attribute__((address_space(1))) const unsigned char gcb2;
            gcb2* kb2 = (gcb2*)(P.K + ((size_t)MP + b * DS) * DM + h * HD); gcb2* vb2 = (gcb2*)(P.V + ((size_t)MP + b * DS) * DM + h * HD);
#pragma unroll
            for (int sub = 0; sub < 2; ++sub) { const int kr = 32 * sub + r32; const unsigned ko = (unsigned)(((kr < DS - 1 ? kr : DS - 1) * DM + 8 * hi) * 2);
#pragma unroll
                for (int d0 = 0; d0 < 4; ++d0) kf[sub][d0] = *(__attribute__((address_space(1))) const bf16x8*)(kb2 + ko + 32 * d0); }
            u32x4 vv[8];
#pragma unroll
            for (int i = 0; i < 8; ++i) { const int row = 8 * i + (lane >> 3); vv[i] = *(__attribute__((address_space(1))) const u32x4*)(vb2 + (unsigned)(((row < DS - 1 ? row : DS - 1) * DM + 8 * (lane & 7)) * 2)); }
#pragma unroll
            for (int i = 0; i < 8; ++i) { const int row = 8 * i + (lane >> 3); *(LAS u32x4*)(vl + row * VROWB + 16 * (lane & 7)) = vv[i]; }
        } else {
            typedef __attribute__((address_space(1))) const unsigned char gcb;
            gcb* kb = (gcb*)(P.ck + (((size_t)b * NCACHE + 64 * j) * NH + h) * HD); gcb* vb = (gcb*)(P.cv + (((size_t)b * NCACHE + 64 * j) * NH + h) * HD);
            const unsigned voff = (unsigned)((lane >> 4) * (NH * HD * 4) + li * 16);
            f32x4 kk[16], vv[16];
#pragma unroll
            for (int i = 0; i < 16; ++i) { gcb* kbi = kb + i * 4 * (NH * HD * 4); kk[i] = *(__attribute__((address_space(1))) const f32x4*)(kbi + voff); }
#pragma unroll
            for (int i = 0; i < 16; ++i) { gcb* vbi = vb + i * 4 * (NH * HD * 4); vv[i] = *(__attribute__((address_space(1))) const f32x4*)(vbi + voff); }
#pragma unroll
            for (int sub = 0; sub < 2; ++sub) {
#pragma unroll
                for (int i = 0; i < 8; ++i) { const int row = 4 * i + (lane >> 4); u32x2 w; w.x = pkbf(kk[8 * sub + i].x, kk[8 * sub + i].y); w.y = pkbf(kk[8 * sub + i].z, kk[8 * sub + i].w); *(LAS u32x2*)(kl + row * KROWB + 8 * li) = w; }
#pragma unroll
                for (int d0 = 0; d0 < 4; ++d0) kf[sub][d0] = *(const LAS bf16x8*)(kl + r32 * KROWB + 16 * hi + 32 * d0);
            }
#pragma unroll
            for (int i = 0; i < 16; ++i) { const int row = 4 * i + (lane >> 4); u32x2 w; w.x = pkbf(vv[i].x, vv[i].y); w.y = pkbf(vv[i].z, vv[i].w); *(LAS u32x2*)(vl + row * VROWB + 8 * li) = w; }
        }
        { const int kbase = 64 * j + 4 * hi; const bool isnew = (j == NTC);
          if (TYPE == 0) { const bool far = (NCACHE - (64 * j + 63)) >= 256;
              if (isnew) attn_step<0, false, true, false>(S, kf, qr, vl + vro, kbase, qpos, 0, NCACHE + DS, hi, aux, cfar);
              else if (far) attn_step<0, false, false, true>(S, kf, qr, vl + vro, kbase, qpos, 0, 0, hi, aux, cfar);
              else attn_step<0, false, false, false>(S, kf, qr, vl + vro, kbase, qpos, 0, 0, hi, aux, cfar); }
          else { if (isnew) attn_step<TYPE, true, false, false>(S, kf, qr, vl + vro, kbase, qpos, qpos, 0, hi, aux, 0.f); else attn_step<TYPE, false, false, false>(S, kf, qr, vl + vro, kbase, qpos, 0, 0, hi, aux, 0.f); } }
    }
    LAS float* comb = (LAS float*)(lds + AL_VS + wave * VTILE); LAS float* cst = (LAS float*)(lds + AL_CST) + wave * 32;
    float ltot = 0.f;
    if (TYPE != 2) { auto rr = __builtin_amdgcn_permlane32_swap(__float_as_uint(S.lsum), __float_as_uint(S.lsum), false, false); ltot = __uint_as_float(rr[0]) + __uint_as_float(rr[1]); }
    if (r32 < 16) {
#pragma unroll
        for (int r = 0; r < 16; ++r) { const int d = (r & 3) + 8 * (r >> 2) + 4 * hi; comb[q16 * 64 + d] = S.o0[r]; comb[q16 * 64 + 32 + d] = S.o1[r]; }
        if (hi == 0) { cst[q16] = (TYPE == 2) ? S.R : S.mrun; cst[16 + q16] = ltot; }
    }
    __syncthreads();
    { const int tid2 = wave * 64 + opaque_lane(); const int q = tid2 >> 5, d2 = (tid2 & 31) * 2; const LAS float* cb = (const LAS float*)(lds + AL_VS); const LAS float* cs = (const LAS float*)(lds + AL_CST);
      float n0 = 0.f, n1 = 0.f;
      if (TYPE == 2) { float f = 1.f;
#pragma unroll
          for (int w = 7; w >= 0; --w) { n0 += f * cb[w * (VTILE / 4) + q * 64 + d2]; n1 += f * cb[w * (VTILE / 4) + q * 64 + d2 + 1]; f *= cs[w * 32 + q]; } }
      else { float mx = cs[q];
#pragma unroll
          for (int w = 1; w < 8; ++w) mx = fmaxf(mx, cs[w * 32 + q]);
          float den = 0.f;
#pragma unroll
          for (int w = 0; w < 8; ++w) { const float f = __builtin_amdgcn_exp2f(cs[w * 32 + q] - mx); den += f * cs[w * 32 + 16 + q]; n0 += f * cb[w * (VTILE / 4) + q * 64 + d2]; n1 += f * cb[w * (VTILE / 4) + q * 64 + d2 + 1]; }
          const float inv = 1.0f / den; n0 *= inv; n1 *= inv; }
      *(unsigned*)(P.O + (size_t)MP * DM + frag_off(b * DS + q, h * HD + d2, DM)) = pkbf(n0, n1); }
    __syncthreads();
}

template <int TYPE>
__device__ __forceinline__ void attn_phase(const AttnP& P, LAS unsigned char* lds, const int wv) {
    PHASE_IDS();
    volatile LAS unsigned* slot = (volatile LAS unsigned*)(lds + MISC_OFF) + 16;
    if (wave >= 4) __builtin_amdgcn_s_setprio(1);
    constexpr unsigned NU = 3 * DB * NH / 8, NS2 = 2 * DB * NH / 8;
    const int xq = bx_ & 7; unsigned* qc = P.qctr + 64 * xq;
    if (tid_ == 0) slot[1] = atomicAdd(qc, 1u);
    __syncthreads();
#pragma unroll 1
    for (;;) {
        const unsigned n = slot[1];
        if (n >= NU) break;
        unsigned nxt = 0u;
        if (tid_ == 0) nxt = atomicAdd(qc, 1u);
        __syncthreads();
        if (n < NS2 && (n & 1u)) { const int s = (int)(n >> 1); attn_sample_unit<TYPE>(P, s >> 1, (s & 1) * 8 + xq, lds, wave, nxt, slot); }
        else { const int p = (n < NS2) ? (int)(n >> 1) : (int)(n - NS2 / 2); const int U = 7 - (p >> 4), bhl = p & 15; attn_prompt_unit<TYPE>(P, bhl >> 1, (bhl & 1) * 8 + xq, U, lds, wave, nxt, slot); }
        __syncthreads();
    }
    __builtin_amdgcn_s_setprio(0);
}
__global__ void __launch_bounds__(NWAVES * 64, 2) fwd_kernel(KArgs A0) {
    extern __shared__ __attribute__((aligned(16))) unsigned char lds_raw[];
    LAS unsigned char* lds = (LAS unsigned char*)lds_raw;
    volatile LAS unsigned* MISC = (volatile LAS unsigned*)(lds + MISC_OFF);
    const int tid = threadIdx.x; const int G0 = gridDim.x, bx0 = blockIdx.x; const int wv = __builtin_amdgcn_readfirstlane(tid >> 6);
    for (int u = tid; u < (LDS_BYTES - RING_BYTES) / 4; u += NWAVES * 64) ((LAS unsigned*)(lds + RING_BYTES))[u] = 0u;
    __syncthreads();
    unsigned* ctl = (unsigned*)(A0.ws + WS_CTL);
    XcdBarrier bar = xcd_barrier_post(ctl + CW_BAR, MISC + 8);
    unsigned char* ws = A0.ws;
    bf16_t* HB = (bf16_t*)(ws + WS_HB); bf16_t* ACT = (bf16_t*)(ws + WS_ACT); bf16_t* QKV = (bf16_t*)(ws + WS_QKV); bf16_t* OB = (bf16_t*)(ws + WS_O);

    float* SS = (float*)(ws + WS_SS);
    prologue_phase(A0, lds, wv);
    xcd_barrier(bar, wv);
    KA2 A; A.out = A0.out; A.ws = A0.ws;

#pragma unroll 1
    for (int step = 0; step < 3 * DEPTH; ++step) {
        const int L = step / 3, sb = step % 3, kind = L % 3, slot = L / 3;
        int G = G0, bx = bx0; asm volatile("" : "+s"(G), "+s"(bx));
        unsigned char* wl = ws + WS_W + (size_t)(L % WSLOTS) * WL_SIZE;
        if (sb != 1) {
            { pg8::Gemm g{HB, (const bf16_t*)(wl + (sb == 0 ? WL_GU1 : WL_GU2)), M, 2 * FF, DM}; pg8::StaticOrder S; S.init(M, 2 * FF, G, bx);
              pg8::EpiSwiGLU E{ACT, FF, (LAS float*)(lds + MSL_OFF), MP, 0, SS};
              pg8::gemm_phase<pg8::EpiSwiGLU, pg8::StaticOrder, true, true>(lds, g, S, E, wv);
              {
                  const int nwg = S.nwg, umax = (nwg + G - 1) / G; int c0 = (nwg % G == 0) ? G : nwg - (umax - 1) * G, nc = G - c0; if (nc < 32) { c0 = 0; nc = G; }
                  if (bx >= c0) convert_tail(A, lds, (sb == 0) ? 1 : 2, L, c0, nc, wv); } }
            xcd_barrier(bar, wv);
            { const bf16_t* wd = (const bf16_t*)(wl + (sb == 0 ? WL_DN1 : WL_DN2));
              pg8::Gemm g{ACT, wd, MP, DM, FF}; pg8::StaticOrder S; S.init(MP, DM, G, bx);
              pg8::EpiResid E{HB, SS, 0.5f};
              pg8::gemm_phase<pg8::EpiResid, pg8::StaticOrder, true, true>(lds, g, S, E, wv);
              SEpiResid SE{HB + (size_t)MP * DM, SS + (size_t)MP * 16, 0.5f, (bf16_t*)(ws + WS_XBF)};
              small_gemm<FF, 8, 64, 6, SEpiResid>(lds, ACT + (size_t)MP * FF, (const bf16_t*)(wl + (sb == 0 ? WL_DN1F : WL_DN2F)), DM, SE, wv); }
            xcd_barrier(bar, wv);
        } else {
            if (kind == 1) fgate_step(A, INP(24) + (size_t)slot * NH, wv);
            { const bf16_t* wq = (const bf16_t*)(wl + WL_QKV);
              float *oks, *ovs;
              if (kind == 0) { oks = A.out + O_AKS + (size_t)slot * MS * DM; ovs = A.out + O_AVS + (size_t)slot * MS * DM; }
              else if (kind == 1) { oks = A.out + O_BKS; ovs = A.out + O_BVS; }
              else { oks = A.out + O_CKS; ovs = A.out + O_CVS; }
              pg8::Gemm g{HB, wq, MP, 3 * DM, DM}; pg8::StaticOrder S; S.init(MP, 3 * DM, G, bx);
              pg8::EpiQKV E;
              E.qkv = QKV; E.tstride = QKV_T; E.qscale = QSCALE; E.msl = (LAS float*)(lds + MSL_OFF); E.ord = 0; E.SS = SS;
              pg8::gemm_phase<pg8::EpiQKV, pg8::StaticOrder, true, true>(lds, g, S, E, wv);
              SEpiQKV SE{QKV + (size_t)MP * DM, QKV_T, QSCALE, oks, ovs, SS + (size_t)MP * 16};
              small_gemm<DM, 4, 96, 4, SEpiQKV>(lds, (const bf16_t*)(ws + WS_XBF), (const bf16_t*)(wl + WL_QKVF), 3 * DM, SE, wv); }
            xcd_barrier(bar, wv);
            if (kind == 1) { scan_phase(A, wv); xcd_barrier(bar, wv); }
            { AttnP P; P.Q = QKV; P.K = QKV + QKV_T; P.V = QKV + 2 * QKV_T; P.O = OB;
              P.tbl = (const float*)(ws + WS_TBL) + (size_t)slot * NH * TBLP; P.cump = (const float*)(ws + WS_CUMP); P.cums = (const float*)(ws + WS_CUMS); P.qctr = ctl + CW_Q + 512 * L;
              if (kind == 0) { P.okp = A.out + O_AKP + (size_t)slot * NB * AKEEP * DM; P.ovp = A.out + O_AVP + (size_t)slot * NB * AKEEP * DM; } else if (kind == 1) { P.okp = A.out + O_BKP; P.ovp = A.out + O_BVP; } else { P.okp = A.out + O_CKP; P.ovp = A.out + O_CVP; }
              if (kind == 0) { P.ck = INP(2) + (size_t)slot * DB * ACACHE * DM; P.cv = INP(3) + (size_t)slot * DB * ACACHE * DM; attn_phase<0>(P, lds, wv); }
              else if (kind == 1) { P.ck = INP(4); P.cv = INP(5); attn_phase<1>(P, lds, wv); }
              else { P.ck = INP(7); P.cv = INP(8); attn_phase<2>(P, lds, wv); } }
            xcd_barrier(bar, wv);
            { const bf16_t* wo = (const bf16_t*)(wl + WL_WO);
              pg8::Gemm g{OB, wo, MP, DM, DM}; pg8::StaticOrder S; S.init(MP, DM, G, bx);
              pg8::EpiResid E{HB, SS, 1.0f};
              pg8::gemm_phase<pg8::EpiResid, pg8::StaticOrder, true, true>(lds, g, S, E, wv);
              SEpiResid SE{HB + (size_t)MP * DM, SS + (size_t)MP * 16, 1.0f, (bf16_t*)(ws + WS_XBF)};
              small_gemm<DM, 8, 64, 4, SEpiResid>(lds, OB + (size_t)MP * DM, (const bf16_t*)(wl + WL_WOF), DM, SE, wv); }
            xcd_barrier(bar, wv);
        }
    }
    final_norm_phase(A, wv);
}

extern "C" void kernel_launch(void* const* d_in, const int* in_sizes, int n_in, void* d_out, int out_size, void* d_ws, size_t ws_size, hipStream_t stream) {
    static int grid = 0;
    if (grid == 0) {
        if (n_in != 28 || (size_t)out_size != O_END || ws_size < WS_END) { fprintf(stderr, "kernel_launch: unexpected shapes: n_in %d out %d (want %zu) ws %zu (want %zu)\n", n_in, out_size, (size_t)O_END, ws_size, (size_t)WS_END); grid = -1; return; }
        int dev = 0, cus = 0, per_cu = 0;
        if (hipGetDevice(&dev) != hipSuccess || hipDeviceGetAttribute(&cus, hipDeviceAttributeMultiprocessorCount, dev) != hipSuccess) { grid = -1; return; }
        if (hipFuncSetAttribute((const void*)fwd_kernel, hipFuncAttributeMaxDynamicSharedMemorySize, LDS_BYTES) != hipSuccess) { fprintf(stderr, "kernel_launch: hipFuncSetAttribute failed\n"); grid = -1; return; }
        if (hipOccupancyMaxActiveBlocksPerMultiprocessor(&per_cu, (const void*)fwd_kernel, NWAVES * 64, LDS_BYTES) != hipSuccess || per_cu < 1) fprintf(stderr, "kernel_launch: occupancy query reports %d blocks per CU\n", per_cu);
        (void)hipGetLastError();
        if (cus < 243) { fprintf(stderr, "kernel_launch: %d CUs: the per-phase LDS row table holds 6 units per workgroup (needs >= 243 workgroups)\n", cus); grid = -1; return; }
        grid = cus;
    }
    if (grid < 0) return;
    if (hipMemsetAsync((char*)d_ws + WS_CTL, 0, CTL_ZERO_BYTES, stream) != hipSuccess) { fprintf(stderr, "kernel_launch: memset failed\n"); return; }
    KArgs a{};
    for (int i = 0; i < 28; ++i) a.in[i] = (const float*)d_in[i];
    a.out = (float*)d_out; a.ws = (unsigned char*)d_ws;
    hipLaunchKernelGGL(fwd_kernel, dim3(grid), dim3(NWAVES * 64), LDS_BYTES, stream, a);
    const hipError_t le = hipPeekAtLastError();
    if (le != hipSuccess) fprintf(stderr, "kernel_launch: launch failed: %s\n", hipGetErrorName(le));
}
```

```cpp
#include <hip/hip_runtime.h>
#include <cstdio>
#include <cstdint>
namespace pg8 {
#define PG8_LAS __attribute__((address_space(3)))
typedef unsigned short bf16_t;
typedef short bf16x8 __attribute__((ext_vector_type(8)));
typedef float f32x4 __attribute__((ext_vector_type(4)));
typedef unsigned u32x4 __attribute__((ext_vector_type(4)));
constexpr int BM = 256, BK = 64, HALF = 128, HTB = HALF * BK * 2  , STAGE_BYTES = 8 * HTB, NXCD = 8, WGM = 4;

__host__ __device__ __forceinline__ int lds_byte(int r, int c) { const int st = (r >> 4) * 2 + (c >> 5), rr = r & 15, cc = c & 31, ob = rr * 64 + cc * 2; return st * 1024 + (ob ^ (((ob >> 9) & 1) << 5)); }
__host__ __device__ __forceinline__ void stage_rc(int b, int& R, int& C) { const int st = b / 1024, sb = b % 1024, swz = sb ^ (((sb >> 9) & 1) << 5); R = (st >> 1) * 16 + swz / 64; C = (st & 1) * 32 + (swz % 64) / 2; }
__host__ __device__ __forceinline__ int perm32(int rho) { const int n = rho >> 4, i = rho & 15; return 8 * (i >> 2) + 4 * n + (i & 3); }

struct Unit { int pm, pn; };
struct Gemm { const bf16_t* A; const bf16_t* Bt; int M, N, K; };

struct StaticOrder {
    int nM, nN, nwg, G, c;
    __host__ __device__ void init(int M, int N, int G_, int c_) { nM = M / BM; nN = N / BM; nwg = nM * nN; G = G_; c = c_; }
    __host__ __device__ bool next(int i, Unit& u) const {
        const long L = (long)i * G + c; if (L >= nwg) return false;
        int wgid = (int)L; { const int q = nwg / NXCD, r = nwg % NXCD, xcd = wgid % NXCD, off = wgid / NXCD; wgid = (xcd < r ? xcd * (q + 1) : r * (q + 1) + (xcd - r) * q) + off; }
        const int nig = WGM * nN, gid = wgid / nig, fm = gid * WGM, gsz = (nM - fm) < WGM ? (nM - fm) : WGM;
        u.pm = fm + ((wgid % nig) % gsz); u.pn = (wgid % nig) / gsz; return true;
    }
    __device__ __forceinline__ void a_ready(const Unit&) const {}
    __device__ __forceinline__ void done(const Unit&) const {}
};

__device__ __forceinline__ unsigned cvt_pk_bf16(float lo, float hi) { unsigned r; asm volatile("v_cvt_pk_bf16_f32 %0, %1, %2" : "=v"(r) : "v"(lo), "v"(hi)); return r; }
typedef float f32x2 __attribute__((ext_vector_type(2)));
typedef unsigned u32x2 __attribute__((ext_vector_type(2)));
typedef __bf16 bf16x2_t __attribute__((ext_vector_type(2)));
__device__ __forceinline__ unsigned pkbf(float lo, float hi) { f32x2 v = {lo, hi}; bf16x2_t b = __builtin_convertvector(v, bf16x2_t); return __builtin_bit_cast(unsigned, b); }

__device__ __forceinline__ float xor16_f(float v) { return __builtin_bit_cast(float, __builtin_amdgcn_ds_swizzle(__builtin_bit_cast(int, v), 0x401F)); }
__device__ __forceinline__ float sum_xor32(float v) { const unsigned a = __builtin_bit_cast(unsigned, v); auto r = __builtin_amdgcn_permlane32_swap(a, a, false, false);
    const unsigned r0 = r[0], r1 = r[1]; return __builtin_bit_cast(float, r0) + __builtin_bit_cast(float, r1); }
template <int CTRL> __device__ __forceinline__ float dpp_f(float v) { return __builtin_bit_cast(float, __builtin_amdgcn_update_dpp(0, __builtin_bit_cast(int, v), CTRL, 0xF, 0xF, true)); }
__device__ __forceinline__ float sum_row16(float v) { v += dpp_f<0x128>(v); v += dpp_f<0x124>(v); v += dpp_f<0x122>(v); v += dpp_f<0x121>(v); return v; }
__device__ __forceinline__ float sum_quad(float v) { v += dpp_f<0xB1>(v); v += dpp_f<0x4E>(v); return v; }
__device__ __forceinline__ float row_scale(const float* SS, int row) {
    const f32x4* p = (const f32x4*)(SS + (size_t)row * 16); const f32x4 a = p[0], b = p[1], c = p[2], d = p[3];
    const float s = ((a.x + a.y) + (a.z + a.w)) + ((b.x + b.y) + (b.z + b.w)) + ((c.x + c.y) + (c.z + c.w)) + ((d.x + d.y) + (d.z + d.w));
    return __builtin_amdgcn_rsqf(s * (1.0f / 1024.0f) + 1e-6f);
}
__device__ __forceinline__ void row_scales8(const float* SS, int row0, int fq, float (&rs)[2][4]) {
    f32x4 t[2][4];
#pragma unroll
    for (int ai = 0; ai < 2; ++ai)
#pragma unroll
        for (int m = 0; m < 4; ++m) t[ai][m] = *(const f32x4*)(SS + (size_t)(row0 + ai * HALF + m * 16) * 16 + 4 * fq);
#pragma unroll
    for (int ai = 0; ai < 2; ++ai)
#pragma unroll
        for (int m = 0; m < 4; ++m) { float s = (t[ai][m].x + t[ai][m].y) + (t[ai][m].z + t[ai][m].w); s += xor16_f(s); s = sum_xor32(s); rs[ai][m] = __builtin_amdgcn_rsqf(s * (1.0f / 1024.0f) + 1e-6f); }
}
__device__ __forceinline__ void row_scales8_ms(const float* SS, int row0, int fq, float (&rs)[2][4], float (&ms)[2][4]) {
    f32x4 t[2][4];
#pragma unroll
    for (int ai = 0; ai < 2; ++ai)
#pragma unroll
        for (int m = 0; m < 4; ++m) t[ai][m] = *(const f32x4*)(SS + (size_t)(row0 + ai * HALF + m * 16) * 16 + 4 * fq);
#pragma unroll
    for (int ai = 0; ai < 2; ++ai)
#pragma unroll
        for (int m = 0; m < 4; ++m) { float s = (t[ai][m].x + t[ai][m].y) + (t[ai][m].z + t[ai][m].w); s += xor16_f(s); s = sum_xor32(s); ms[ai][m] = s * (1.0f / 1024.0f) + 1e-6f; rs[ai][m] = __builtin_amdgcn_rsqf(ms[ai][m]); }
}
template <class Sched>
__device__ __forceinline__ void ms_prepass(PG8_LAS float* msl, const Sched& S, const float* SS, int tid) {
    f32x4 t[3][4]; bool ok[3]; Unit u;
#pragma unroll
    for (int k = 0; k < 3; ++k) { const int idx = tid + 512 * k; ok[k] = S.next(idx >> 8, u);
        if (ok[k]) { const f32x4* p = (const f32x4*)(SS + (size_t)(u.pm * BM + (idx & 255)) * 16); t[k][0] = p[0]; t[k][1] = p[1]; t[k][2] = p[2]; t[k][3] = p[3]; } }
#pragma unroll
    for (int k = 0; k < 3; ++k) if (ok[k]) { const f32x4 a = t[k][0], b = t[k][1], c = t[k][2], d = t[k][3];
        const float s = ((a.x + a.y) + (a.z + a.w)) + ((b.x + b.y) + (b.z + b.w)) + ((c.x + c.y) + (c.z + c.w)) + ((d.x + d.y) + (d.z + d.w));
        msl[tid + 512 * k] = s * (1.0f / 1024.0f) + 1e-6f; }
    asm volatile("s_waitcnt lgkmcnt(0)" ::: "memory"); __builtin_amdgcn_s_barrier();
}
struct EpiSwiGLU {
    static constexpr bool PERM = true, AFTER_DRAIN = false;
    bf16_t* act; int ldc; PG8_LAS float* msl; int mp; mutable int ord; const float* SS;
    template <class Sched> __device__ __forceinline__ void begin(const Sched& S, int tid) const { ms_prepass(msl, S, SS, tid); }
    __device__ __forceinline__ void operator()(const f32x4 (&acc)[2][2][4][2], const Unit& u, int wr, int wc, int fr, int fq) const {
        const int row0 = u.pm * BM + wr * 64 + fr, col0 = u.pn * HALF + wc * 32 + 8 * fq;
        const PG8_LAS float* mq = msl + ord * 256 + wr * 64 + fr; ++ord;
        float rsv[2][4], msv[2][4];
#pragma unroll
        for (int ai = 0; ai < 2; ++ai)
#pragma unroll
            for (int m = 0; m < 4; ++m) { msv[ai][m] = mq[ai * HALF + m * 16]; rsv[ai][m] = __builtin_amdgcn_rsqf(msv[ai][m]); }
#pragma unroll
        for (int ai = 0; ai < 2; ++ai)
#pragma unroll
            for (int m = 0; m < 4; ++m) {
                const int row = row0 + ai * HALF + m * 16; const float ms = msv[ai][m], ce = -1.4426950408889634f * rsv[ai][m];
                bf16_t* rowp = (u.pm * BM >= mp) ? act + (size_t)mp * ldc + ((size_t)((row - mp) >> 4) * (ldc >> 5) + (col0 >> 5)) * 512 + (fq * 16 + fr) * 8 : act + (size_t)row * ldc + col0;
                float o[8];
#pragma unroll
                for (int n = 0; n < 2; ++n)
#pragma unroll
                    for (int e = 0; e < 4; ++e) { const float g = acc[ai][0][m][n][e], up = acc[ai][1][m][n][e];
                        const float t = __builtin_amdgcn_exp2f(g * ce); const float s = __builtin_amdgcn_rcpf(__builtin_fmaf(t, ms, ms)); o[n * 4 + e] = (g * up) * s; }
                u32x4 w; w.x = pkbf(o[0], o[1]); w.y = pkbf(o[2], o[3]); w.z = pkbf(o[4], o[5]); w.w = pkbf(o[6], o[7]);
                *(u32x4*)rowp = w; }
    }
};
__device__ __forceinline__ float bflo(unsigned w) { return __builtin_bit_cast(float, w << 16); }
__device__ __forceinline__ float bfhi(unsigned w) { return __builtin_bit_cast(float, w & 0xffff0000u); }
struct EpiResid {
    static constexpr bool PERM = true, AFTER_DRAIN = false;
    bf16_t* xb; float* SS; float c;
    template <class Sched> __device__ __forceinline__ void begin(const Sched&, int) const {}
    __device__ __forceinline__ void operator()(const f32x4 (&acc)[2][2][4][2], const Unit& u, int wr, int wc, int fr, int fq) const {
        const int row0 = u.pm * BM + wr * 64 + fr, col0 = u.pn * BM + wc * 32 + 8 * fq;
        u32x4 in[2][4][2];
#pragma unroll
        for (int ai = 0; ai < 2; ++ai)
#pragma unroll
            for (int m = 0; m < 4; ++m)
#pragma unroll
                for (int bj = 0; bj < 2; ++bj) in[ai][m][bj] = *(const u32x4*)(xb + (size_t)(row0 + ai * HALF + m * 16) * 1024 + col0 + bj * HALF);
        asm volatile("" ::: "memory");
#pragma unroll
        for (int ai = 0; ai < 2; ++ai)
#pragma unroll
            for (int m = 0; m < 4; ++m) { const int row = row0 + ai * HALF + m * 16; bf16_t* p = xb + (size_t)row * 1024 + col0; float ss = 0.f;
#pragma unroll
                for (int bj = 0; bj < 2; ++bj) { const u32x4 iv = in[ai][m][bj]; const f32x4 a0 = acc[ai][bj][m][0], a1 = acc[ai][bj][m][1];
                    const float x0 = __builtin_fmaf(a0[0], c, bflo(iv.x)), x1 = __builtin_fmaf(a0[1], c, bfhi(iv.x)), x2 = __builtin_fmaf(a0[2], c, bflo(iv.y)), x3 = __builtin_fmaf(a0[3], c, bfhi(iv.y));
                    const float x4 = __builtin_fmaf(a1[0], c, bflo(iv.z)), x5 = __builtin_fmaf(a1[1], c, bfhi(iv.z)), x6 = __builtin_fmaf(a1[2], c, bflo(iv.w)), x7 = __builtin_fmaf(a1[3], c, bfhi(iv.w));
                    u32x4 w; w.x = pkbf(x0, x1); w.y = pkbf(x2, x3); w.z = pkbf(x4, x5); w.w = pkbf(x6, x7);
                    *(u32x4*)(p + bj * HALF) = w;
                    ss += ((x0 * x0 + x1 * x1) + (x2 * x2 + x3 * x3)) + ((x4 * x4 + x5 * x5) + (x6 * x6 + x7 * x7)); }
                ss += xor16_f(ss); ss = sum_xor32(ss);
                if (fq == 0) SS[(size_t)row * 16 + u.pn * 4 + wc] = ss; }
    }
};
struct EpiQKV {
    static constexpr bool PERM = true, AFTER_DRAIN = false;
    bf16_t* qkv; size_t tstride; float qscale;
    PG8_LAS float* msl; mutable int ord; const float* SS;
    template <class Sched> __device__ __forceinline__ void begin(const Sched& S, int tid) const { ms_prepass(msl, S, SS, tid); }
    __device__ __forceinline__ void operator()(const f32x4 (&acc)[2][2][4][2], const Unit& u, int wr, int wc, int fr, int fq) const {
        typedef __attribute__((address_space(1))) unsigned char gbyte;
        const int t = u.pn >> 2; const int colt = (u.pn & 3) * BM;
        gbyte* bb = (gbyte*)(qkv + (size_t)t * tstride + (size_t)u.pm * BM * 1024); const float sc = (t == 0) ? qscale : 1.0f;
        const PG8_LAS float* mq = msl + ord * 256 + wr * 64 + fr; ++ord;
        float rsv[2][4];
#pragma unroll
        for (int ai = 0; ai < 2; ++ai)
#pragma unroll
            for (int m = 0; m < 4; ++m) rsv[ai][m] = __builtin_amdgcn_rsqf(mq[ai * HALF + m * 16]);
        const unsigned loff = (unsigned)((wr * 64 + fr) * 1024 + colt + wc * 32 + 8 * fq);
#pragma unroll
        for (int ai = 0; ai < 2; ++ai)
#pragma unroll
            for (int m = 0; m < 4; ++m) { const unsigned o = loff + (unsigned)((ai * HALF + m * 16) * 1024); const float rs = rsv[ai][m], scq = sc * rs;
#pragma unroll
                for (int bj = 0; bj < 2; ++bj) { const f32x4 v0 = acc[ai][bj][m][0] * scq, v1 = acc[ai][bj][m][1] * scq;
                    u32x4 w; w.x = pkbf(v0[0], v0[1]); w.y = pkbf(v0[2], v0[3]); w.z = pkbf(v1[0], v1[1]); w.w = pkbf(v1[2], v1[3]);
                    *(__attribute__((address_space(1))) u32x4*)(bb + (size_t)(o + bj * HALF) * 2) = w;
                }
                if (m & 1) asm volatile("" ::: "memory"); }
    }
};
template <class Epi, class Sched, bool ALIGN_EPI = false, bool SP2 = false>
__device__ __forceinline__ void gemm_phase(PG8_LAS unsigned char* lds, const Gemm g, const Sched& S, const Epi& E, const int wv) {
    int lane; asm volatile("v_mbcnt_lo_u32_b32 %0, -1, 0\n\tv_mbcnt_hi_u32_b32 %0, -1, %0" : "=v"(lane)); int wid = wv; asm volatile("" : "+s"(wid)); const int tid = wid * 64 + lane, wr = wid >> 2, wc = wid & 3, fr = lane & 15, fq = lane >> 4;
    const int K = g.K, nt = K / BK;
    unsigned voffA[2], voffB[2];
#pragma unroll
    for (int i = 0; i < 2; ++i) { int R, C; stage_rc(tid * 16 + i * 8192, R, C); const int Rb = Epi::PERM ? ((R & ~31) + perm32(R & 31)) : R;
        voffA[i] = (unsigned)(R * K + C) * 2u; voffB[i] = (unsigned)(Rb * K + C) * 2u; }
    const size_t kstep = (size_t)(BK * 2);
    const size_t hstep = (size_t)HALF * K * 2;
    const size_t tstep = 2 * hstep;
    const unsigned ldsw = (unsigned)wid * 1024u;
    const int aoff = lds_byte(wr * 64 + fr, fq * 8), boff = lds_byte(wc * 32 + fr, fq * 8);
#define PG8_SA(b, h) (((b) * 2 + (h)) * HTB)
#define PG8_SB(b, h) ((4 + (b) * 2 + (h)) * HTB)
#define PG8_STAGE(bufoff, gbase, voff) do { _Pragma("unroll") for (int _i = 0; _i < 2; ++_i) \
        __builtin_amdgcn_global_load_lds((const unsigned*)((const char*)(gbase) + (voff)[_i]), (PG8_LAS unsigned*)(lds + (bufoff) + ldsw + _i * 8192), 16, 0, 0); } while (0)
#define PG8_LDA(dst, b, h) do { _Pragma("unroll") for (int m = 0; m < 4; ++m) _Pragma("unroll") for (int k = 0; k < 2; ++k) dst[m][k] = *(const PG8_LAS bf16x8*)(lds + PG8_SA(b, h) + aoff + m * 2048 + k * 1024); } while (0)
#define PG8_LDB(dst, b, h) do { _Pragma("unroll") for (int n = 0; n < 2; ++n) _Pragma("unroll") for (int k = 0; k < 2; ++k) dst[n][k] = *(const PG8_LAS bf16x8*)(lds + PG8_SB(b, h) + boff + n * 2048 + k * 1024); } while (0)
#define PG8_MMA(ai, bj, At, Bt) do { __builtin_amdgcn_s_setprio(1); _Pragma("unroll") for (int m = 0; m < 4; ++m) _Pragma("unroll") for (int n = 0; n < 2; ++n) _Pragma("unroll") for (int k = 0; k < 2; ++k) \
        acc[ai][bj][m][n] = __builtin_amdgcn_mfma_f32_16x16x32_bf16(Bt[n][k], At[m][k], acc[ai][bj][m][n], 0, 0, 0); __builtin_amdgcn_s_setprio(0); } while (0)
#define PG8_WAIT_V(n) asm volatile("s_waitcnt vmcnt(" #n ")" ::: "memory")
#define PG8_WAIT_L(n) asm volatile("s_waitcnt lgkmcnt(" #n ")" ::: "memory")
#define PG8_BAR __builtin_amdgcn_s_barrier()
#define PG8_SCHED __builtin_amdgcn_sched_barrier(0)
    Unit cur, nxt; int ui = 0;
    if (!S.next(0, cur)) return;
    f32x4 acc[2][2][4][2];
#pragma unroll
    for (int a = 0; a < 2; ++a)
#pragma unroll
        for (int b = 0; b < 2; ++b)
#pragma unroll
            for (int m = 0; m < 4; ++m)
#pragma unroll
                for (int n = 0; n < 2; ++n) acc[a][b][m][n] = (f32x4){0.f, 0.f, 0.f, 0.f};
    bf16x8 At[4][2], B0[2][2], B1[2][2];
    const char* cA = (const char*)g.A + (size_t)cur.pm * tstep; const char* cB = (const char*)g.Bt + (size_t)cur.pn * tstep;
    S.a_ready(cur);
    if constexpr (SP2) {
        PG8_STAGE(PG8_SB(0, 0), cB, voffB); PG8_STAGE(PG8_SB(0, 1), cB + hstep, voffB); PG8_STAGE(PG8_SA(0, 0), cA, voffA); PG8_STAGE(PG8_SA(0, 1), cA + hstep, voffA);
        E.begin(S, tid);
        if (wr == 1) PG8_BAR;
        PG8_WAIT_V(2); PG8_BAR;
        PG8_STAGE(PG8_SB(1, 0), cB + kstep, voffB); PG8_STAGE(PG8_SA(1, 0), cA + kstep, voffA); PG8_STAGE(PG8_SB(1, 1), cB + hstep + kstep, voffB);
        PG8_WAIT_V(6); PG8_BAR;
    } else {
        PG8_STAGE(PG8_SB(0, 0), cB, voffB); PG8_STAGE(PG8_SA(0, 0), cA, voffA); PG8_STAGE(PG8_SB(0, 1), cB + hstep, voffB); PG8_STAGE(PG8_SA(0, 1), cA + hstep, voffA);
        if (wr == 1) PG8_BAR;
        PG8_WAIT_V(4); PG8_BAR;
        PG8_STAGE(PG8_SB(1, 0), cB + kstep, voffB); PG8_STAGE(PG8_SA(1, 0), cA + kstep, voffA); PG8_STAGE(PG8_SB(1, 1), cB + hstep + kstep, voffB);
        PG8_WAIT_V(6); PG8_BAR;
    }
    for (;;) {
        const bool has_next = S.next(ui + 1, nxt);
        const char* nA = has_next ? (const char*)g.A + (size_t)nxt.pm * tstep : cA; const char* nB = has_next ? (const char*)g.Bt + (size_t)nxt.pn * tstep : cB;
        for (int t = 0; t < nt; t += 2) {
            const bool last = (t == nt - 2);
            const char* a1 = cA + (size_t)(t + 1) * kstep;
            const char* a2 = last ? nA : cA + (size_t)(t + 2) * kstep; const char* b2 = last ? nB : cB + (size_t)(t + 2) * kstep;
            const char* a3 = a2 + kstep; const char* b3 = b2 + kstep;
            if (last && has_next) S.a_ready(nxt);
            if constexpr (SP2) {
            PG8_LDB(B0, 0, 0); PG8_LDB(B1, 0, 1); PG8_SCHED; PG8_LDA(At, 0, 0); PG8_STAGE(PG8_SA(1, 1), a1 + hstep, voffA);
            PG8_WAIT_V(8); PG8_WAIT_L(0); PG8_BAR; PG8_MMA(0, 0, At, B0); PG8_MMA(0, 1, At, B1); PG8_BAR; PG8_SCHED;
            PG8_LDA(At, 0, 1); PG8_STAGE(PG8_SB(0, 0), b2, voffB); PG8_STAGE(PG8_SB(0, 1), b2 + hstep, voffB); PG8_STAGE(PG8_SA(0, 0), a2, voffA);
            PG8_WAIT_V(8); PG8_WAIT_L(0); PG8_BAR; PG8_MMA(1, 0, At, B0); PG8_MMA(1, 1, At, B1); PG8_BAR; PG8_SCHED;
            PG8_LDB(B0, 1, 0); PG8_LDB(B1, 1, 1); PG8_SCHED; PG8_LDA(At, 1, 0); PG8_STAGE(PG8_SA(0, 1), a2 + hstep, voffA);
            PG8_WAIT_V(8); PG8_WAIT_L(0); PG8_BAR; PG8_MMA(0, 0, At, B0); PG8_MMA(0, 1, At, B1); PG8_BAR; PG8_SCHED;
            PG8_LDA(At, 1, 1); PG8_STAGE(PG8_SB(1, 0), b3, voffB); PG8_STAGE(PG8_SB(1, 1), b3 + hstep, voffB); PG8_STAGE(PG8_SA(1, 0), a3, voffA);
            PG8_WAIT_V(8); PG8_WAIT_L(0); PG8_BAR; PG8_MMA(1, 0, At, B0); PG8_MMA(1, 1, At, B1); PG8_BAR; PG8_SCHED;
            } else {
            PG8_LDB(B0, 0, 0); PG8_SCHED; PG8_LDA(At, 0, 0); PG8_STAGE(PG8_SA(1, 1), a1 + hstep, voffA);
            PG8_WAIT_L(8); PG8_BAR; PG8_WAIT_L(0); PG8_MMA(0, 0, At, B0); PG8_BAR; PG8_SCHED;
            PG8_LDB(B1, 0, 1); PG8_STAGE(PG8_SB(0, 0), b2, voffB);
            PG8_BAR; PG8_WAIT_L(0); PG8_MMA(0, 1, At, B1); PG8_BAR;
            PG8_LDA(At, 0, 1); PG8_STAGE(PG8_SA(0, 0), a2, voffA);
            PG8_BAR; PG8_WAIT_L(0); PG8_MMA(1, 0, At, B0); PG8_BAR; PG8_SCHED;
            PG8_STAGE(PG8_SB(0, 1), b2 + hstep, voffB);
            PG8_WAIT_V(6); PG8_BAR; PG8_MMA(1, 1, At, B1); PG8_BAR;
            PG8_LDB(B0, 1, 0); PG8_SCHED; PG8_LDA(At, 1, 0); PG8_STAGE(PG8_SA(0, 1), a2 + hstep, voffA);
            PG8_WAIT_L(8); PG8_BAR; PG8_WAIT_L(0); PG8_MMA(0, 0, At, B0); PG8_BAR; PG8_SCHED;
            PG8_LDB(B1, 1, 1); PG8_STAGE(PG8_SB(1, 0), b3, voffB);
            PG8_BAR; PG8_WAIT_L(0); PG8_MMA(0, 1, At, B1); PG8_BAR;
            PG8_LDA(At, 1, 1); PG8_STAGE(PG8_SA(1, 0), a3, voffA);
            PG8_BAR; PG8_WAIT_L(0); PG8_MMA(1, 0, At, B0); PG8_BAR; PG8_SCHED;
            PG8_STAGE(PG8_SB(1, 1), b3 + hstep, voffB);
            PG8_WAIT_V(6); PG8_BAR; PG8_MMA(1, 1, At, B1); PG8_BAR;
            }
        }
        if constexpr (ALIGN_EPI) { if (wr == 0) PG8_BAR; }
        if constexpr (!Epi::AFTER_DRAIN) { E(acc, cur, wr, wc, fr, fq); S.done(cur); }
        if (!has_next) break;
#pragma unroll
        for (int a = 0; a < 2; ++a)
#pragma unroll
            for (int b = 0; b < 2; ++b)
#pragma unroll
                for (int m = 0; m < 4; ++m)
#pragma unroll
                    for (int n = 0; n < 2; ++n) acc[a][b][m][n] = (f32x4){0.f, 0.f, 0.f, 0.f};
        cur = nxt; cA = nA; cB = nB; ++ui;
        if constexpr (ALIGN_EPI) { if (wr == 1) PG8_BAR; }
    }
    PG8_WAIT_V(0);
    if constexpr (!ALIGN_EPI) { if (wr == 0) PG8_BAR; }
    PG8_BAR;
    if constexpr (Epi::AFTER_DRAIN) { E.fused(acc, cur, wr, wc, fr, fq, lds, wid, lane); S.done(cur); }
#undef PG8_SA
#undef PG8_SB
#undef PG8_STAGE
#undef PG8_LDA
#undef PG8_LDB
#undef PG8_MMA
#undef PG8_WAIT_V
#undef PG8_WAIT_L
#undef PG8_BAR
#undef PG8_SCHED
}
}
using pg8::bf16_t; using pg8::bf16x8; using pg8::f32x4; using pg8::u32x4; using pg8::pkbf;
typedef float f32x16 __attribute__((ext_vector_type(16)));
typedef short s16x4 __attribute__((ext_vector_type(4)));
typedef short v4i16_t __attribute__((ext_vector_type(4)));
typedef unsigned u32x2 __attribute__((ext_vector_type(2)));

constexpr int DM = 1024, NH = 16, HD = 64, FF = 2816, SEQ = 2048, NB = 8, DB = 32, DS = 16, PAST = 1024, ACACHE = 512, AKEEP = 512, DEPTH = 4;
constexpr int MP = NB * SEQ, MS = DB * DS, M = MP + MS;
constexpr int NREL = 513, TBLP = 520;
constexpr float RMS_EPS = 1e-6f, LOG2E = 1.4426950408889634f, QSCALE = 0.125f * 1.4426950408889634f;
constexpr int NWAVES = 8;
constexpr size_t O_YP = 0, O_YS = O_YP + (size_t)MP * DM, O_AKP = O_YS + (size_t)MS * DM, O_AVP = O_AKP + (size_t)2 * NB * AKEEP * DM, O_AKS = O_AVP + (size_t)2 * NB * AKEEP * DM,
    O_AVS = O_AKS + (size_t)2 * MS * DM, O_BKP = O_AVS + (size_t)2 * MS * DM, O_BVP = O_BKP + (size_t)MP * DM, O_BFP = O_BVP + (size_t)MP * DM, O_BKS = O_BFP + (size_t)MP * NH,
    O_BVS = O_BKS + (size_t)MS * DM, O_BFS = O_BVS + (size_t)MS * DM, O_CKP = O_BFS + (size_t)MS * NH, O_CVP = O_CKP + (size_t)MP * DM, O_CKS = O_CVP + (size_t)MP * DM,
    O_CVS = O_CKS + (size_t)MS * DM, O_END = O_CVS + (size_t)MS * DM;
constexpr size_t MiB = 1u << 20;
constexpr size_t WS_CTL = 0, CTL_ZERO_BYTES = 1 * MiB;
constexpr size_t W_GU = (size_t)2 * FF * DM * 2, W_DN = (size_t)DM * FF * 2, W_QKV = (size_t)3 * DM * DM * 2, W_WO = (size_t)DM * DM * 2;
constexpr size_t WL_GU1 = 0, WL_DN1 = WL_GU1 + W_GU, WL_QKV = WL_DN1 + W_DN, WL_WO = WL_QKV + W_QKV, WL_GU2 = WL_WO + W_WO, WL_DN2 = WL_GU2 + W_GU,
    WL_DN1F = WL_DN2 + W_DN, WL_DN2F = WL_DN1F + W_DN, WL_QKVF = WL_DN2F + W_DN, WL_WOF = WL_QKVF + W_QKV, WL_SIZE = WL_WOF + W_WO;
constexpr int WSLOTS = 2;
constexpr size_t WS_W = 1 * MiB;
constexpr size_t WS_HB = WS_W + WSLOTS * WL_SIZE;
constexpr size_t WS_ACT = WS_HB + (size_t)M * DM * 2;
constexpr size_t WS_QKV = WS_ACT + (size_t)M * FF * 2;
constexpr size_t QKV_T = (size_t)(M + 64) * DM;
constexpr size_t WS_O = WS_QKV + 3 * QKV_T * 2;
constexpr size_t WS_CUMP = WS_O + (size_t)M * DM * 2;
constexpr size_t WS_CUMS = WS_CUMP + (size_t)128 * SEQ * 4;
constexpr size_t WS_TBL = WS_CUMS + (size_t)512 * 1088 * 4;
constexpr size_t WS_SS = WS_TBL + (size_t)2 * 16 * TBLP * 4;
constexpr size_t WS_WFB = WS_SS + (size_t)M * 16 * 4;
constexpr size_t WS_XBF = WS_WFB + (size_t)NH * DM * 2;
constexpr size_t WS_END = WS_XBF + (size_t)MS * DM * 2;
static_assert(WS_W % 256 == 0 && WL_SIZE % 256 == 0 && WS_HB % 256 == 0 && WS_ACT % 256 == 0 && WS_QKV % 256 == 0 && WS_O % 256 == 0 && WS_CUMP % 256 == 0 && WS_CUMS % 256 == 0 && WS_TBL % 256 == 0 && WS_SS % 256 == 0 && WS_WFB % 256 == 0, "ws alignment");
constexpr int CW_BAR = 4096, CW_Q = 8192;
constexpr size_t WS_PTRS = 512 * 1024;
constexpr int RING_BYTES = 131072, MISC_OFF = RING_BYTES + 320, LDS_BYTES = 147456, MSL_OFF = RING_BYTES + 1024;
static_assert(MSL_OFF + 6 * 256 * 4 <= LDS_BYTES, "LDS map");
constexpr int KROWB = 144, KTILE = 64 * KROWB, VROWB = 192, VTILE = 64 * VROWB;

__device__ __forceinline__ size_t frag_off(int row, int k, int K) { return ((size_t)(row >> 4) * (K >> 5) + (k >> 5)) * 512 + ((((k & 31) >> 3) * 16 + (row & 15)) * 8 + (k & 7)); }
#define GAS __attribute__((address_space(1)))
#define LAS __attribute__((address_space(3)))
#define LDS_WAIT() asm volatile("s_waitcnt lgkmcnt(0)" ::: "memory")
#define XB_TMO      128
#define XB_XCNT(j)  (256  + 64 * (j))
#define XB_XSUB(j)  (1280 + 64 * (j))
#define XB_XGEN(j)  (2304 + 64 * (j))
#define XB_TOP      3328
#define XB_TOPGEN   3392
#define XCD_BAR_WORDS 3456
#define XB_SPIN_CAP (1u << 18)

__device__ __forceinline__ unsigned xb_ld(unsigned* p)              { return __hip_atomic_load(p, __ATOMIC_RELAXED, __HIP_MEMORY_SCOPE_AGENT); }
__device__ __forceinline__ unsigned xb_add(unsigned* p, unsigned v) { return __hip_atomic_fetch_add(p, v, __ATOMIC_RELAXED, __HIP_MEMORY_SCOPE_AGENT); }
__device__ __forceinline__ unsigned xb_xcc_id() { return (unsigned)__builtin_amdgcn_s_getreg((3 << 11) | 20) & 0xFu; }
#define XB_SPIN(cond, bar) do { unsigned _sp = 0; while (cond) { __builtin_amdgcn_s_sleep(1); \
    if ((++_sp & 255u) == 0u) { if (xb_ld(&(bar)[XB_TMO])) break; if (_sp > XB_SPIN_CAP) { atomicAdd(&(bar)[XB_TMO], 1u); break; } } } } while (0)

struct XcdBarrier {
    unsigned* bar; unsigned x;
    volatile LAS unsigned* st;
};

__device__ __forceinline__ XcdBarrier xcd_barrier_post(unsigned* bar, volatile LAS unsigned* st) {
    XcdBarrier b; b.bar = bar; b.x = xb_xcc_id(); b.st = st;
    if (threadIdx.x == 0) (void)xb_add(&bar[XB_XCNT(b.x)], 1u);
    return b;
}
__device__ __forceinline__ void xcd_barrier_complete(unsigned* bar, unsigned x, unsigned& nloc, unsigned& nx) {
    const unsigned G = gridDim.x * gridDim.y * gridDim.z;
    unsigned sum, cnt, mine, sp = 0u;
    for (;;) {
        sum = 0u; cnt = 0u; mine = 0u;
#pragma unroll
        for (unsigned j = 0; j < 16; ++j) { const unsigned c = xb_ld(&bar[XB_XCNT(j)]); sum += c; cnt += (c > 0u) ? 1u : 0u; mine = (j == x) ? c : mine; }
        if (sum == G) break;
        __builtin_amdgcn_s_sleep(1);
        if ((++sp & 255u) == 0u) { if (xb_ld(&bar[XB_TMO])) break; if (sp > XB_SPIN_CAP) { atomicAdd(&bar[XB_TMO], 1u); break; } }
    }
    nloc = mine > 0u ? mine : 1u; nx = cnt > 0u ? cnt : 1u;
}

__device__ __forceinline__ int xb_lane() { int l; asm volatile("v_mbcnt_lo_u32_b32 %0, -1, 0\n\tv_mbcnt_hi_u32_b32 %0, -1, %0" : "=v"(l)); return l; }
__device__ __forceinline__ void xcd_barrier(const XcdBarrier& b, const int wv) {
    asm volatile("s_waitcnt vmcnt(0)" ::: "memory");
    __syncthreads();
    if (wv == 0 && xb_lane() == 0) {
        unsigned* bar = b.bar; unsigned bx_id = __builtin_amdgcn_readfirstlane(b.x); asm volatile("" : "+s"(bx_id));
        __builtin_amdgcn_s_waitcnt(0);
        unsigned nloc = b.st[0], nx = b.st[1];
        if (nloc == 0u) { xcd_barrier_complete(bar, bx_id, nloc, nx); b.st[0] = nloc; b.st[1] = nx; }
        const unsigned old = xb_add(&bar[XB_XSUB(bx_id)], 1u);
        const unsigned gen = old / nloc;
        if (old + 1u == (gen + 1u) * nloc) {
            __builtin_amdgcn_fence(__ATOMIC_RELEASE, "agent");
            asm volatile("s_waitcnt vmcnt(0)" ::: "memory");
            const unsigned og = xb_add(&bar[XB_TOP], 1u);
            const unsigned tg = og / nx;
            if (og + 1u == (tg + 1u) * nx) xb_add(&bar[XB_TOPGEN], 1u);
            else XB_SPIN(xb_ld(&bar[XB_TOPGEN]) == tg, bar);
            __builtin_amdgcn_fence(__ATOMIC_ACQUIRE, "agent");
            xb_add(&bar[XB_XGEN(bx_id)], 1u);
            asm volatile("s_waitcnt vmcnt(0)" ::: "memory");
        } else {
            XB_SPIN(xb_ld(&bar[XB_XGEN(bx_id)]) == gen, bar);
            __builtin_amdgcn_fence(__ATOMIC_ACQUIRE, "agent");
            asm volatile("s_waitcnt vmcnt(0)" ::: "memory");
        }
    }
    __syncthreads();
}
__device__ __forceinline__ int opaque_lane() { int l; asm volatile("v_mbcnt_lo_u32_b32 %0, -1, 0\n\tv_mbcnt_hi_u32_b32 %0, -1, %0" : "=v"(l)); return l; }
#define PHASE_IDS() const int lane = opaque_lane(); int wave = wv; asm volatile("" : "+s"(wave)); const int tid_ = wave * 64 + lane; \
    const int G_ = gridDim.x, bx_ = blockIdx.x, vcu_ = (G_ % 8 == 0) ? (bx_ % 8) * (G_ / 8) + bx_ / 8 : bx_; const int gw = vcu_ * NWAVES + wave, NGW = G_ * NWAVES; (void)lane; (void)gw; (void)NGW
__device__ __forceinline__ float wave_sum(float v) {
    v = pg8::sum_row16(v); v += pg8::xor16_f(v); return pg8::sum_xor32(v);
}
struct TItem { f32x4 v[8]; float gk[8]; };
__device__ __forceinline__ void titem_load(TItem& T, const float* W, int N, int item, int lane, const float* gain) {
    const int nblk = N / 32, kb = item / nblk, nb = item % nblk, k0 = 64 * kb, n0 = 32 * nb; const int rg = lane >> 3, c4 = lane & 7;
#pragma unroll
    for (int i = 0; i < 8; ++i) T.v[i] = __builtin_nontemporal_load((const __attribute__((address_space(1))) f32x4*)(W + (size_t)(k0 + 8 * i + rg) * N + n0 + 4 * c4));
    if (gain) {
#pragma unroll
        for (int i = 0; i < 8; ++i) T.gk[i] = *(const __attribute__((address_space(1))) float*)(gain + k0 + 8 * i + rg);
    } else {
#pragma unroll
        for (int i = 0; i < 8; ++i) T.gk[i] = 1.0f; }
}
__device__ __forceinline__ void titem_finish(const TItem& T, int K, int N, bf16_t* WT, bf16_t* WTF, int mode, LAS float* scr, int item, int lane) {
    const int nblk = N / 32, kb = item / nblk, nb = item % nblk, k0 = 64 * kb, n0 = 32 * nb; const int rg = lane >> 3, c4 = lane & 7;
#pragma unroll
    for (int i = 0; i < 8; ++i) { LAS float* p = scr + (8 * i + rg) * 33 + 4 * c4; p[0] = T.v[i].x * T.gk[i]; p[1] = T.v[i].y * T.gk[i]; p[2] = T.v[i].z * T.gk[i]; p[3] = T.v[i].w * T.gk[i]; }
    LDS_WAIT(); asm volatile("" ::: "memory");
    const int c = lane & 7;
    const int rbase = (mode == 0) ? n0 : ((n0 >> 7) * 256 + (n0 & 127) + (mode == 2 ? 128 : 0));
#pragma unroll
    for (int j = 0; j < 4; ++j) { const int n = (lane >> 3) + 8 * j; const LAS float* s = scr + (8 * c) * 33 + n;
        u32x4 o; o.x = pkbf(s[0 * 33], s[1 * 33]); o.y = pkbf(s[2 * 33], s[3 * 33]); o.z = pkbf(s[4 * 33], s[5 * 33]); o.w = pkbf(s[6 * 33], s[7 * 33]);
        *(u32x4*)(WT + (size_t)(rbase + n) * K + k0 + 8 * c) = o;
        if (WTF) *(u32x4*)(WTF + frag_off(rbase + n, k0 + 8 * c, K)) = o; }
    LDS_WAIT(); asm volatile("" ::: "memory");
}
struct KArgs { const float* in[28]; float* out; unsigned char* ws; };
struct KA2 { float* out; unsigned char* ws; };
__device__ __forceinline__ const float* uniform_fptr(unsigned long long v) { const unsigned lo = __builtin_amdgcn_readfirstlane((unsigned)v), hi = __builtin_amdgcn_readfirstlane((unsigned)(v >> 32)); return (const float*)(((unsigned long long)hi << 32) | lo); }
#define INP(i) uniform_fptr(((const unsigned long long*)(A.ws + WS_PTRS))[i])

constexpr int CI_G = (DM / 64) * (FF / 32), CI_D = (FF / 64) * (DM / 32), CI_Q = (DM / 64) * (3 * DM / 32), CI_O = (DM / 64) * (DM / 32), CI_L = 4 * CI_G + 2 * CI_D + CI_Q + CI_O;
__device__ __forceinline__ const float* inp_of(const KArgs& A, int i) { return A.in[i]; }
__device__ __forceinline__ const float* inp_of(const KA2& A, int i) { return uniform_fptr(((const unsigned long long*)(A.ws + WS_PTRS))[i]); }
struct CItem { const float* W; const float* gain; bf16_t* WT; bf16_t* WTF; int K, N, mode, r; };
template <class AT>
__device__ __forceinline__ CItem citem_of(const AT& A, int L, int r) {
    const int kind = L % 3, slot = L / 3; unsigned char* wl = A.ws + WS_W + (size_t)(L % WSLOTS) * WL_SIZE; CItem c;
    if (r < CI_G) { c = CItem{inp_of(A, 10) + (size_t)L * DM * FF, inp_of(A, 9) + (size_t)L * DM, (bf16_t*)(wl + WL_GU1), nullptr, DM, FF, 1, r}; return c; } r -= CI_G;
    if (r < CI_G) { c = CItem{inp_of(A, 11) + (size_t)L * DM * FF, inp_of(A, 9) + (size_t)L * DM, (bf16_t*)(wl + WL_GU1), nullptr, DM, FF, 2, r}; return c; } r -= CI_G;
    if (r < CI_D) { c = CItem{inp_of(A, 12) + (size_t)L * FF * DM, nullptr, (bf16_t*)(wl + WL_DN1), (bf16_t*)(wl + WL_DN1F), FF, DM, 0, r}; return c; } r -= CI_D;
    if (r < CI_G) { c = CItem{inp_of(A, 15) + (size_t)L * DM * FF, inp_of(A, 14) + (size_t)L * DM, (bf16_t*)(wl + WL_GU2), nullptr, DM, FF, 1, r}; return c; } r -= CI_G;
    if (r < CI_G) { c = CItem{inp_of(A, 16) + (size_t)L * DM * FF, inp_of(A, 14) + (size_t)L * DM, (bf16_t*)(wl + WL_GU2), nullptr, DM, FF, 2, r}; return c; } r -= CI_G;
    if (r < CI_D) { c = CItem{inp_of(A, 17) + (size_t)L * FF * DM, nullptr, (bf16_t*)(wl + WL_DN2), (bf16_t*)(wl + WL_DN2F), FF, DM, 0, r}; return c; } r -= CI_D;
    const float* wq = (kind == 0) ? inp_of(A, 18) : (kind == 1) ? inp_of(A, 21) : inp_of(A, 25);
    const float* wo = (kind == 0) ? inp_of(A, 19) : (kind == 1) ? inp_of(A, 22) : inp_of(A, 26);
    if (r < CI_Q) { c = CItem{wq + (size_t)slot * DM * 3 * DM, inp_of(A, 13) + (size_t)L * DM, (bf16_t*)(wl + WL_QKV), (bf16_t*)(wl + WL_QKVF), DM, 3 * DM, 0, r}; return c; } r -= CI_Q;
    c = CItem{wo + (size_t)slot * DM * DM, nullptr, (bf16_t*)(wl + WL_WO), (bf16_t*)(wl + WL_WOF), DM, DM, 0, r}; return c;
}
constexpr int CR_D1 = 2 * CI_G, CR_G2 = 2 * CI_G + CI_D, CR_D2 = 4 * CI_G + CI_D, CR_Q = 4 * CI_G + 2 * CI_D, CR_O = CR_Q + CI_Q, CV_NA = CI_D + CI_Q + CI_O, CV_G1A = CI_L / 2 - CV_NA, CV_G1B = 2 * CI_G - CV_G1A;
static_assert(CV_G1A > 0 && CV_G1B > 0, "conversion schedule");
__device__ __forceinline__ int conv_list_len(int kind, int L) { return kind == 0 ? 4 * CI_G : kind == 1 ? CV_NA + (L + 1 < DEPTH ? CV_G1A : 0) : CI_D + (L + 1 < DEPTH ? CV_G1B + 2 * CI_G : 0); }
template <class AT>
__device__ __forceinline__ CItem citem_v(const AT& A, int kind, int L, int v) {
    if (kind == 0) return (v < 2 * CI_G) ? citem_of(A, L, v) : citem_of(A, L, CR_G2 + (v - 2 * CI_G));
    if (kind == 1) {
        if (v < CI_D) return citem_of(A, L, CR_D1 + v);
        if (v < CI_D + CI_Q) return citem_of(A, L, CR_Q + (v - CI_D));
        if (v < CV_NA) return citem_of(A, L, CR_O + (v - CI_D - CI_Q));
        return citem_of(A, L + 1, v - CV_NA); }
    if (v < CI_D) return citem_of(A, L, CR_D2 + v);
    if (v < CI_D + CV_G1B) return citem_of(A, L + 1, CV_G1A + (v - CI_D));
    return citem_of(A, L + 1, CR_G2 + (v - CI_D - CV_G1B));
}
template <class AT>
__device__ __forceinline__ void convert_items(const AT& A, int kind, int L, int first, int hi, int stride, LAS float* scr, int lane) {
    if (first >= hi) return;
    TItem Ta; CItem ca = citem_v(A, kind, L, first); titem_load(Ta, ca.W, ca.N, ca.r, lane, ca.gain);
#pragma unroll 1
    for (int it = first; it < hi; it += stride) {
        TItem Tb; CItem cb = ca; const bool more = it + stride < hi;
        if (more) { cb = citem_v(A, kind, L, it + stride); titem_load(Tb, cb.W, cb.N, cb.r, lane, cb.gain); }
        titem_finish(Ta, ca.K, ca.N, ca.WT, ca.WTF, ca.mode, scr, ca.r, lane);
        if (more) { Ta = Tb; ca = cb; }
    }
}
__device__ __forceinline__ void convert_tail(const KA2& A, LAS unsigned char* lds, int kind, int L, int c0, int nc, const int wv) {
    PHASE_IDS();
    LAS float* scr = (LAS float*)(lds + wave * 16384);
    convert_items(A, kind, L, (bx_ - c0) * NWAVES + wave, conv_list_len(kind, L), nc * NWAVES, scr, lane);
}
__device__ __forceinline__ void prologue_phase(const KArgs& A, LAS unsigned char* lds, const int wv) {
    PHASE_IDS();
    LAS float* scr = (LAS float*)(lds + wave * 16384);
    if (tid_ == 0) { const float** tab = (const float**)(A.ws + WS_PTRS);
#pragma unroll
        for (int i = 0; i < 28; ++i) tab[i] = A.in[i]; }
    convert_items(A, 0, 0, gw, conv_list_len(0, 0), NGW, scr, lane);
    bf16_t* XB = (bf16_t*)(A.ws + WS_HB); float* SS = (float*)(A.ws + WS_SS); bf16_t* XBF = (bf16_t*)(A.ws + WS_XBF);
    for (int m0 = 2 * gw; m0 < M; m0 += 2 * NGW) {
        f32x4 v[2][4];
#pragma unroll
        for (int q = 0; q < 2; ++q) { const int m = m0 + q; const float* src = (m < MP) ? A.in[0] + (size_t)m * DM : A.in[1] + (size_t)(m - MP) * DM;
#pragma unroll
            for (int j = 0; j < 4; ++j) v[q][j] = ((const f32x4*)src)[lane + 64 * j]; }
#pragma unroll
        for (int q = 0; q < 2; ++q) { const int m = m0 + q; u32x2* o8 = (u32x2*)(XB + (size_t)m * DM) + lane; float s = 0.f;
#pragma unroll
            for (int j = 0; j < 4; ++j) { u32x2 w; w.x = pkbf(v[q][j].x, v[q][j].y); w.y = pkbf(v[q][j].z, v[q][j].w); o8[64 * j] = w;
                if (m >= MP) *(u32x2*)(XBF + frag_off(m - MP, 4 * (lane + 64 * j), DM)) = w;
                s += (pg8::bflo(w.x) * pg8::bflo(w.x) + pg8::bfhi(w.x) * pg8::bfhi(w.x)) + (pg8::bflo(w.y) * pg8::bflo(w.y) + pg8::bfhi(w.y) * pg8::bfhi(w.y)); }
            s = wave_sum(s);
            if (lane < 16) SS[(size_t)m * 16 + lane] = (lane == 0) ? s : 0.f; }
    }
    { bf16_t* wfb = (bf16_t*)(A.ws + WS_WFB); const float* wf = A.in[23]; const float* gm = A.in[13] + DM;
      for (int i = gw * 64 + lane; i < NH * DM; i += NGW * 64) { const int hh = i / DM, kk = i % DM; wfb[i] = (bf16_t)(pkbf(wf[(size_t)kk * NH + hh] * gm[kk], 0.f) & 0xffffu); } }
    float* tbl = (float*)(A.ws + WS_TBL);
    for (int i = gw * 64 + lane; i < 2 * 16 * NREL; i += NGW * 64) { const int slot = i / (16 * NREL), rem = i % (16 * NREL), h = rem / NREL, idx = rem % NREL;
        tbl[(slot * 16 + h) * TBLP + idx] = A.in[20][((size_t)slot * NREL + idx) * 16 + h] * LOG2E; }
}

__device__ __forceinline__ void fgate_step(const KA2& A, const float* bfv, const int wv) {
    PHASE_IDS();
    const bf16_t* XB = (const bf16_t*)(A.ws + WS_HB); const bf16_t* WFB = (const bf16_t*)(A.ws + WS_WFB); const float* SS = (const float*)(A.ws + WS_SS);
    const float bias = bfv[lane & 15];
    for (int rb = gw; rb < M / 16; rb += NGW) {
        const bf16_t* ap = XB + (size_t)(rb * 16 + (lane & 15)) * DM + 8 * (lane >> 4); const bf16_t* bp = WFB + (size_t)(lane & 15) * DM + 8 * (lane >> 4);
        f32x4 acc = {0.f, 0.f, 0.f, 0.f};
#pragma unroll
        for (int k0 = 0; k0 < DM / 32; k0 += 8) { bf16x8 a[8], b[8];
#pragma unroll
            for (int kk = 0; kk < 8; ++kk) { a[kk] = *(const bf16x8*)(ap + (k0 + kk) * 32); b[kk] = *(const bf16x8*)(bp + (k0 + kk) * 32); }
#pragma unroll
            for (int kk = 0; kk < 8; ++kk) acc = __builtin_amdgcn_mfma_f32_16x16x32_bf16(a[kk], b[kk], acc, 0, 0, 0); }
#pragma unroll
        for (int e = 0; e < 4; ++e) { const int m = rb * 16 + 4 * (lane >> 4) + e; const float z = acc[e] * pg8::row_scale(SS, m) + bias;
            const float lf = fminf(z, 0.f) - 0.6931471805599453f * __builtin_amdgcn_logf(1.0f + __builtin_amdgcn_exp2f(-1.4426950408889634f * fabsf(z)));
            float* dst = (m < MP) ? A.out + O_BFP + (size_t)m * NH : A.out + O_BFS + (size_t)(m - MP) * NH; dst[lane & 15] = lf; }
    }
}
template <int K, int KSPLIT, int CW, int KB, class Epi>
__device__ __forceinline__ void small_gemm(LAS unsigned char* lds, const bf16_t* Af, const bf16_t* Bf, int N, const Epi& E, const int wv) {
    PHASE_IDS();
    constexpr int NCH = 8 / KSPLIT, TN = NCH * CW, KW = K / KSPLIT, NKS = KW / 32, NB = CW / 16, NE = TN / 64;
    static_assert(KW % 32 == 0 && CW % 16 == 0 && TN % 64 == 0 && 8 * 32 * CW * 4 <= RING_BYTES, "small_gemm geometry");
    const int ntn = N / TN, ntiles = (MS / 32) * ntn;
    const int kq = wave % KSPLIT, ch = wave / KSPLIT;
#pragma unroll 1
    for (int tile = bx_; tile < ntiles; tile += G_) {
        int tm = tile / ntn, tn = tile % ntn;
        if (G_ == 256 && ntiles == 256 && ntn == 16) {
            const int x = tile & 7, q = tile >> 3; tm = 8 * (x & 1) + (q & 7); tn = 4 * (x >> 1) + (q >> 3); }
        const int row = tid_ >> 4, c4 = (tid_ & 15) * 4;
        typename Epi::Pre pre[NE];
#pragma unroll
        for (int q = 0; q < NE; ++q) pre[q] = E.pre(tm * 32 + row, tn * TN + c4 + 64 * q);
        const bf16_t* ap = Af + ((size_t)(tm * 2) * (K / 32) + kq * NKS) * 512 + lane * 8;
        const bf16_t* bp = Bf + ((size_t)((tn * TN + ch * CW) / 16) * (K / 32) + kq * NKS) * 512 + lane * 8;
        f32x4 acc[2][NB];
#pragma unroll
        for (int i = 0; i < 2; ++i)
#pragma unroll
            for (int j = 0; j < NB; ++j) acc[i][j] = (f32x4){0.f, 0.f, 0.f, 0.f};
#pragma unroll
        for (int k0 = 0; k0 < NKS; k0 += KB) {
            bf16x8 a[KB][2], b[KB][NB];
#pragma unroll
            for (int kk = 0; kk < KB; ++kk) if (k0 + kk < NKS) {
#pragma unroll
                for (int i = 0; i < 2; ++i) a[kk][i] = *(const bf16x8*)(ap + (size_t)(i * (K / 32) + k0 + kk) * 512);
#pragma unroll
                for (int j = 0; j < NB; ++j) b[kk][j] = *(const bf16x8*)(bp + (size_t)(j * (K / 32) + k0 + kk) * 512); }
#pragma unroll
            for (int kk = 0; kk < KB; ++kk) if (k0 + kk < NKS) {
#pragma unroll
                for (int i = 0; i < 2; ++i)
#pragma unroll
                    for (int j = 0; j < NB; ++j) acc[i][j] = __builtin_amdgcn_mfma_f32_16x16x32_bf16(a[kk][i], b[kk][j], acc[i][j], 0, 0, 0); }
        }
        LAS float* part = (LAS float*)(lds + wave * (32 * CW * 4));
#pragma unroll
        for (int i = 0; i < 2; ++i)
#pragma unroll
            for (int j = 0; j < NB; ++j)
#pragma unroll
                for (int e = 0; e < 4; ++e) part[(16 * i + 4 * (lane >> 4) + e) * CW + 16 * j + (lane & 15)] = acc[i][j][e];
        __syncthreads();
#pragma unroll
        for (int q = 0; q < NE; ++q) { const int col = c4 + 64 * q, cch = col / CW, cin = col % CW;
            const LAS unsigned char* pb = lds + (size_t)(cch * KSPLIT) * (32 * CW * 4) + (row * CW + cin) * 4;
            f32x4 sum = *(const LAS f32x4*)pb;
#pragma unroll
            for (int w = 1; w < KSPLIT; ++w) sum += *(const LAS f32x4*)(pb + w * (32 * CW * 4));
            E.fin(tm * 32 + row, tn * TN + col, sum, pre[q]); }
        __syncthreads();
    }
}
struct SEpiResid {
    typedef u32x2 Pre;
    bf16_t* xb; float* SS; float c; bf16_t* xbf;
    __device__ __forceinline__ Pre pre(int row, int col) const { return *(const u32x2*)(xb + (size_t)row * DM + col); }
    __device__ __forceinline__ void fin(int row, int col, f32x4 v, const Pre& in) const {
        const size_t off = (size_t)row * DM + col;
        u32x2 w; w.x = pkbf(pg8::bflo(in.x) + v.x * c, pg8::bfhi(in.x) + v.y * c); w.y = pkbf(pg8::bflo(in.y) + v.z * c, pg8::bfhi(in.y) + v.w * c); *(u32x2*)(xb + off) = w; *(u32x2*)(xbf + frag_off(row, col, DM)) = w;
        float ss = (pg8::bflo(w.x) * pg8::bflo(w.x) + pg8::bfhi(w.x) * pg8::bfhi(w.x)) + (pg8::bflo(w.y) * pg8::bflo(w.y) + pg8::bfhi(w.y) * pg8::bfhi(w.y));
        ss = pg8::sum_row16(ss);
        if ((col & 63) == 0) SS[(size_t)row * 16 + (col >> 6)] = ss;
    }
};
struct SEpiQKV {
    typedef f32x4 Pre;
    bf16_t* qkv; size_t tstride; float qscale; float* oks; float* ovs; const float* SS;
    __device__ __forceinline__ Pre pre(int row, int col) const { return *(const f32x4*)(SS + (size_t)row * 16 + (col & 12)); }
    __device__ __forceinline__ void fin(int row, int col, f32x4 v, const Pre& p) const {
        float s = (p.x + p.y) + (p.z + p.w); s = pg8::sum_quad(s);
        const float rs = __builtin_amdgcn_rsqf(s * (1.0f / 1024.0f) + 1e-6f); const int t = col >> 10, c = col & 1023; const float sc = (t == 0) ? qscale * rs : rs;
        u32x2 w; w.x = pkbf(v.x * sc, v.y * sc); w.y = pkbf(v.z * sc, v.w * sc); *(u32x2*)(qkv + (size_t)t * tstride + (size_t)row * DM + c) = w;
        if (t >= 1) { float* o = (t == 1) ? oks : ovs; *(f32x4*)(o + (size_t)row * DM + c) = v * rs; }
    }
};
__device__ __forceinline__ void final_norm_phase(const KA2& A, const int wv) {
    PHASE_IDS();
    const bf16_t* XB = (const bf16_t*)(A.ws + WS_HB); const float* SS = (const float*)(A.ws + WS_SS); const float* gain = INP(27);
    f32x4 g[4];
#pragma unroll
    for (int j = 0; j < 4; ++j) g[j] = ((const f32x4*)gain)[lane + 64 * j];
    for (int m0 = 4 * gw; m0 < M; m0 += 4 * NGW) {
        const float part = SS[(size_t)(m0 + (lane >> 4)) * 16 + (lane & 15)];
        u32x2 w[4][4];
#pragma unroll
        for (int q = 0; q < 4; ++q)
#pragma unroll
            for (int j = 0; j < 4; ++j) w[q][j] = ((const u32x2*)(XB + (size_t)(m0 + q) * DM))[lane + 64 * j];
        const float tot = pg8::sum_row16(part); const float rl = __builtin_amdgcn_rsqf(tot * (1.0f / DM) + RMS_EPS);
#pragma unroll
        for (int q = 0; q < 4; ++q) { const float r = __builtin_bit_cast(float, __builtin_amdgcn_readlane(__builtin_bit_cast(int, rl), 16 * q));
            f32x4* o = (f32x4*)(A.out + O_YP + (size_t)(m0 + q) * DM) + lane;
#pragma unroll
            for (int j = 0; j < 4; ++j) { const f32x4 v = {pg8::bflo(w[q][j].x), pg8::bfhi(w[q][j].x), pg8::bflo(w[q][j].y), pg8::bfhi(w[q][j].y)}; o[64 * j] = v * r * g[j]; } }
    }
}
__device__ __forceinline__ float wave_incl_scan(float v, int lane) {
#pragma unroll
    for (int o = 1; o < 64; o <<= 1) { const float t = __builtin_bit_cast(float, __builtin_amdgcn_ds_bpermute(((lane - o) & 63) << 2, __builtin_bit_cast(int, v))); if (lane >= o) v += t; }
    return v;
}
__device__ __forceinline__ void scan_phase(const KA2& A, const int wv) {
    PHASE_IDS();
    float* cump = (float*)(A.ws + WS_CUMP); float* cums = (float*)(A.ws + WS_CUMS);
    for (int task = gw; task < 128 + 512; task += NGW) {
        if (task < 128) { const int b = task >> 4, h = task & 15; const float* f = A.out + O_BFP + ((size_t)b * SEQ) * NH + h;
            float loc[32]; float run = 0.f;
#pragma unroll
            for (int i = 0; i < 32; ++i) { run += f[(size_t)(32 * lane + i) * NH]; loc[i] = run; }
            const float incl = wave_incl_scan(run, lane); const float off = incl - run;
            float* dst = cump + (size_t)task * SEQ + 32 * lane;
#pragma unroll
            for (int i = 0; i < 32; ++i) dst[i] = (loc[i] + off) * LOG2E;
        } else { const int su = task - 128, b = su >> 4, h = su & 15; const float* f = INP(6) + ((size_t)b * PAST) * NH + h;
            float loc[16]; float run = 0.f;
#pragma unroll
            for (int i = 0; i < 16; ++i) { run += f[(size_t)(16 * lane + i) * NH]; loc[i] = run; }
            const float incl = wave_incl_scan(run, lane); const float off = incl - run;
            float* dst = cums + (size_t)su * 1088;
#pragma unroll
            for (int i = 0; i < 16; ++i) dst[16 * lane + i] = (loc[i] + off) * LOG2E;
            const float total = __builtin_bit_cast(float, __builtin_amdgcn_readlane(__builtin_bit_cast(int, incl), 63));
            const float fn = (lane < 16) ? A.out[O_BFS + (size_t)(b * 16 + lane) * NH + h] : 0.f;
            const float sc = wave_incl_scan(fn, lane);
            if (lane < 16) dst[1024 + lane] = (total + sc) * LOG2E;
        }
    }
}
__device__ __forceinline__ s16x4 vtr(const LAS unsigned char* p) { return __builtin_bit_cast(s16x4, __builtin_amdgcn_ds_read_tr16_b64_v4i16((LAS v4i16_t*)p)); }
struct AttnP {
    const bf16_t* Q; const bf16_t* K; const bf16_t* V; bf16_t* O;
    const float* ck; const float* cv;
    const float* tbl;
    const float* cump; const float* cums;
    unsigned* qctr;
    float* okp; float* ovp;
};
typedef float f32x2 __attribute__((ext_vector_type(2)));
struct AttState { f32x16 o0, o1; float mrun, lsum, R; };
constexpr int AL_KT = 0, AL_VT = 3 * KTILE, AL_AUXP = 3 * KTILE + 2 * VTILE, AL_VS = 0, AL_AUXS = 8 * VTILE, AL_CST = AL_AUXS + 4352, AL_KS1 = AL_CST + 1024, AL_KS2 = RING_BYTES + 1024, KHALF = 32 * KROWB;
static_assert(AL_AUXP + 8192 <= RING_BYTES && AL_KS1 + 5 * KHALF <= RING_BYTES && AL_KS2 + 3 * KHALF <= LDS_BYTES && AL_KS2 >= MISC_OFF + 512 && VTILE >= 4096, "attention LDS map");

__device__ __forceinline__ float max3f(float a, float b, float c) { float r; asm("v_max3_f32 %0, %1, %2, %3" : "=v"(r) : "v"(a), "v"(b), "v"(c)); return r; }
__device__ __forceinline__ float max2f(float a, float b) { float r; asm("v_max_f32_e32 %0, %1, %2" : "=v"(r) : "v"(a), "v"(b)); return r; }
template <int TYPE, bool MASK, bool KMASK, bool FAR>
__device__ __forceinline__ void attn_step(AttState& S, const bf16x8 (&kf)[2][4], const bf16x8 (&qr)[4], const LAS unsigned char* vrd, int kbase, int qpos, int qlim, int klim, int hi, const LAS float* aux, float cfar) {
    f32x16 p0, p1;
    if (TYPE == 0 && !FAR) {
        const LAS float* tb = aux + (384 - qpos + kbase);
#pragma unroll
        for (int r = 0; r < 16; ++r) { const int o = (r & 3) + 8 * (r >> 2); p0[r] = tb[o]; p1[r] = tb[o + 32]; }
    } else if (TYPE == 1) {
#pragma unroll
        for (int gi = 0; gi < 4; ++gi) { const f32x4 c0 = *(const LAS f32x4*)(aux + kbase + 8 * gi), c1 = *(const LAS f32x4*)(aux + kbase + 8 * gi + 32);
#pragma unroll
            for (int e = 0; e < 4; ++e) { p0[4 * gi + e] = c0[e]; p1[4 * gi + e] = c1[e]; } }
    } else if (TYPE == 0 && FAR) {
#pragma unroll
        for (int r = 0; r < 16; ++r) { p0[r] = cfar; p1[r] = cfar; }
    } else { p0 = f32x16{}; p1 = f32x16{}; }
#pragma unroll
    for (int d0 = 0; d0 < 4; ++d0) { p0 = __builtin_amdgcn_mfma_f32_32x32x16_bf16(kf[0][d0], qr[d0], p0, 0, 0, 0); p1 = __builtin_amdgcn_mfma_f32_32x32x16_bf16(kf[1][d0], qr[d0], p1, 0, 0, 0); }
    if (TYPE == 2) {
        float k0[16], k1[16];
#pragma unroll
        for (int r = 0; r < 16; ++r) { const int kp = kbase + (r & 3) + 8 * (r >> 2);
            { const float e = __builtin_amdgcn_exp2f(fminf(p0[r], 100.f)), k = __builtin_amdgcn_rcpf(1.f + e); if (MASK) { const bool v = kp < qlim; k0[r] = v ? k : 1.f; p0[r] = v ? e * k : 0.f; } else { k0[r] = k; p0[r] = e * k; } }
            { const float e = __builtin_amdgcn_exp2f(fminf(p1[r], 100.f)), k = __builtin_amdgcn_rcpf(1.f + e); if (MASK) { const bool v = kp + 32 < qlim; k1[r] = v ? k : 1.f; p1[r] = v ? e * k : 0.f; } else { k1[r] = k; p1[r] = e * k; } } }
        float all[16];
#pragma unroll
        for (int gi = 0; gi < 4; ++gi) {
            const float ga = (k0[4 * gi] * k0[4 * gi + 1]) * (k0[4 * gi + 2] * k0[4 * gi + 3]), gb = (k1[4 * gi] * k1[4 * gi + 1]) * (k1[4 * gi + 2] * k1[4 * gi + 3]);
            auto ra = __builtin_amdgcn_permlane32_swap(__float_as_uint(ga), __float_as_uint(ga), false, false); all[2 * gi] = __uint_as_float(ra[0]); all[2 * gi + 1] = __uint_as_float(ra[1]);
            auto rb = __builtin_amdgcn_permlane32_swap(__float_as_uint(gb), __float_as_uint(gb), false, false); all[8 + 2 * gi] = __uint_as_float(rb[0]); all[8 + 2 * gi + 1] = __uint_as_float(rb[1]); }
        float run = S.R;
#pragma unroll
        for (int gi = 3; gi >= 0; --gi) {
            const float above_odd = run, above_even = run * all[8 + 2 * gi + 1]; float s = hi ? above_odd : above_even; run = above_even * all[8 + 2 * gi];
            p1[4 * gi + 3] *= s; s *= k1[4 * gi + 3]; p1[4 * gi + 2] *= s; s *= k1[4 * gi + 2]; p1[4 * gi + 1] *= s; s *= k1[4 * gi + 1]; p1[4 * gi] *= s; }
#pragma unroll
        for (int gi = 3; gi >= 0; --gi) {
            const float above_odd = run, above_even = run * all[2 * gi + 1]; float s = hi ? above_odd : above_even; run = above_even * all[2 * gi];
            p0[4 * gi + 3] *= s; s *= k0[4 * gi + 3]; p0[4 * gi + 2] *= s; s *= k0[4 * gi + 2]; p0[4 * gi + 1] *= s; s *= k0[4 * gi + 1]; p0[4 * gi] *= s; }
        S.R = run;
    } else {
        if (TYPE == 0 && KMASK) {
#pragma unroll
            for (int r = 0; r < 16; ++r) { const int kp = kbase + (r & 3) + 8 * (r >> 2); p0[r] = (kp < klim) ? p0[r] : -1e30f; p1[r] = (kp + 32 < klim) ? p1[r] : -1e30f; }
        }
        if (TYPE == 1 && MASK) {
#pragma unroll
            for (int r = 0; r < 16; ++r) { const int kp = kbase + (r & 3) + 8 * (r >> 2); p0[r] = (kp <= qlim) ? p0[r] : -1e30f; p1[r] = (kp + 32 <= qlim) ? p1[r] : -1e30f; }
        }
        asm volatile("s_nop 15\n\ts_nop 7" : "+v"(p0), "+v"(p1));
        float tm = max3f(p0[0], p1[0], p0[1]);
#pragma unroll
        for (int r = 1; r < 15; ++r) tm = max3f(tm, p1[r], p0[r + 1]);
        tm = max2f(tm, p1[15]);
        { auto rr = __builtin_amdgcn_permlane32_swap(__float_as_uint(tm), __float_as_uint(tm), false, false); tm = max2f(__uint_as_float(rr[0]), __uint_as_float(rr[1])); }
        if (__any(tm > S.mrun + 8.0f)) {
            const float mt = max2f(S.mrun, tm), alpha = __builtin_amdgcn_exp2f(S.mrun - mt); S.mrun = mt; S.lsum *= alpha;
#pragma unroll
            for (int r = 0; r < 16; ++r) { S.o0[r] *= alpha; S.o1[r] *= alpha; }
        }
        const float mref = S.mrun; float ps = 0.f; const f32x2 m2 = {mref, mref};
#pragma unroll
        for (int r = 0; r < 16; r += 2) { const f32x2 a = (f32x2){p0[r], p0[r + 1]} - m2, bq = (f32x2){p1[r], p1[r + 1]} - m2;
            p0[r] = __builtin_amdgcn_exp2f(a.x); p0[r + 1] = __builtin_amdgcn_exp2f(a.y); p1[r] = __builtin_amdgcn_exp2f(bq.x); p1[r + 1] = __builtin_amdgcn_exp2f(bq.y); }
#pragma unroll
        for (int r = 0; r < 16; ++r) ps += p0[r] + p1[r];
        S.lsum += ps;
    }
    bf16x8 pa[4];
#pragma unroll
    for (int s = 0; s < 2; ++s) {
        u32x4 w0; w0.x = pkbf(p0[8 * s], p0[8 * s + 1]); w0.y = pkbf(p0[8 * s + 2], p0[8 * s + 3]); w0.z = pkbf(p0[8 * s + 4], p0[8 * s + 5]); w0.w = pkbf(p0[8 * s + 6], p0[8 * s + 7]); pa[s] = __builtin_bit_cast(bf16x8, w0);
        u32x4 w1; w1.x = pkbf(p1[8 * s], p1[8 * s + 1]); w1.y = pkbf(p1[8 * s + 2], p1[8 * s + 3]); w1.z = pkbf(p1[8 * s + 4], p1[8 * s + 5]); w1.w = pkbf(p1[8 * s + 6], p1[8 * s + 7]); pa[2 + s] = __builtin_bit_cast(bf16x8, w1); }
#pragma unroll
    for (int ks = 0; ks < 4; ++ks) {
        const s16x4 a0 = vtr(vrd + (16 * ks) * VROWB), a1 = vtr(vrd + (16 * ks + 8) * VROWB), c0 = vtr(vrd + (16 * ks) * VROWB + 64), c1 = vtr(vrd + (16 * ks + 8) * VROWB + 64);
        const bf16x8 v0 = {a0[0], a0[1], a0[2], a0[3], a1[0], a1[1], a1[2], a1[3]}, v1 = {c0[0], c0[1], c0[2], c0[3], c1[0], c1[1], c1[2], c1[3]};
        S.o0 = __builtin_amdgcn_mfma_f32_32x32x16_bf16(v0, pa[ks], S.o0, 0, 0, 0);
        S.o1 = __builtin_amdgcn_mfma_f32_32x32x16_bf16(v1, pa[ks], S.o1, 0, 0, 0); }
}
__device__ __forceinline__ void fill_bias_table(LAS float* aux, const float* tb, int tid) {
    for (int i = tid; i < 640; i += NWAVES * 64) { int d = 384 - i; d = d < -256 ? -256 : (d > 256 ? 256 : d); aux[i] = tb[d + 256]; }
}

template <int TYPE>
__device__ __forceinline__ void kv_out(const AttnP& P, int b, int h, int U, int jt, int srow, int sch, const u32x4 kreg, const u32x4 vreg) {
    if (jt < 4 * U) return;
    if (TYPE == 0 && jt < (SEQ - AKEEP) / 64) return;
    const size_t row = (TYPE == 0) ? (size_t)b * AKEEP + (64 * jt - (SEQ - AKEEP)) + srow : (size_t)b * SEQ + 64 * jt + srow;
    __attribute__((address_space(1))) f32x4* ko = (__attribute__((address_space(1))) f32x4*)(P.okp + row * DM + h * HD + 8 * sch);
    __attribute__((address_space(1))) f32x4* vo = (__attribute__((address_space(1))) f32x4*)(P.ovp + row * DM + h * HD + 8 * sch);
    ko[0] = (f32x4){pg8::bflo(kreg.x), pg8::bfhi(kreg.x), pg8::bflo(kreg.y), pg8::bfhi(kreg.y)}; ko[1] = (f32x4){pg8::bflo(kreg.z), pg8::bfhi(kreg.z), pg8::bflo(kreg.w), pg8::bfhi(kreg.w)};
    vo[0] = (f32x4){pg8::bflo(vreg.x), pg8::bfhi(vreg.x), pg8::bflo(vreg.y), pg8::bfhi(vreg.y)}; vo[1] = (f32x4){pg8::bflo(vreg.z), pg8::bfhi(vreg.z), pg8::bflo(vreg.w), pg8::bfhi(vreg.w)};
}
template <int TYPE>
__device__ __forceinline__ void row_out(float* obase, int b, int h, int U, int jt, int srow, int sch, const u32x4 reg) {
    if (jt < 4 * U) return;
    if (TYPE == 0 && jt < (SEQ - AKEEP) / 64) return;
    const size_t row = (TYPE == 0) ? (size_t)b * AKEEP + (64 * jt - (SEQ - AKEEP)) + srow : (size_t)b * SEQ + 64 * jt + srow;
    __attribute__((address_space(1))) f32x4* o = (__attribute__((address_space(1))) f32x4*)(obase + row * DM + h * HD + 8 * sch);
    o[0] = (f32x4){pg8::bflo(reg.x), pg8::bfhi(reg.x), pg8::bflo(reg.y), pg8::bfhi(reg.y)}; o[1] = (f32x4){pg8::bflo(reg.z), pg8::bfhi(reg.z), pg8::bflo(reg.w), pg8::bfhi(reg.w)};
}
template <int TYPE>
__device__ __forceinline__ void attn_prompt_unit(const AttnP& P, int b, int h, int U, LAS unsigned char* lds, int wave, unsigned nxt, volatile LAS unsigned* slot) {
    const int lane = opaque_lane(), tid = wave * 64 + lane;
    const int r32 = lane & 31, hi = lane >> 5, li = lane & 15;
    const int qblk = 8 * U + wave, c = qblk >> 1, qpos = 32 * qblk + r32;
    const int jlast = 4 * U + 3, jfirst = (TYPE == 0) ? (4 * U > 8 ? 4 * U - 8 : 0) : 0, nt = jlast - jfirst + 1;
    LAS float* aux = (LAS float*)(lds + AL_AUXP);
    if (TYPE == 1) { const float* src = P.cump + (size_t)(b * NH + h) * SEQ; for (int i = tid; i < 256 * (U + 1); i += NWAVES * 64) aux[i] = -src[i]; }
    if (TYPE == 0) fill_bias_table(aux, P.tbl + h * TBLP, tid);
    const float cfar = (TYPE == 0) ? P.tbl[h * TBLP + 512] : 0.f;
    volatile LAS unsigned* dflag = (volatile LAS unsigned*)(lds + MISC_OFF + 256);
    bf16x8 qr[4];
    { const __attribute__((address_space(1))) unsigned char* qb = (const __attribute__((address_space(1))) unsigned char*)(P.Q + (size_t)b * SEQ * DM + h * HD); const unsigned qo = (unsigned)((qpos * DM + 8 * hi) * 2);
#pragma unroll
      for (int d0 = 0; d0 < 4; ++d0) qr[d0] = *(const __attribute__((address_space(1))) bf16x8*)(qb + qo + 32 * d0); }
    const int srow = tid >> 3, sch = tid & 7;
    typedef __attribute__((address_space(1))) const unsigned char gcb;
    gcb* kg = (gcb*)(P.K + (size_t)b * SEQ * DM + h * HD); gcb* vg = (gcb*)(P.V + (size_t)b * SEQ * DM + h * HD);
    const unsigned goff = (unsigned)((srow * DM + 8 * sch) * 2);
#define TILE_LD(base, jj) (*(__attribute__((address_space(1))) const u32x4*)((base) + (size_t)(jj) * (64 * DM * 2) + goff))
    const int soffk = srow * KROWB + 16 * sch, soffv = srow * VROWB + 16 * sch;
#define TIDX(tau) ((TYPE == 2) ? jlast - (tau) : jfirst + (tau))
    { const u32x4 kr0 = TILE_LD(kg, TIDX(0)), kr1 = TILE_LD(kg, TIDX(1)), vr0 = TILE_LD(vg, TIDX(0));
      *(LAS u32x4*)(lds + AL_KT + soffk) = kr0; *(LAS u32x4*)(lds + AL_KT + KTILE + soffk) = kr1; *(LAS u32x4*)(lds + AL_VT + soffv) = vr0;
      row_out<TYPE>(P.okp, b, h, U, TIDX(0), srow, sch, kr0); row_out<TYPE>(P.okp, b, h, U, TIDX(1), srow, sch, kr1); row_out<TYPE>(P.ovp, b, h, U, TIDX(0), srow, sch, vr0); }
    const int grp = wave >> 2, gt = tid & 255, grow = gt >> 3;
    const unsigned ggoff = (unsigned)((grow * DM + 8 * sch) * 2);
#define TILE_LD2(base, jj, half) (*(__attribute__((address_space(1))) const u32x4*)((base) + (size_t)(jj) * (64 * DM * 2) + ggoff + (half) * (32 * DM * 2)))
    const int gsk = grow * KROWB + 16 * sch, gsv = grow * VROWB + 16 * sch;
    u32x4 rk0 = {}, rk1 = {}, rv0 = {}, rv1 = {};
    if (grp == 1) { rk0 = TILE_LD2(kg, TIDX(2), 0); rk1 = TILE_LD2(kg, TIDX(2), 1); rv0 = TILE_LD2(vg, TIDX(1), 0); rv1 = TILE_LD2(vg, TIDX(1), 1); }
    if (tid == 0) slot[1] = nxt;
    __syncthreads();
    AttState S; S.o0 = f32x16{}; S.o1 = f32x16{}; S.mrun = -1e30f; S.lsum = 0.f; S.R = 1.f;
    const int vro = (4 * hi + (li >> 2)) * VROWB + (16 * ((lane >> 4) & 1) + 4 * (li & 3)) * 2, kro = r32 * KROWB + 16 * hi;
    bool done = false;
    bf16x8 kf[2][4];
#pragma unroll
    for (int sub = 0; sub < 2; ++sub)
#pragma unroll
        for (int d0 = 0; d0 < 4; ++d0) kf[sub][d0] = *(const LAS bf16x8*)(lds + AL_KT + kro + sub * 32 * KROWB + 32 * d0);
    int ksl = 0;
#pragma unroll 1
    for (int t = 0; t < nt; ++t) {
        const int j = TIDX(t), bufv = (t & 1) * VTILE;
        const bool mine = ((t ^ grp) & 1) == 0;
        if (mine) { if (t + 3 < nt) { rk0 = TILE_LD2(kg, TIDX(t + 3), 0); rk1 = TILE_LD2(kg, TIDX(t + 3), 1); }
                    if (t + 2 < nt) { rv0 = TILE_LD2(vg, TIDX(t + 2), 0); rv1 = TILE_LD2(vg, TIDX(t + 2), 1); } }
        const bool active = ((TYPE == 0) ? (j >= c - 8 && j <= c) : (j <= c)) && !done;
        if (active) {
            const LAS unsigned char* vrd = lds + AL_VT + bufv + vro; const int kbase = 64 * j + 4 * hi;
            if (TYPE == 0) { if (64 * c - (64 * j + 63) >= 256) attn_step<0, false, false, true>(S, kf, qr, vrd, kbase, qpos, 0, 0, hi, aux, cfar); else attn_step<0, false, false, false>(S, kf, qr, vrd, kbase, qpos, 0, 0, hi, aux, cfar); }
            else { if (j == c) attn_step<TYPE, true, false, false>(S, kf, qr, vrd, kbase, qpos, qpos, 0, hi, aux, 0.f); else attn_step<TYPE, false, false, false>(S, kf, qr, vrd, kbase, qpos, 0, 0, hi, aux, 0.f); }
            if (TYPE == 2) done = __all(S.R == 0.f);
        }
        const int ksn = (ksl == 2) ? 0 : ksl + 1, ksw = (ksn == 2) ? 0 : ksn + 1;
        if (t + 1 < nt) {
#pragma unroll
            for (int sub = 0; sub < 2; ++sub)
#pragma unroll
                for (int d0 = 0; d0 < 4; ++d0) kf[sub][d0] = *(const LAS bf16x8*)(lds + AL_KT + ksn * KTILE + kro + sub * 32 * KROWB + 32 * d0); }
        if (!mine) {
            if (t + 2 < nt) { *(LAS u32x4*)(lds + AL_KT + ksw * KTILE + gsk) = rk0; *(LAS u32x4*)(lds + AL_KT + ksw * KTILE + gsk + 32 * KROWB) = rk1;
                row_out<TYPE>(P.okp, b, h, U, TIDX(t + 2), grow, sch, rk0); row_out<TYPE>(P.okp, b, h, U, TIDX(t + 2), grow + 32, sch, rk1); }
            if (t + 1 < nt) { *(LAS u32x4*)(lds + AL_VT + (VTILE - bufv) + gsv) = rv0; *(LAS u32x4*)(lds + AL_VT + (VTILE - bufv) + gsv + 32 * VROWB) = rv1;
                row_out<TYPE>(P.ovp, b, h, U, TIDX(t + 1), grow, sch, rv0); row_out<TYPE>(P.ovp, b, h, U, TIDX(t + 1), grow + 32, sch, rv1); } }
        ksl = ksn;
        if (TYPE == 2 && lane == 0) dflag[wave] = done ? 1u : 0u;
        __syncthreads();
        if (TYPE == 2) { unsigned alld = 1u;
#pragma unroll
            for (int w = 0; w < NWAVES; ++w) alld &= dflag[w];
            if (alld && t >= 2) break; }
    }
#undef TIDX
    float inv = 1.f;
    if (TYPE != 2) { auto rr = __builtin_amdgcn_permlane32_swap(__float_as_uint(S.lsum), __float_as_uint(S.lsum), false, false); inv = 1.0f / (__uint_as_float(rr[0]) + __uint_as_float(rr[1])); }
#undef TILE_LD
#undef TILE_LD2
    { __attribute__((address_space(1))) unsigned char* ob = (__attribute__((address_space(1))) unsigned char*)(P.O + (size_t)b * SEQ * DM + h * HD);
      const int lane2 = opaque_lane(); const unsigned oo = (unsigned)(((32 * qblk + (lane2 & 31)) * DM) * 2 + ((lane2 >> 5) ? 16 : 0));
      u32x2 grp[8];
#pragma unroll
      for (int g = 0; g < 4; ++g) { grp[g].x = pkbf(S.o0[4 * g] * inv, S.o0[4 * g + 1] * inv); grp[g].y = pkbf(S.o0[4 * g + 2] * inv, S.o0[4 * g + 3] * inv);
        grp[4 + g].x = pkbf(S.o1[4 * g] * inv, S.o1[4 * g + 1] * inv); grp[4 + g].y = pkbf(S.o1[4 * g + 2] * inv, S.o1[4 * g + 3] * inv); }
#pragma unroll
      for (int k = 0; k < 8; k += 2) {
          auto rx = __builtin_amdgcn_permlane32_swap(grp[k].x, grp[k + 1].x, false, false); auto ry = __builtin_amdgcn_permlane32_swap(grp[k].y, grp[k + 1].y, false, false);
          const unsigned ax = rx[0], bx2 = rx[1], ay = ry[0], by2 = ry[1];
          u32x4 w; w.x = ax; w.y = ay; w.z = bx2; w.w = by2;
          *(__attribute__((address_space(1))) u32x4*)(ob + oo + 16 * k) = w; } }
}

template <int TYPE>
__device__ __forceinline__ void attn_sample_unit(const AttnP& P, int b, int h, LAS unsigned char* lds, int wave, unsigned nxt, volatile LAS unsigned* slot) {
    const int lane = opaque_lane(), tid = wave * 64 + lane;
    constexpr int NCACHE = (TYPE == 0) ? ACACHE : PAST, NTC = NCACHE / 64, TPW = NTC / 8;
    const int r32 = lane & 31, hi = lane >> 5, li = lane & 15, q16 = r32 & 15;
    const size_t qrow = (size_t)MP + b * DS + q16; const int qpos = NCACHE + q16;
    LAS float* aux = (LAS float*)(lds + AL_AUXS); LAS unsigned char* vl = lds + AL_VS + wave * VTILE; LAS unsigned char* kl = lds + (wave < 5 ? AL_KS1 + wave * KHALF : AL_KS2 + (wave - 5) * KHALF);
    if (TYPE == 1) { const float* src = P.cums + (size_t)(b * NH + h) * 1088; for (int i = tid; i < 1088; i += NWAVES * 64) aux[i] = -src[i]; }
    if (TYPE == 0) fill_bias_table(aux, P.tbl + h * TBLP, tid);
    const float cfar = (TYPE == 0) ? P.tbl[h * TBLP + 512] : 0.f;
    bf16x8 qr[4];
    { const bf16_t* qp = P.Q + qrow * DM + h * HD + 8 * hi;
#pragma unroll
      for (int d0 = 0; d0 < 4; ++d0) qr[d0] = *(const bf16x8*)(qp + 16 * d0); }
    if (tid == 0) slot[1] = nxt;
    __syncthreads();
    AttState S; S.o0 = f32x16{}; S.o1 = f32x16{}; S.mrun = -1e30f; S.lsum = 0.f; S.R = 1.f;
    const int vro = (4 * hi + (li >> 2)) * VROWB + (16 * ((lane >> 4) & 1) + 4 * (li & 3)) * 2;
    const int ntw = TPW + (wave == 7 ? 1 : 0);
#pragma unroll 1
    for (int t = 0; t < ntw; ++t) {
        const int j = (TYPE == 2) ? ((wave + 1) * TPW - 1 + (wave == 7 ? 1 : 0) - t) : (wave * TPW + t);
        bf16x8 kf[2][4];
        if (j == NTC) {
            typedef __attribute__((address_space(1))) const unsigned char gcb2;
            gcb2* kb2 = (gcb2*)(P.K + ((size_t)MP + b * DS) * DM + h * HD); gcb2* vb2 = (gcb2*)(P.V + ((size_t)MP + b * DS) * DM + h * HD);
#pragma unroll
            for (int sub = 0; sub < 2; ++sub) { const int kr = 32 * sub + r32; const unsigned ko = (unsigned)(((kr < DS - 1 ? kr : DS - 1) * DM + 8 * hi) * 2);
#pragma unroll
                for (int d0 = 0; d0 < 4; ++d0) kf[sub][d0] = *(__attribute__((address_space(1))) const bf16x8*)(kb2 + ko + 32 * d0); }
            u32x4 vv[8];
#pragma unroll
            for (int i = 0; i < 8; ++i) { const int row = 8 * i + (lane >> 3); vv[i] = *(__attribute__((address_space(1))) const u32x4*)(vb2 + (unsigned)(((row < DS - 1 ? row : DS - 1) * DM + 8 * (lane & 7)) * 2)); }
#pragma unroll
            for (int i = 0; i < 8; ++i) { const int row = 8 * i + (lane >> 3); *(LAS u32x4*)(vl + row * VROWB + 16 * (lane & 7)) = vv[i]; }
        } else {
            typedef __attribute__((address_space(1))) const unsigned char gcb;
            gcb* kb = (gcb*)(P.ck + (((size_t)b * NCACHE + 64 * j) * NH + h) * HD); gcb* vb = (gcb*)(P.cv + (((size_t)b * NCACHE + 64 * j) * NH + h) * HD);
            const unsigned voff = (unsigned)((lane >> 4) * (NH * HD * 4) + li * 16);
            f32x4 kk[16], vv[16];
#pragma unroll
            for (int i = 0; i < 16; ++i) { gcb* kbi = kb + i * 4 * (NH * HD * 4); kk[i] = *(__attribute__((address_space(1))) const f32x4*)(kbi + voff); }
#pragma unroll
            for (int i = 0; i < 16; ++i) { gcb* vbi = vb + i * 4 * (NH * HD * 4); vv[i] = *(__attribute__((address_space(1))) const f32x4*)(vbi + voff); }
#pragma unroll
            for (int sub = 0; sub < 2; ++sub) {
#pragma unroll
                for (int i = 0; i < 8; ++i) { const int row = 4 * i + (lane >> 4); u32x2 w; w.x = pkbf(kk[8 * sub + i].x, kk[8 * sub + i].y); w.y = pkbf(kk[8 * sub + i].z, kk[8 * sub + i].w); *(LAS u32x2*)(kl + row * KROWB + 8 * li) = w; }
#pragma unroll
                for (int d0 = 0; d0 < 4; ++d0) kf[sub][d0] = *(const LAS bf16x8*)(kl + r32 * KROWB + 16 * hi + 32 * d0);
            }
#pragma unroll
            for (int i = 0; i < 16; ++i) { const int row = 4 * i + (lane >> 4); u32x2 w; w.x = pkbf(vv[i].x, vv[i].y); w.y = pkbf(vv[i].z, vv[i].w); *(LAS u32x2*)(vl + row * VROWB + 8 * li) = w; }
        }
        { const int kbase = 64 * j + 4 * hi; const bool isnew = (j == NTC);
          if (TYPE == 0) { const bool far = (NCACHE - (64 * j + 63)) >= 256;
              if (isnew) attn_step<0, false, true, false>(S, kf, qr, vl + vro, kbase, qpos, 0, NCACHE + DS, hi, aux, cfar);
              else if (far) attn_step<0, false, false, true>(S, kf, qr, vl + vro, kbase, qpos, 0, 0, hi, aux, cfar);
              else attn_step<0, false, false, false>(S, kf, qr, vl + vro, kbase, qpos, 0, 0, hi, aux, cfar); }
          else { if (isnew) attn_step<TYPE, true, false, false>(S, kf, qr, vl + vro, kbase, qpos, qpos, 0, hi, aux, 0.f); else attn_step<TYPE, false, false, false>(S, kf, qr, vl + vro, kbase, qpos, 0, 0, hi, aux, 0.f); } }
    }
    LAS float* comb = (LAS float*)(lds + AL_VS + wave * VTILE); LAS float* cst = (LAS float*)(lds + AL_CST) + wave * 32;
    float ltot = 0.f;
    if (TYPE != 2) { auto rr = __builtin_amdgcn_permlane32_swap(__float_as_uint(S.lsum), __float_as_uint(S.lsum), false, false); ltot = __uint_as_float(rr[0]) + __uint_as_float(rr[1]); }
    if (r32 < 16) {
#pragma unroll
        for (int r = 0; r < 16; ++r) { const int d = (r & 3) + 8 * (r >> 2) + 4 * hi; comb[q16 * 64 + d] = S.o0[r]; comb[q16 * 64 + 32 + d] = S.o1[r]; }
        if (hi == 0) { cst[q16] = (TYPE == 2) ? S.R : S.mrun; cst[16 + q16] = ltot; }
    }
    __syncthreads();
    { const int tid2 = wave * 64 + opaque_lane(); const int q = tid2 >> 5, d2 = (tid2 & 31) * 2; const LAS float* cb = (const LAS float*)(lds + AL_VS); const LAS float* cs = (const LAS float*)(lds + AL_CST);
      float n0 = 0.f, n1 = 0.f;
      if (TYPE == 2) { float f = 1.f;
#pragma unroll
          for (int w = 7; w >= 0; --w) { n0 += f * cb[w * (VTILE / 4) + q * 64 + d2]; n1 += f * cb[w * (VTILE / 4) + q * 64 + d2 + 1]; f *= cs[w * 32 + q]; } }
      else { float mx = cs[q];
#pragma unroll
          for (int w = 1; w < 8; ++w) mx = fmaxf(mx, cs[w * 32 + q]);
          float den = 0.f;
#pragma unroll
          for (int w = 0; w < 8; ++w) { const float f = __builtin_amdgcn_exp2f(cs[w * 32 + q] - mx); den += f * cs[w * 32 + 16 + q]; n0 += f * cb[w * (VTILE / 4) + q * 64 + d2]; n1 += f * cb[w * (VTILE / 4) + q * 64 + d2 + 1]; }
          const float inv = 1.0f / den; n0 *= inv; n1 *= inv; }
      *(unsigned*)(P.O + (size_t)MP * DM + frag_off(b * DS + q, h * HD + d2, DM)) = pkbf(n0, n1); }
    __syncthreads();
}

template <int TYPE>
__device__ __forceinline__ void attn_phase(const AttnP& P, LAS unsigned char* lds, const int wv) {
    PHASE_IDS();
    volatile LAS unsigned* slot = (volatile LAS unsigned*)(lds + MISC_OFF) + 16;
    if (wave >= 4) __builtin_amdgcn_s_setprio(1);
    constexpr unsigned NU = 3 * DB * NH / 8, NS2 = 2 * DB * NH / 8;
    const int xq = bx_ & 7; unsigned* qc = P.qctr + 64 * xq;
    if (tid_ == 0) slot[1] = atomicAdd(qc, 1u);
    __syncthreads();
#pragma unroll 1
    for (;;) {
        const unsigned n = slot[1];
        if (n >= NU) break;
        unsigned nxt = 0u;
        if (tid_ == 0) nxt = atomicAdd(qc, 1u);
        __syncthreads();
        if (n < NS2 && (n & 1u)) { const int s = (int)(n >> 1); attn_sample_unit<TYPE>(P, s >> 1, (s & 1) * 8 + xq, lds, wave, nxt, slot); }
        else { const int p = (n < NS2) ? (int)(n >> 1) : (int)(n - NS2 / 2); const int U = 7 - (p >> 4), bhl = p & 15; attn_prompt_unit<TYPE>(P, bhl >> 1, (bhl & 1) * 8 + xq, U, lds, wave, nxt, slot); }
        __syncthreads();
    }
    __builtin_amdgcn_s_setprio(0);
}
__global__ void __launch_bounds__(NWAVES * 64, 2) fwd_kernel(KArgs A0) {
    extern __shared__ __attribute__((aligned(16))) unsigned char lds_raw[];
    LAS unsigned char* lds = (LAS unsigned char*)lds_raw;
    volatile LAS unsigned* MISC = (volatile LAS unsigned*)(lds + MISC_OFF);
    const int tid = threadIdx.x; const int G0 = gridDim.x, bx0 = blockIdx.x; const int wv = __builtin_amdgcn_readfirstlane(tid >> 6);
    for (int u = tid; u < (LDS_BYTES - RING_BYTES) / 4; u += NWAVES * 64) ((LAS unsigned*)(lds + RING_BYTES))[u] = 0u;
    __syncthreads();
    unsigned* ctl = (unsigned*)(A0.ws + WS_CTL);
    XcdBarrier bar = xcd_barrier_post(ctl + CW_BAR, MISC + 8);
    unsigned char* ws = A0.ws;
    bf16_t* HB = (bf16_t*)(ws + WS_HB); bf16_t* ACT = (bf16_t*)(ws + WS_ACT); bf16_t* QKV = (bf16_t*)(ws + WS_QKV); bf16_t* OB = (bf16_t*)(ws + WS_O);

    float* SS = (float*)(ws + WS_SS);
    prologue_phase(A0, lds, wv);
    xcd_barrier(bar, wv);
    KA2 A; A.out = A0.out; A.ws = A0.ws;

#pragma unroll 1
    for (int step = 0; step < 3 * DEPTH; ++step) {
        const int L = step / 3, sb = step % 3, kind = L % 3, slot = L / 3;
        int G = G0, bx = bx0; asm volatile("" : "+s"(G), "+s"(bx));
        unsigned char* wl = ws + WS_W + (size_t)(L % WSLOTS) * WL_SIZE;
        if (sb != 1) {
            { pg8::Gemm g{HB, (const bf16_t*)(wl + (sb == 0 ? WL_GU1 : WL_GU2)), M, 2 * FF, DM}; pg8::StaticOrder S; S.init(M, 2 * FF, G, bx);
              pg8::EpiSwiGLU E{ACT, FF, (LAS float*)(lds + MSL_OFF), MP, 0, SS};
              pg8::gemm_phase<pg8::EpiSwiGLU, pg8::StaticOrder, true, true>(lds, g, S, E, wv);
              {
                  const int nwg = S.nwg, umax = (nwg + G - 1) / G; int c0 = (nwg % G == 0) ? G : nwg - (umax - 1) * G, nc = G - c0; if (nc < 32) { c0 = 0; nc = G; }
                  if (bx >= c0) convert_tail(A, lds, (sb == 0) ? 1 : 2, L, c0, nc, wv); } }
            xcd_barrier(bar, wv);
            { const bf16_t* wd = (const bf16_t*)(wl + (sb == 0 ? WL_DN1 : WL_DN2));
              pg8::Gemm g{ACT, wd, MP, DM, FF}; pg8::StaticOrder S; S.init(MP, DM, G, bx);
              pg8::EpiResid E{HB, SS, 0.5f};
              pg8::gemm_phase<pg8::EpiResid, pg8::StaticOrder, true, true>(lds, g, S, E, wv);
              SEpiResid SE{HB + (size_t)MP * DM, SS + (size_t)MP * 16, 0.5f, (bf16_t*)(ws + WS_XBF)};
              small_gemm<FF, 8, 64, 6, SEpiResid>(lds, ACT + (size_t)MP * FF, (const bf16_t*)(wl + (sb == 0 ? WL_DN1F : WL_DN2F)), DM, SE, wv); }
            xcd_barrier(bar, wv);
        } else {
            if (kind == 1) fgate_step(A, INP(24) + (size_t)slot * NH, wv);
            { const bf16_t* wq = (const bf16_t*)(wl + WL_QKV);
              float *oks, *ovs;
              if (kind == 0) { oks = A.out + O_AKS + (size_t)slot * MS * DM; ovs = A.out + O_AVS + (size_t)slot * MS * DM; }
              else if (kind == 1) { oks = A.out + O_BKS; ovs = A.out + O_BVS; }
              else { oks = A.out + O_CKS; ovs = A.out + O_CVS; }
              pg8::Gemm g{HB, wq, MP, 3 * DM, DM}; pg8::StaticOrder S; S.init(MP, 3 * DM, G, bx);
              pg8::EpiQKV E;
              E.qkv = QKV; E.tstride = QKV_T; E.qscale = QSCALE; E.msl = (LAS float*)(lds + MSL_OFF); E.ord = 0; E.SS = SS;
              pg8::gemm_phase<pg8::EpiQKV, pg8::StaticOrder, true, true>(lds, g, S, E, wv);
              SEpiQKV SE{QKV + (size_t)MP * DM, QKV_T, QSCALE, oks, ovs, SS + (size_t)MP * 16};
              small_gemm<DM, 4, 96, 4, SEpiQKV>(lds, (const bf16_t*)(ws + WS_XBF), (const bf16_t*)(wl + WL_QKVF), 3 * DM, SE, wv); }
            xcd_barrier(bar, wv);
            if (kind == 1) { scan_phase(A, wv); xcd_barrier(bar, wv); }
            { AttnP P; P.Q = QKV; P.K = QKV + QKV_T; P.V = QKV + 2 * QKV_T; P.O = OB;
              P.tbl = (const float*)(ws + WS_TBL) + (size_t)slot * NH * TBLP; P.cump = (const float*)(ws + WS_CUMP); P.cums = (const float*)(ws + WS_CUMS); P.qctr = ctl + CW_Q + 512 * L;
              if (kind == 0) { P.okp = A.out + O_AKP + (size_t)slot * NB * AKEEP * DM; P.ovp = A.out + O_AVP + (size_t)slot * NB * AKEEP * DM; } else if (kind == 1) { P.okp = A.out + O_BKP; P.ovp = A.out + O_BVP; } else { P.okp = A.out + O_CKP; P.ovp = A.out + O_CVP; }
              if (kind == 0) { P.ck = INP(2) + (size_t)slot * DB * ACACHE * DM; P.cv = INP(3) + (size_t)slot * DB * ACACHE * DM; attn_phase<0>(P, lds, wv); }
              else if (kind == 1) { P.ck = INP(4); P.cv = INP(5); attn_phase<1>(P, lds, wv); }
              else { P.ck = INP(7); P.cv = INP(8); attn_phase<2>(P, lds, wv); } }
            xcd_barrier(bar, wv);
            { const bf16_t* wo = (const bf16_t*)(wl + WL_WO);
              pg8::Gemm g{OB, wo, MP, DM, DM}; pg8::StaticOrder S; S.init(MP, DM, G, bx);
              pg8::EpiResid E{HB, SS, 1.0f};
              pg8::gemm_phase<pg8::EpiResid, pg8::StaticOrder, true, true>(lds, g, S, E, wv);
              SEpiResid SE{HB + (size_t)MP * DM, SS + (size_t)MP * 16, 1.0f, (bf16_t*)(ws + WS_XBF)};
              small_gemm<DM, 8, 64, 4, SEpiResid>(lds, OB + (size_t)MP * DM, (const bf16_t*)(wl + WL_WOF), DM, SE, wv); }
            xcd_barrier(bar, wv);
        }
    }
    final_norm_phase(A, wv);
}

extern "C" void kernel_launch(void* const* d_in, const int* in_sizes, int n_in, void* d_out, int out_size, void* d_ws, size_t ws_size, hipStream_t stream) {
    static int grid = 0;
    if (grid == 0) {
        if (n_in != 28 || (size_t)out_size != O_END || ws_size < WS_END) { fprintf(stderr, "kernel_launch: unexpected shapes: n_in %d out %d (want %zu) ws %zu (want %zu)\n", n_in, out_size, (size_t)O_END, ws_size, (size_t)WS_END); grid = -1; return; }
        int dev = 0, cus = 0, per_cu = 0;
        if (hipGetDevice(&dev) != hipSuccess || hipDeviceGetAttribute(&cus, hipDeviceAttributeMultiprocessorCount, dev) != hipSuccess) { grid = -1; return; }
        if (hipFuncSetAttribute((const void*)fwd_kernel, hipFuncAttributeMaxDynamicSharedMemorySize, LDS_BYTES) != hipSuccess) { fprintf(stderr, "kernel_launch: hipFuncSetAttribute failed\n"); grid = -1; return; }
        if (hipOccupancyMaxActiveBlocksPerMultiprocessor(&per_cu, (const void*)fwd_kernel, NWAVES * 64, LDS_BYTES) != hipSuccess || per_cu < 1) fprintf(stderr, "kernel_launch: occupancy query reports %d blocks per CU\n", per_cu);
        (void)hipGetLastError();
        if (cus < 243) { fprintf(stderr, "kernel_launch: %d CUs: the per-phase LDS row table holds 6 units per workgroup (needs >= 243 workgroups)\n", cus); grid = -1; return; }
        grid = cus;
    }
    if (grid < 0) return;
    if (hipMemsetAsync((char*)d_ws + WS_CTL, 0, CTL_ZERO_BYTES, stream) != hipSuccess) { fprintf(stderr, "kernel_launch: memset failed\n"); return; }
    KArgs a{};
    for (int i = 0; i < 28; ++i) a.in[i] = (const float*)d_in[i];
    a.out = (float*)d_out; a.ws = (unsigned char*)d_ws;
    hipLaunchKernelGGL(fwd_kernel, dim3(grid), dim3(NWAVES * 64), LDS_BYTES, stream, a);
    const hipError_t le = hipPeekAtLastError();
    if (le != hipSuccess) fprintf(stderr, "kernel_launch: launch failed: %s\n", hipGetErrorName(le));
}
```
